# Optimizing an MI355X kernel written in HIP

```python
import math
import jax, jax.numpy as jnp
from jax import lax
import numpy as np

D_MODEL = 1024
BATCH = 2
SEQ = 16384
DEPTH = 4

F32 = jnp.float32
GRID_W = 64
CTX_LEN = 256
HEAD_DIM = 64
NA_HEADS = 4
WIN_H = 8
WIN_W = 16
DIFF_HEADS = 4
DIFF_DK = 32
DIFF_DV = 64
MLA_HEADS = 4
MLA_Q_RANK = 256
MLA_KV_RANK = 128
MLA_NOPE = 64
MLA_ROPE = 32
MLA_V = 64
S5_GROUPS = 16
S5_GROUP_CH = 16
S5_STATE = 64
S5_WIDTH = S5_GROUPS * S5_GROUP_CH
N_BRANCH = 4
BRANCH_W = 256
N_EXPERTS = 64
TOP_K = 6
EXPERT_FF = 256
ROUTED_SCALE = 1.0
EXPERT_BLOCK = 256
Q_BLOCK = 128
ROPE_BASE = 10000.0
EPS = 1e-6
NEG_INF = -1e30

NA_W = NA_HEADS * HEAD_DIM
DIFF_QK_W = DIFF_HEADS * 2 * DIFF_DK
DIFF_V_W = DIFF_HEADS * DIFF_DV
IN_SIZES = (3 * NA_W, DIFF_QK_W, DIFF_QK_W, DIFF_V_W, MLA_Q_RANK, MLA_KV_RANK, MLA_ROPE, S5_WIDTH, N_BRANCH * D_MODEL)
IN_W = sum(IN_SIZES)
IN_OFFSETS = tuple(int(v) for v in np.cumsum(IN_SIZES)[:-1])

kernel_name = "hybrid_natten_diff_mla_s5_moe_dit"


def rmsnorm(x, g):
    xf = x.astype(F32)
    y = xf * lax.rsqrt(jnp.mean(xf * xf, axis=-1, keepdims=True) + EPS)
    return (y * g.astype(F32)).astype(x.dtype)


def modulate(h, shift, scale):
    return h * (1 + scale) + shift


def heads_to_tokens(o):
    b, h, l, d = o.shape
    return o.transpose(0, 2, 1, 3).reshape(b, l, h * d)


def _rotate(x, pos):
    n = x.shape[-1]
    half = n // 2
    freqs = ROPE_BASE ** (-jnp.arange(half, dtype=F32) * 2.0 / n)
    ang = pos.astype(F32)[:, None] * freqs[None, :]
    cos, sin = jnp.cos(ang), jnp.sin(ang)
    xf = x.astype(F32)
    x1, x2 = xf[..., :half], xf[..., half:]
    return jnp.concatenate([x1 * cos - x2 * sin, x1 * sin + x2 * cos], axis=-1).astype(x.dtype)


def rope_2d(x, rows, cols):
    r = x.shape[-1] // 2
    return jnp.concatenate([_rotate(x[..., :r], rows), _rotate(x[..., r:], cols)], axis=-1)


def ctx_attention(q, k, v, scale):
    s = jnp.einsum('bhqd,bhkd->bhqk', q, k).astype(F32) * scale
    p = jax.nn.softmax(s, axis=-1).astype(v.dtype)
    return jnp.einsum('bhqk,bhkd->bhqd', p, v)


def attend_latent(q_lat, q_ctx, k_lat, k_ctx, v_lat, v_ctx, scale):
    b, h, s, _ = q_lat.shape
    nb = s // Q_BLOCK

    def to_blocks(q):
        return q.reshape(b, h, nb, Q_BLOCK, q.shape[-1]).transpose(2, 0, 1, 3, 4)

    def one_block(qs):
        ql, qc = qs
        s_lat = jnp.einsum('bhqd,bhkd->bhqk', ql, k_lat).astype(F32)
        s_ctx = jnp.einsum('bhqd,bhkd->bhqk', qc, k_ctx).astype(F32)
        p = jax.nn.softmax(jnp.concatenate([s_lat, s_ctx], axis=-1) * scale, axis=-1).astype(v_lat.dtype)
        return (jnp.einsum('bhqk,bhkd->bhqd', p[..., :s], v_lat)
                + jnp.einsum('bhqk,bhkd->bhqd', p[..., s:], v_ctx))

    o = lax.map(one_block, (to_blocks(q_lat), to_blocks(q_ctx)))
    return o.transpose(1, 2, 0, 3, 4).reshape(b, h, s, -1)


def neighbourhood_attention(qkv_l, qkv_c, rpb, with_ctx_out):
    b, s, _ = qkv_l.shape
    lc = qkv_c.shape[1]
    n_rows = s // GRID_W
    kh = min(WIN_H, n_rows)
    q, k, v = qkv_l.reshape(b, s, 3, NA_HEADS, HEAD_DIM).transpose(2, 0, 3, 1, 4)
    qc, kc, vc = qkv_c.reshape(b, lc, 3, NA_HEADS, HEAD_DIM).transpose(2, 0, 3, 1, 4)
    scale = HEAD_DIM ** -0.5

    def grid(t):
        return t.reshape(b, NA_HEADS, n_rows, GRID_W, HEAD_DIM)

    qg, kg, vg = grid(q), grid(k), grid(v)
    r = jnp.arange(n_rows)
    ridx = jnp.clip(r - kh // 2, 0, n_rows - kh)[:, None] + jnp.arange(kh)[None, :]
    kw = kg[:, :, ridx].reshape(b, NA_HEADS, n_rows, kh * GRID_W, HEAD_DIM)
    vw = vg[:, :, ridx].reshape(b, NA_HEADS, n_rows, kh * GRID_W, HEAD_DIM)
    col = jnp.arange(GRID_W)
    cstart = jnp.clip(col - WIN_W // 2, 0, GRID_W - WIN_W)
    valid = (col[None, :] >= cstart[:, None]) & (col[None, :] < cstart[:, None] + WIN_W)
    dr = ridx - r[:, None] + (WIN_H - 1)
    dc = jnp.clip(col[None, :] - col[:, None], 1 - WIN_W, WIN_W - 1) + (WIN_W - 1)
    bias = rpb.astype(F32)[:, dr[:, None, :, None], dc[None, :, None, :]]
    bias = jnp.where(valid[:, None, :], bias, NEG_INF).reshape(NA_HEADS, n_rows, GRID_W, kh * GRID_W)
    s_win = jnp.einsum('bhrqd,bhrkd->bhrqk', qg, kw).astype(F32) * scale + bias
    s_ctx = jnp.einsum('bhrqd,bhcd->bhrqc', qg, kc).astype(F32) * scale
    p = jax.nn.softmax(jnp.concatenate([s_win, s_ctx], axis=-1), axis=-1).astype(v.dtype)
    nw = kh * GRID_W
    o = (jnp.einsum('bhrqk,bhrkd->bhrqd', p[..., :nw], vw)
         + jnp.einsum('bhrqc,bhcd->bhrqd', p[..., nw:], vc))
    y_l = heads_to_tokens(o.reshape(b, NA_HEADS, s, HEAD_DIM))
    y_c = heads_to_tokens(ctx_attention(qc, kc, vc, scale)) if with_ctx_out else None
    return y_l, y_c


def diff_attention(q_l, k_l, v_l, q_c, k_c, v_c, lam, g_sub, lam_init, rows, cols, with_ctx_out):
    b = q_l.shape[0]

    def qk_heads(t):
        return t.reshape(b, t.shape[1], DIFF_HEADS * 2, DIFF_DK).transpose(0, 2, 1, 3)

    def v_heads(t):
        vv = t.reshape(b, t.shape[1], DIFF_HEADS, DIFF_DV).transpose(0, 2, 1, 3)
        return jnp.repeat(vv, 2, axis=1)

    q, k, v = qk_heads(q_l), qk_heads(k_l), v_heads(v_l)
    kc, vc = qk_heads(k_c), v_heads(v_c)
    scale = DIFF_DK ** -0.5
    lf = lam.astype(F32)
    lam_full = jnp.exp(jnp.sum(lf[0] * lf[1])) - jnp.exp(jnp.sum(lf[2] * lf[3])) + lam_init

    def combine(o):
        l = o.shape[2]
        o5 = o.reshape(b, DIFF_HEADS, 2, l, DIFF_DV).astype(F32)
        d = rmsnorm(o5[:, :, 0] - lam_full * o5[:, :, 1], g_sub) * (1.0 - lam_init)
        return heads_to_tokens(d.astype(o.dtype))

    o = attend_latent(rope_2d(q, rows, cols), q, rope_2d(k, rows, cols), kc, v, vc, scale)
    y_l = combine(o)
    y_c = combine(ctx_attention(qk_heads(q_c), kc, vc, scale)) if with_ctx_out else None
    return y_l, y_c


def mla(cq_l, ckv_l, kpe_l, cq_c, ckv_c, kpe_c, g_q, g_kv, w_uq, w_ukv, rows, cols, with_ctx_out):
    b = cq_l.shape[0]

    def q_heads(cq):
        q = (rmsnorm(cq, g_q) @ w_uq).reshape(b, cq.shape[1], MLA_HEADS, MLA_NOPE + MLA_ROPE).transpose(0, 2, 1, 3)
        return q[..., :MLA_NOPE], q[..., MLA_NOPE:]

    def kv_heads(ckv):
        kv = (rmsnorm(ckv, g_kv) @ w_ukv).reshape(b, ckv.shape[1], MLA_HEADS, MLA_NOPE + MLA_V).transpose(0, 2, 1, 3)
        return kv[..., :MLA_NOPE], kv[..., MLA_NOPE:]

    def with_rope_key(k_nope, k_pe):
        return jnp.concatenate([k_nope, jnp.broadcast_to(k_pe[:, None], k_nope.shape[:3] + (MLA_ROPE,))], axis=-1)

    qn, qp = q_heads(cq_l)
    kn, v = kv_heads(ckv_l)
    knc, vc = kv_heads(ckv_c)
    k_ctx = with_rope_key(knc, kpe_c)
    k_lat = with_rope_key(kn, rope_2d(kpe_l, rows, cols))
    q_lat = jnp.concatenate([qn, rope_2d(qp, rows, cols)], axis=-1)
    q_lc = jnp.concatenate([qn, qp], axis=-1)
    scale = (MLA_NOPE + MLA_ROPE) ** -0.5
    y_l = heads_to_tokens(attend_latent(q_lat, q_lc, k_lat, k_ctx, v, vc, scale))
    y_c = None
    if with_ctx_out:
        qnc, qpc = q_heads(cq_c)
        y_c = heads_to_tokens(ctx_attention(jnp.concatenate([qnc, qpc], axis=-1), k_ctx, vc, scale))
    return y_l, y_c


def _cplx_combine(e1, e2):
    a1r, a1i, b1r, b1i = e1
    a2r, a2i, b2r, b2i = e2
    return (a2r * a1r - a2i * a1i, a2r * a1i + a2i * a1r,
            a2r * b1r - a2i * b1i + b2r, a2r * b1i + a2i * b1r + b2i)


def s5_discretise(lam_re, lam_im, log_step, b_re, b_im):
    lr, li = lam_re.astype(F32), lam_im.astype(F32)
    step = jnp.exp(log_step.astype(F32))[:, None]
    mag = jnp.exp(lr * step)
    ar, ai = mag * jnp.cos(li * step), mag * jnp.sin(li * step)
    den = lr * lr + li * li
    fr = ((ar - 1.0) * lr + ai * li) / den
    fi = (ai * lr - (ar - 1.0) * li) / den
    br, bi = b_re.astype(F32), b_im.astype(F32)
    return ar, ai, fr[..., None] * br - fi[..., None] * bi, fr[..., None] * bi + fi[..., None] * br


def s5_scan(u, disc, h0, reverse):
    ar, ai, bbr, bbi = disc
    br = jnp.einsum('blgj,gpj->lbgp', u, bbr)
    bi = jnp.einsum('blgj,gpj->lbgp', u, bbi)
    if h0 is not None:
        h0r, h0i = h0
        pos = -1 if reverse else 0
        br = br.at[pos].add(ar * h0r - ai * h0i)
        bi = bi.at[pos].add(ar * h0i + ai * h0r)
    a_r = jnp.broadcast_to(ar, br.shape)
    a_i = jnp.broadcast_to(ai, bi.shape)
    _, _, hr, hi = lax.associative_scan(_cplx_combine, (a_r, a_i, br, bi), reverse=reverse, axis=0)
    return hr, hi


def s5_readout(h, c_re, c_im):
    hr, hi = h
    return (jnp.einsum('lbgp,gjp->blgj', hr, c_re.astype(F32))
            - jnp.einsum('lbgp,gjp->blgj', hi, c_im.astype(F32)))


def s5_mixer(u_l, u_c, lam_re, lam_im, log_step, b_re, b_im, c_re, c_im, d, w_glu, b_glu, with_ctx_out):
    b, s, _ = u_l.shape
    lc = u_c.shape[1]
    disc_f = s5_discretise(lam_re[0], lam_im[0], log_step[0], b_re[0], b_im[0])
    disc_b = s5_discretise(lam_re[1], lam_im[1], log_step[1], b_re[1], b_im[1])
    ul = u_l.astype(F32).reshape(b, s, S5_GROUPS, S5_GROUP_CH)
    uc = u_c.astype(F32).reshape(b, lc, S5_GROUPS, S5_GROUP_CH)
    hf_c = s5_scan(uc, disc_f, None, False)
    hb_c = s5_scan(uc, disc_b, None, True)
    hf_l = s5_scan(ul, disc_f, (hf_c[0][-1], hf_c[1][-1]), False)
    hb_l = s5_scan(ul, disc_b, (hb_c[0][0], hb_c[1][0]), True)
    d_f = d.astype(F32)

    def out(hf, hb, u, l):
        y = s5_readout(hf, c_re[0], c_im[0]) + s5_readout(hb, c_re[1], c_im[1]) + d_f * u
        g = jax.nn.gelu(y.reshape(b, l, S5_WIDTH))
        return (g * jax.nn.sigmoid(g @ w_glu.astype(F32) + b_glu.astype(F32))).astype(u_l.dtype)

    y_l = out(hf_l, hb_l, ul, s)
    y_c = out(hf_c, hb_c, uc, lc) if with_ctx_out else None
    return y_l, y_c


def hybrid_mixer(hl, hc, rows, cols, layer, with_ctx_out, w_in, na_rpb, diff_lambda, g_diff, g_mla_q, g_mla_kv,
                 w_mla_uq, w_mla_ukv, s5_lam_re, s5_lam_im, s5_log_step, s5_b_re, s5_b_im, s5_c_re, s5_c_im,
                 s5_d, w_glu, b_glu, w_branch, w_out):
    pl = jnp.split(hl @ w_in, IN_OFFSETS, axis=-1)
    pc = jnp.split(hc @ w_in, IN_OFFSETS, axis=-1)
    lam_init = 0.8 - 0.6 * math.exp(-0.3 * layer)
    ya = neighbourhood_attention(pl[0], pc[0], na_rpb, with_ctx_out)
    yb = diff_attention(pl[1], pl[2], pl[3], pc[1], pc[2], pc[3], diff_lambda, g_diff, lam_init, rows, cols,
                        with_ctx_out)
    ym = mla(pl[4], pl[5], pl[6], pc[4], pc[5], pc[6], g_mla_q, g_mla_kv, w_mla_uq, w_mla_ukv, rows, cols,
             with_ctx_out)
    yd = s5_mixer(pl[7], pc[7], s5_lam_re, s5_lam_im, s5_log_step, s5_b_re, s5_b_im, s5_c_re, s5_c_im, s5_d,
                  w_glu, b_glu, with_ctx_out)
    branches = (ya, yb, ym, yd)

    def merge(ys, gate_pre):
        b, l, _ = gate_pre.shape
        gates = jax.nn.sigmoid(gate_pre.astype(F32).reshape(b, l, N_BRANCH, D_MODEL)).astype(gate_pre.dtype)
        m = gates[:, :, 0] * (ys[0] @ w_branch[0])
        for i in range(1, N_BRANCH):
            m = m + gates[:, :, i] * (ys[i] @ w_branch[i])
        return m @ w_out

    y_l = merge([br[0] for br in branches], pl[8])
    y_c = merge([br[1] for br in branches], pc[8]) if with_ctx_out else None
    return y_l, y_c


def swiglu(x, w1, w3, w2):
    return (jax.nn.silu(x @ w1) * (x @ w3)) @ w2


def routed_experts(h, idx, gw, w_e1, w_e3, w_e2):
    n, d = h.shape
    n_assign = n * TOP_K
    e_flat = idx.reshape(-1)
    t_flat = jnp.repeat(jnp.arange(n, dtype=jnp.int32), TOP_K)
    w_flat = gw.reshape(-1)
    order = jnp.argsort(e_flat)
    e_s, t_s, w_s = e_flat[order], t_flat[order], w_flat[order]
    counts = jnp.bincount(e_flat, length=N_EXPERTS)
    starts = jnp.cumsum(counts) - counts
    padded = (counts + EXPERT_BLOCK - 1) // EXPERT_BLOCK * EXPERT_BLOCK
    pends = jnp.cumsum(padded)
    pstarts = pends - padded
    dest = pstarts[e_s] + jnp.arange(n_assign, dtype=jnp.int32) - starts[e_s]
    n_blocks = -(-n_assign // EXPERT_BLOCK) + N_EXPERTS
    tok = jnp.full((n_blocks * EXPERT_BLOCK,), n, jnp.int32).at[dest].set(t_s)
    wt = jnp.zeros((n_blocks * EXPERT_BLOCK,), h.dtype).at[dest].set(w_s)
    blk_e = jnp.minimum(jnp.searchsorted(pends, jnp.arange(n_blocks, dtype=jnp.int32) * EXPERT_BLOCK,
                                         side='right'), N_EXPERTS - 1)
    h_ext = jnp.concatenate([h, jnp.zeros((1, d), h.dtype)], axis=0)

    def body(acc, blk):
        t, w, e = blk
        y = swiglu(h_ext[t], w_e1[e], w_e3[e], w_e2[e]) * w[:, None]
        return acc.at[t].add(y), None

    acc, _ = lax.scan(body, jnp.zeros_like(h_ext),
                      (tok.reshape(n_blocks, EXPERT_BLOCK), wt.reshape(n_blocks, EXPERT_BLOCK), blk_e))
    return acc[:n]


def moe_ffn(h, w_router, e_bias, w_e1, w_e3, w_e2, w_s1, w_s3, w_s2):
    scores = jax.nn.sigmoid((h @ w_router).astype(F32))
    _, idx = lax.top_k(scores + e_bias.astype(F32), TOP_K)
    gw = jnp.take_along_axis(scores, idx, axis=1)
    gw = gw / jnp.sum(gw, axis=1, keepdims=True) * ROUTED_SCALE
    return swiglu(h, w_s1, w_s3, w_s2) + routed_experts(h, idx, gw.astype(h.dtype), w_e1, w_e3, w_e2)


def setup_inputs(seed: int = 0) -> dict:
    key = jax.random.key(seed)
    ks = iter(jax.random.split(key, 48))
    L, D, G, P, J = DEPTH, D_MODEL, S5_GROUPS, S5_STATE, S5_GROUP_CH
    E, FF = N_EXPERTS, EXPERT_FF

    def nrm(shape, s):
        return jax.random.normal(next(ks), shape, F32) * s

    n_idx = jnp.arange(P, dtype=F32)
    return {
        "x": nrm((BATCH, SEQ, D), 1.0),
        "c": nrm((BATCH, D), 1.0),
        "ctx": nrm((BATCH, CTX_LEN, D), 1.0),
        "c_ctx": nrm((D,), 1.0),
        "w_ada": nrm((L, D, 6 * D), 0.5 * D ** -0.5),
        "b_ada": nrm((L, 6 * D), 0.02),
        "g_norm1": 1.0 + nrm((L, D), 0.02),
        "g_norm2": 1.0 + nrm((L, D), 0.02),
        "w_in": nrm((L, D, IN_W), D ** -0.5),
        "na_rpb": nrm((L, NA_HEADS, 2 * WIN_H - 1, 2 * WIN_W - 1), 0.1),
        "diff_lambda": nrm((L, 4, DIFF_DK), 0.1),
        "g_diff": 1.0 + nrm((L, DIFF_DV), 0.02),
        "g_mla_q": 1.0 + nrm((L, MLA_Q_RANK), 0.02),
        "g_mla_kv": 1.0 + nrm((L, MLA_KV_RANK), 0.02),
        "w_mla_uq": nrm((L, MLA_Q_RANK, MLA_HEADS * (MLA_NOPE + MLA_ROPE)), MLA_Q_RANK ** -0.5),
        "w_mla_ukv": nrm((L, MLA_KV_RANK, MLA_HEADS * (MLA_NOPE + MLA_V)), MLA_KV_RANK ** -0.5),
        "s5_lam_re": -0.5 + nrm((L, 2, G, P), 1e-3),
        "s5_lam_im": math.pi * n_idx + nrm((L, 2, G, P), 1e-3),
        "s5_log_step": jax.random.uniform(next(ks), (L, 2, G), F32, math.log(1e-3), math.log(1e-1)),
        "s5_b_re": nrm((L, 2, G, P, J), (2 * J) ** -0.5),
        "s5_b_im": nrm((L, 2, G, P, J), (2 * J) ** -0.5),
        "s5_c_re": nrm((L, 2, G, J, P), (2 * P) ** -0.5),
        "s5_c_im": nrm((L, 2, G, J, P), (2 * P) ** -0.5),
        "s5_d": nrm((L, G, J), 1.0),
        "w_glu": nrm((L, S5_WIDTH, S5_WIDTH), S5_WIDTH ** -0.5),
        "b_glu": nrm((L, S5_WIDTH), 0.02),
        "w_branch": nrm((L, N_BRANCH, BRANCH_W, D), BRANCH_W ** -0.5),
        "w_out": nrm((L, D, D), D ** -0.5),
        "w_router": nrm((L, D, E), D ** -0.5),
        "e_bias": nrm((L, E), 0.01),
        "w_e1": nrm((L, E, D, FF), D ** -0.5),
        "w_e3": nrm((L, E, D, FF), D ** -0.5),
        "w_e2": nrm((L, E, FF, D), FF ** -0.5),
        "w_s1": nrm((L, D, FF), D ** -0.5),
        "w_s3": nrm((L, D, FF), D ** -0.5),
        "w_s2": nrm((L, FF, D), FF ** -0.5),
        "g_final": 1.0 + nrm((D,), 0.02),
    }


def reference(x, c, ctx, c_ctx, w_ada, b_ada, g_norm1, g_norm2, w_in, na_rpb, diff_lambda, g_diff, g_mla_q,
              g_mla_kv, w_mla_uq, w_mla_ukv, s5_lam_re, s5_lam_im, s5_log_step, s5_b_re, s5_b_im, s5_c_re,
              s5_c_im, s5_d, w_glu, b_glu, w_branch, w_out, w_router, e_bias, w_e1, w_e3, w_e2, w_s1, w_s3,
              w_s2, g_final):
    b, s, d = x.shape
    lc = ctx.shape[1]
    pos = jnp.arange(s, dtype=jnp.int32)
    rows, cols = pos // GRID_W, pos % GRID_W
    xl, xc = x, ctx
    sc, scc = jax.nn.silu(c), jax.nn.silu(c_ctx)
    for l in range(DEPTH):
        ctx_out = l < DEPTH - 1
        sh1, sc1, gt1, sh2, sc2, gt2 = jnp.split((sc @ w_ada[l] + b_ada[l])[:, None, :], 6, axis=-1)
        csh1, csc1, cgt1, csh2, csc2, cgt2 = jnp.split((scc @ w_ada[l] + b_ada[l])[None, None, :], 6, axis=-1)
        hl = modulate(rmsnorm(xl, g_norm1[l]), sh1, sc1)
        hc = modulate(rmsnorm(xc, g_norm1[l]), csh1, csc1)
        yl, yc = hybrid_mixer(hl, hc, rows, cols, l, ctx_out, w_in[l], na_rpb[l], diff_lambda[l], g_diff[l],
                              g_mla_q[l], g_mla_kv[l], w_mla_uq[l], w_mla_ukv[l], s5_lam_re[l], s5_lam_im[l],
                              s5_log_step[l], s5_b_re[l], s5_b_im[l], s5_c_re[l], s5_c_im[l], s5_d[l],
                              w_glu[l], b_glu[l], w_branch[l], w_out[l])
        xl = xl + gt1 * yl
        hl2 = modulate(rmsnorm(xl, g_norm2[l]), sh2, sc2)
        moe_w = (w_router[l], e_bias[l], w_e1[l], w_e3[l], w_e2[l], w_s1[l], w_s3[l], w_s2[l])
        if ctx_out:
            xc = xc + cgt1 * yc
            hc2 = modulate(rmsnorm(xc, g_norm2[l]), csh2, csc2)
            f = moe_ffn(jnp.concatenate([hl2.reshape(-1, d), hc2.reshape(-1, d)], axis=0), *moe_w)
            xl = xl + gt2 * f[:b * s].reshape(b, s, d)
            xc = xc + cgt2 * f[b * s:].reshape(b, lc, d)
        else:
            xl = xl + gt2 * moe_ffn(hl2.reshape(-1, d), *moe_w).reshape(b, s, d)
    return rmsnorm(xl, g_final)
```

```cpp
#include <hip/hip_runtime.h>
#include <stdint.h>
#include <stdio.h>
#ifndef PROBE_GROUP
#define PROBE_GROUP 0
#endif

#define DI __device__ __forceinline__
#define LAS __attribute__((address_space(3)))
typedef unsigned short bf16_t;
using bf16x8 = __attribute__((ext_vector_type(8))) short;
using s16x4 = __attribute__((ext_vector_type(4))) short;
using f32x4 = __attribute__((ext_vector_type(4))) float;
using f32x16 = __attribute__((ext_vector_type(16))) float;
using u32x4 = __attribute__((ext_vector_type(4))) unsigned;
using u32x2 = __attribute__((ext_vector_type(2))) unsigned;
typedef __bf16 bf2_t __attribute__((ext_vector_type(2)));
typedef float fl2_t __attribute__((ext_vector_type(2)));
typedef short v4i16_t __attribute__((ext_vector_type(4)));

constexpr int NL = 32768, NC = 512, NTOK = 33280, DM = 1024, SEQ = 16384, CTXL = 256, KLEN = 16640, DEPTH = 4;
constexpr int INW = 6304, NTHR = 512;
constexpr int NCHUNK = 260;
constexpr int YROWS = 216064 + 33280;
constexpr float LOG2E = 1.4426950408889634f;
constexpr float NA_QS = 0.125f * LOG2E;
constexpr float DIFF_QS = 0.17677669529663687f * LOG2E;
constexpr float MLA_QS = 0.10206207261596577f * LOG2E;
constexpr float EPS = 1e-6f;

constexpr size_t O_BAR = 0;
constexpr size_t O_TP = O_BAR + 14336;
constexpr size_t O_CNT = O_BAR + 16384;
constexpr size_t O_QCTR = O_CNT + 1024;
constexpr size_t O_LAMF = O_QCTR + 2048;
constexpr size_t O_ADA = O_LAMF + 256;
constexpr size_t O_ROPER = O_ADA + 294912;
constexpr size_t O_ROPEC = O_ROPER + 16384;
constexpr size_t O_S5PW = O_ROPEC + 4096;
constexpr size_t O_S5BB = O_S5PW + 4259840;
constexpr size_t O_S5K = O_S5BB + 1048576;
constexpr size_t O_X = O_S5K + 8388608;
constexpr size_t O_H1 = O_X + 136314880;
constexpr size_t O_R = O_H1 + 68157440;
constexpr size_t O_H2 = O_R;
constexpr size_t O_YCAT = O_H2 + 68157440;
constexpr size_t O_MBUF = O_YCAT + 68157440;
constexpr size_t O_QN = O_MBUF + 68157440;
constexpr size_t O_KN = O_QN + 17039360;
constexpr size_t O_VN = O_KN + 17039360;
constexpr size_t O_QDL = O_VN + 17039360;
constexpr size_t O_QDR = O_QDL + 16777216;
constexpr size_t O_KD = O_QDR + 17039360;
constexpr size_t O_VD = O_KD + 17039360;
constexpr size_t O_QML = O_VD + 17039360;
constexpr size_t O_QMR = O_QML + 25165824;
constexpr size_t O_KM = O_QMR + 25559040;
constexpr size_t O_VM = O_KM + 25559040;
constexpr size_t O_CQ = O_VM + 17039360;
constexpr size_t O_CKV = O_CQ + 17039360;
constexpr size_t O_UCAT = O_CKV + 8519680;
constexpr size_t O_SLOC = O_UCAT + 21954560;
constexpr size_t O_G5 = O_SLOC + 8519680;
constexpr size_t R_END1 = O_G5 + 17039360;
constexpr size_t R_END2 = O_R + (size_t)YROWS * 2048;
constexpr size_t O_ACT = R_END1 > R_END2 ? R_END1 : R_END2;
constexpr size_t O_IDX = O_ACT + (size_t)YROWS * 512;
constexpr size_t O_GW = O_IDX + 798720;
constexpr size_t O_SLOT = O_GW + 798720;
constexpr size_t O_ROWIDX = O_SLOT + 798720;
constexpr size_t O_WIN = O_ROWIDX + 997376;
constexpr size_t O_WG = O_WIN + 2304 * 1024 * 2;
constexpr size_t O_WUQ = O_WG + 4096 * 1024 * 2;
constexpr size_t O_WUKV = O_WUQ + 384 * 256 * 2;
constexpr size_t O_WGLU = O_WUKV + 512 * 128 * 2;
constexpr size_t O_WBR = O_WGLU + 256 * 256 * 2;
constexpr size_t O_WOUT = O_WBR + 4 * 1024 * 256 * 2;
constexpr size_t O_WE1 = O_WOUT + 1024 * 1024 * 2;
constexpr size_t O_WE3 = O_WE1 + (size_t)65 * 256 * 1024 * 2;
constexpr size_t O_WE2 = O_WE3 + (size_t)65 * 256 * 1024 * 2;
constexpr size_t O_S5B2 = O_WE2 + (size_t)65 * 1024 * 256 * 2;
constexpr size_t O_S5B1 = O_S5B2 + (size_t)16 * 1024 * 1280 * 2;
constexpr size_t O_WRHI = O_S5B1 + (size_t)16 * 256 * 1024 * 2;
constexpr size_t O_WRLO = O_WRHI + 128 * 1024 * 2;
constexpr size_t WS_NEED = O_WRLO + 128 * 1024 * 2;
constexpr size_t O_H2LO = O_MBUF;
constexpr size_t O_LOGIT = O_YCAT;

struct Params_ {
  const float *x, *c, *ctx, *c_ctx, *w_ada, *b_ada, *g_norm1, *g_norm2, *w_in, *na_rpb, *diff_lambda, *g_diff, *g_mla_q, *g_mla_kv,
      *w_mla_uq, *w_mla_ukv, *s5_lam_re, *s5_lam_im, *s5_log_step, *s5_b_re, *s5_b_im, *s5_c_re, *s5_c_im, *s5_d, *w_glu, *b_glu,
      *w_branch, *w_out, *w_router, *e_bias, *w_e1, *w_e3, *w_e2, *w_s1, *w_s3, *w_s2, *g_final;
  float* out;
  char* ws;
};
typedef const __attribute__((address_space(4))) Params_ Params;
DI Params* kargs() { Params* k = (Params*)__builtin_amdgcn_kernarg_segment_ptr(); asm volatile("" : "+s"(k)); return k; }

DI float bf2f(bf16_t b) { return __uint_as_float((unsigned)b << 16); }
DI bf16_t f2bf(float x) { unsigned u = __float_as_uint(x); u += 0x7fffu + ((u >> 16) & 1u); return (bf16_t)(u >> 16); }
DI unsigned pack2(float a, float b) { fl2_t f = {a, b}; bf2_t r = __builtin_convertvector(f, bf2_t); return __builtin_bit_cast(unsigned, r); }
DI float sigm(float x) { return __builtin_amdgcn_rcpf(1.f + __builtin_amdgcn_exp2f(-LOG2E * x)); }
DI float gelu_tanh(float x) { float u = 0.7978845608028654f * (x + 0.044715f * x * x * x); return x * (1.f - __builtin_amdgcn_rcpf(__builtin_amdgcn_exp2f((2.f * LOG2E) * u) + 1.f)); }
DI float bperm(float v, int srclane) { return __int_as_float(__builtin_amdgcn_ds_bpermute(srclane << 2, __float_as_int(v))); }
DI float xhalf(float v) { auto rr = __builtin_amdgcn_permlane32_swap(__float_as_uint(v), __float_as_uint(v), false, false); return __uint_as_float(rr[0]) + __uint_as_float(rr[1]); }
DI float xhalf_max(float v) { auto rr = __builtin_amdgcn_permlane32_swap(__float_as_uint(v), __float_as_uint(v), false, false); return fmaxf(__uint_as_float(rr[0]), __uint_as_float(rr[1])); }
DI float xhalf_get(float v, int hi) { auto rr = __builtin_amdgcn_permlane32_swap(__float_as_uint(v), __float_as_uint(v), false, false); return __uint_as_float(hi ? rr[0] : rr[1]); }
DI float wave_sum(float v, int lane) {
#pragma unroll
  for (int o = 16; o > 0; o >>= 1) v += bperm(v, lane ^ o);
  return xhalf(v);
}
DI float wave_max(float v, int lane) {
#pragma unroll
  for (int o = 16; o > 0; o >>= 1) v = fmaxf(v, bperm(v, lane ^ o));
  return xhalf_max(v);
}
DI void tokinfo(int row, int& b, int& isctx, int& t) {
  if (row < NL) { b = row >> 14; t = row & 16383; isctx = 0; }
  else { int r = row - NL; b = r >> 8; t = r & 255; isctx = 1; }
}
#define MFMA16(a, b, c) __builtin_amdgcn_mfma_f32_16x16x32_bf16((a), (b), (c), 0, 0, 0)
#define MFMA32(a, b, c) __builtin_amdgcn_mfma_f32_32x32x16_bf16((a), (b), (c), 0, 0, 0)
DI int otid() { int t = threadIdx.x; asm volatile("" : "+v"(t)); return t; }
template <int DK> DI size_t kimg(int kidx, int d) { return ((size_t)((kidx >> 6) * (DK / 8) + (d >> 3)) * 64 + (kidx & 63)) * 8 + (d & 7); }
DI size_t vimg(int kidx, int d) { return (size_t)(kidx >> 6) * 4096 + (d >> 5) * 2048 + (kidx & 63) * 32 + (d & 31); }
DI void glds16(const void* g, unsigned lds_base) {
  unsigned sv;
  asm volatile("s_mov_b32 %0, m0\n\ts_mov_b32 m0, %2\n\ts_nop 0\n\tglobal_load_lds_dwordx4 %1, off\n\ts_mov_b32 m0, %0" : "=&s"(sv) : "v"(g), "s"(lds_base) : "memory");
}
DI int crow(int r, int hi) { return (r & 3) + 8 * (r >> 2) + 4 * hi; }

constexpr int GSTAGE = 49152;
constexpr int GNST = 3;
constexpr int GEMM_LDS = GNST * GSTAGE;
constexpr int LDS_BYTES = GEMM_LDS + 2048;
constexpr int LDS_XBW = LDS_BYTES, LDS_POFF = LDS_BYTES + 16, LDS_TOTAL = LDS_BYTES + 16 + 512;
struct GJ { const bf16_t* A; const int* ridx; const bf16_t* Bt; int lda, m0, ldb, n0, nt; bool valid; };
DI GJ gj_none() { GJ j; j.A = nullptr; j.ridx = nullptr; j.Bt = nullptr; j.lda = 0; j.m0 = 0; j.ldb = 0; j.n0 = 0; j.nt = 0; j.valid = false; return j; }
DI GJ gj_make(const bf16_t* A, const int* ridx, int lda, int m0, const bf16_t* Bt, int ldb, int n0, int K) {
  GJ j; j.A = A; j.ridx = ridx; j.Bt = Bt; j.lda = lda; j.m0 = m0; j.ldb = ldb; j.n0 = n0; j.nt = K >> 6; j.valid = true; return j; }
struct GP { const bf16_t* p[6]; };
DI GP g_setup(const GJ& j, int tid) {
  const int r = tid >> 3, c = (((tid & 7) ^ ((r >> 1) & 7))) * 8;
  GP g;
#pragma unroll
  for (int i = 0; i < 4; ++i) { int rr = j.m0 + r + 64 * i; if (j.ridx) rr = j.ridx[rr]; g.p[i] = j.A + (size_t)rr * j.lda + c; }
#pragma unroll
  for (int i = 0; i < 2; ++i) g.p[4 + i] = j.Bt + (size_t)(j.n0 + r + 64 * i) * j.ldb + c;
  return g;
}
DI void g_issue1(const GP& g, int kt, char* base, int tid, int i) {
  __builtin_amdgcn_global_load_lds((const unsigned*)(g.p[i] + kt * 64), (unsigned*)(base + i * 8192 + tid * 16), 16, 0, 0);
}
DI const bf16_t* g_ptr1(const GJ& j, int tid, int i) {
  const int r = tid >> 3, c = (((tid & 7) ^ ((r >> 1) & 7))) * 8;
  if (i < 4) { int rr = j.m0 + r + 64 * i; if (j.ridx) rr = j.ridx[rr]; return j.A + (size_t)rr * j.lda + c; }
  return j.Bt + (size_t)(j.n0 + r + 64 * (i - 4)) * j.ldb + c;
}
DI void g_issue(const GP& g, int kt, char* base, int tid) {
#pragma unroll
  for (int i = 0; i < 6; ++i) g_issue1(g, kt, base, tid, i);
}
template <int NST>
struct GStream {
  GP cur; int cur_nt, ring, tid; char* lds;
  DI void start(const GJ& j, char* lds_, int tid_) {
    lds = lds_; tid = tid_; ring = 0; cur_nt = j.nt;
    if (j.valid) { cur = g_setup(j, tid);
#pragma unroll
      for (int i = 0; i < NST - 1; ++i) g_issue(cur, i, lds + i * GSTAGE, tid); }
  }
  template <bool LAZY = false, bool PF2 = true>
  DI void run(f32x4 (&acc)[4][4], const GJ& next) {
    const int lane = tid & 63, wid = tid >> 6, wr = wid >> 1, wc = wid & 1, fr = lane & 15, fq = lane >> 4;
    const int sw = (fr >> 1) & 7;
    const int aoff = (wr * 64 + fr) * 128, boff = 32768 + (wc * 64 + fr) * 128;
    const int c0 = ((fq ^ sw) * 16), c1 = (((4 + fq) ^ sw) * 16);
    const bool hn = next.valid;
    GP nxt = cur;
    if (!LAZY && hn) nxt = g_setup(next, tid);
    const int nt = cur_nt;
#pragma unroll 1
    for (int t = 0; t < nt; ++t) {
      int infl = nt - 1 - t + (hn ? NST - 1 : 0); infl = infl > NST - 2 ? NST - 2 : infl;
      if (infl >= 2) asm volatile("s_waitcnt vmcnt(12)" ::: "memory");
      else if (infl == 1) asm volatile("s_waitcnt vmcnt(6)" ::: "memory");
      else asm volatile("s_waitcnt vmcnt(0)" ::: "memory");
      __builtin_amdgcn_s_barrier();
      const int j = t + NST - 1;
      char* ib = lds + ((ring + j) % NST) * GSTAGE;
      const bool own = j < nt, doi = own || hn;
      const int ikt = own ? j : j - nt;
      GP src = cur;
      if (!LAZY && !own && hn) src = nxt;
#define G_ISSUE1(i_) do { if (LAZY && !own) __builtin_amdgcn_global_load_lds((const unsigned*)(g_ptr1(next, tid, (i_)) + ikt * 64), (unsigned*)(ib + (i_) * 8192 + tid * 16), 16, 0, 0); else g_issue1(src, ikt, ib, tid, (i_)); } while (0)
      const char* base = lds + ((ring + t) % NST) * GSTAGE;
      bf16x8 af[4], bfr[4], af1[4], bf1[4];
#pragma unroll
      for (int m = 0; m < 4; ++m) af[m] = *(const bf16x8*)(base + aoff + m * 2048 + c0);
#pragma unroll
      for (int n = 0; n < 4; ++n) bfr[n] = *(const bf16x8*)(base + boff + n * 2048 + c0);
      __builtin_amdgcn_sched_barrier(0);
#pragma unroll
      for (int m = 0; m < 4; ++m) {
#pragma unroll
        for (int n = 0; n < 4; ++n) acc[m][n] = MFMA16(bfr[n], af[m], acc[m][n]);
        if (doi) G_ISSUE1(m);
        if (!LAZY && PF2) {
          if (m == 0) {
#pragma unroll
            for (int n = 0; n < 4; ++n) bf1[n] = *(const bf16x8*)(base + boff + n * 2048 + c1);
          }
          if (m == 1) {
#pragma unroll
            for (int q = 0; q < 4; ++q) af1[q] = *(const bf16x8*)(base + aoff + q * 2048 + c1);
          }
        }
        __builtin_amdgcn_sched_barrier(0);
      }
      if (LAZY || !PF2) {
#pragma unroll
        for (int m = 0; m < 4; ++m) af1[m] = *(const bf16x8*)(base + aoff + m * 2048 + c1);
#pragma unroll
        for (int n = 0; n < 4; ++n) bf1[n] = *(const bf16x8*)(base + boff + n * 2048 + c1);
        __builtin_amdgcn_sched_barrier(0);
      }
#pragma unroll
      for (int m = 0; m < 4; ++m) {
#pragma unroll
        for (int n = 0; n < 4; ++n) acc[m][n] = MFMA16(bf1[n], af1[m], acc[m][n]);
        if (m < 2 && doi) G_ISSUE1(4 + m);
        __builtin_amdgcn_sched_barrier(0);
      }
    }
#undef G_ISSUE1
    ring = (ring + nt) % NST;
    if (LAZY) { if (hn) cur = g_setup(next, tid); } else cur = nxt;
    cur_nt = next.nt;
  }
  DI void run2(f32x4 (&acc)[4][4], const GJ& next) { run(acc, next); }
};
DI void mini_gemm16(f32x4& acc, const bf16_t* __restrict__ A, int lda, const bf16_t* __restrict__ Bt, int ldb, int K, int lane) {
  const bf16_t* ap = A + (size_t)(lane & 15) * lda + 8 * (lane >> 4);
  const bf16_t* bp = Bt + (size_t)(lane & 15) * ldb + 8 * (lane >> 4);
#pragma unroll 16
  for (int k0 = 0; k0 < K; k0 += 32) {
    const bf16x8 a = *(const bf16x8*)(ap + k0), b = *(const bf16x8*)(bp + k0);
    acc = MFMA16(a, b, acc);
  }
}
constexpr int WSTAGE = 32768, WNST = 4;
struct GPW { const bf16_t* p[4]; };
DI GPW gw_setup(const GJ& j, int tid) {
  const int r = tid >> 2, c = (((tid & 3) ^ ((0 - (r >> 2)) & 3))) * 8;
  GPW g;
#pragma unroll
  for (int i = 0; i < 2; ++i) { int rr = j.m0 + r + 128 * i; if (j.ridx) rr = j.ridx[rr]; g.p[i] = j.A + (size_t)rr * j.lda + c; }
#pragma unroll
  for (int i = 0; i < 2; ++i) g.p[2 + i] = j.Bt + (size_t)(j.n0 + r + 128 * i) * j.ldb + c;
  return g;
}
DI void gw_issue1(const GPW& g, int kt, char* base, int tid, int i) {
  __builtin_amdgcn_global_load_lds((const unsigned*)(g.p[i] + kt * 32), (unsigned*)(base + i * 8192 + tid * 16), 16, 0, 0);
}
struct GStreamW {
  GPW cur; int cur_nt, ring, tid; char* lds;
  DI void start(const GJ& j, char* lds_, int tid_) {
    lds = lds_; tid = tid_; ring = 0; cur_nt = j.nt * 2;
    if (j.valid) { cur = gw_setup(j, tid);
#pragma unroll
      for (int s = 0; s < WNST - 1; ++s)
#pragma unroll
        for (int i = 0; i < 4; ++i) gw_issue1(cur, s, lds + s * WSTAGE, tid, i); }
  }
  DI void run(f32x4 (&acc)[4][8], const GJ& next) {
    const int lane = tid & 63, wid = tid >> 6, wr = wid >> 1, wc = wid & 1, fr = lane & 15, fq = lane >> 4;
    const int fo = ((fq ^ ((0 - (fr >> 2)) & 3)) * 16);
    const int aoff = (wr * 64 + fr) * 64 + fo, boff = 16384 + (wc * 128 + fr) * 64 + fo;
    const bool hn = next.valid;
    GPW nxt = cur;
    if (hn) nxt = gw_setup(next, tid);
    const int nt = cur_nt;
#pragma unroll 1
    for (int t = 0; t < nt; ++t) {
      int infl = nt - 1 - t + (hn ? WNST - 1 : 0); infl = infl > WNST - 2 ? WNST - 2 : infl;
      if (infl >= 2) asm volatile("s_waitcnt vmcnt(8)" ::: "memory");
      else if (infl == 1) asm volatile("s_waitcnt vmcnt(4)" ::: "memory");
      else asm volatile("s_waitcnt vmcnt(0)" ::: "memory");
      __builtin_amdgcn_s_barrier();
      const int j = t + WNST - 1;
      char* ib = lds + ((ring + j) % WNST) * WSTAGE;
      const bool own = j < nt, doi = own || hn;
      const int ikt = own ? j : j - nt;
      GPW src = cur;
      if (!own && hn) src = nxt;
      const char* base = lds + ((ring + t) % WNST) * WSTAGE;
      bf16x8 af[4], bfr[8];
#pragma unroll
      for (int m = 0; m < 4; ++m) af[m] = *(const bf16x8*)(base + aoff + m * 1024);
#pragma unroll
      for (int n = 0; n < 8; ++n) bfr[n] = *(const bf16x8*)(base + boff + n * 1024);
      __builtin_amdgcn_sched_barrier(0);
#pragma unroll
      for (int m = 0; m < 4; ++m) {
#pragma unroll
        for (int n = 0; n < 8; ++n) acc[m][n] = MFMA16(bfr[n], af[m], acc[m][n]);
        if (doi) gw_issue1(src, ikt, ib, tid, m);
        __builtin_amdgcn_sched_barrier(0);
      }
    }
    ring = (ring + nt) % WNST;
    cur = nxt; cur_nt = next.nt * 2;
  }
};
DI void zero_accw(f32x4 (&acc)[4][8]) {
#pragma unroll
  for (int m = 0; m < 4; ++m)
#pragma unroll
    for (int n = 0; n < 8; ++n) acc[m][n] = f32x4{0.f, 0.f, 0.f, 0.f};
}
constexpr int G8_HT = 128 * 64;
DI int g8_lds_byte(int r, int c) { const int st = (r >> 4) * 2 + (c >> 5), rr = r & 15, cc = c & 31, ob = rr * 64 + cc * 2; return st * 1024 + (ob ^ (((ob >> 9) & 1) << 5)); }
DI void g8_stage_rc(int b, int& R, int& C) { const int st = b / 1024, sb = b % 1024, swz = sb ^ (((sb >> 9) & 1) << 5); R = (st >> 1) * 16 + swz / 64; C = (st & 1) * 32 + (swz % 64) / 2; }
template <bool GATHER>
DI void gemm8(f32x4 (&acc)[2][2][4][2], const bf16_t* __restrict__ A, const int* __restrict__ ridx, int brow, const bf16_t* __restrict__ B0, const bf16_t* __restrict__ B1, int K, char* shmc) {
  bf16_t* shm = (bf16_t*)shmc;
#define G8_SA(b, h) (shm + ((b) * 2 + (h)) * G8_HT)
#define G8_SB(b, h) (shm + (4 + (b) * 2 + (h)) * G8_HT)
  int tz = otid();
  int wid = tz >> 6, lane = tz & 63, wr = wid >> 2, wc = wid & 3, fr = lane & 15, fq = lane >> 4;
  int ar[2][2];
  if (GATHER) {
#pragma unroll
    for (int h = 0; h < 2; ++h)
#pragma unroll
      for (int i = 0; i < 2; ++i) { int r_, c_; g8_stage_rc(tz * 16 + i * 8192, r_, c_); ar[h][i] = ridx[brow + h * 128 + r_]; }
  }
#define G8_STAGE_A(P, h, kt) do { _Pragma("unroll") for (int i_ = 0; i_ < 2; ++i_) { const int b_ = tz * 16 + i_ * 8192; int r_, c_; g8_stage_rc(b_, r_, c_); \
      const long row_ = GATHER ? (long)ar[h][i_] : (long)(brow + (h) * 128 + r_); \
      __builtin_amdgcn_global_load_lds((const unsigned*)(A + row_ * K + (long)(kt) * 64 + c_), (unsigned*)((char*)(P) + b_), 16, 0, 0); } } while (0)
#define G8_STAGE_B(P, h, kt) do { const bf16_t* bb_ = (h) ? B1 : B0; _Pragma("unroll") for (int i_ = 0; i_ < 2; ++i_) { const int b_ = tz * 16 + i_ * 8192; int r_, c_; g8_stage_rc(b_, r_, c_); \
      __builtin_amdgcn_global_load_lds((const unsigned*)(bb_ + (long)r_ * K + (long)(kt) * 64 + c_), (unsigned*)((char*)(P) + b_), 16, 0, 0); } } while (0)
#define G8_LDA(dst, b, h) _Pragma("unroll") for (int m = 0; m < 4; ++m) _Pragma("unroll") for (int k = 0; k < 2; ++k) \
    dst[m][k] = *reinterpret_cast<const bf16x8*>((char*)G8_SA(b, h) + g8_lds_byte(wr * 64 + m * 16 + fr, k * 32 + fq * 8))
#define G8_LDB(dst, b, h) _Pragma("unroll") for (int n = 0; n < 2; ++n) _Pragma("unroll") for (int k = 0; k < 2; ++k) \
    dst[n][k] = *reinterpret_cast<const bf16x8*>((char*)G8_SB(b, h) + g8_lds_byte(wc * 32 + n * 16 + fr, k * 32 + fq * 8))
#define G8_MMA(ai, bj, At_, Bt_) do { __builtin_amdgcn_s_setprio(1); \
    _Pragma("unroll") for (int m = 0; m < 4; ++m) _Pragma("unroll") for (int n = 0; n < 2; ++n) _Pragma("unroll") for (int k = 0; k < 2; ++k) \
      acc[ai][bj][m][n] = MFMA16(Bt_[n][k], At_[m][k], acc[ai][bj][m][n]); \
    __builtin_amdgcn_s_setprio(0); } while (0)
#define G8_WAIT_V(n) asm volatile("s_waitcnt vmcnt(" #n ")" ::: "memory")
#define G8_WAIT_L(n) asm volatile("s_waitcnt lgkmcnt(" #n ")" ::: "memory")
#define G8_BAR __builtin_amdgcn_s_barrier()
#define G8_SCHED __builtin_amdgcn_sched_barrier(0)
  bf16x8 At[4][2], Bq0[2][2], Bq1[2][2];
  const int nt = K / 64;
  G8_STAGE_B(G8_SB(0, 0), 0, 0); G8_STAGE_A(G8_SA(0, 0), 0, 0);
  G8_STAGE_B(G8_SB(0, 1), 1, 0); G8_STAGE_A(G8_SA(0, 1), 1, 0);
  if (wr == 1) G8_BAR;
  G8_WAIT_V(4); G8_BAR;
  G8_STAGE_B(G8_SB(1, 0), 0, 1); G8_STAGE_A(G8_SA(1, 0), 0, 1); G8_STAGE_B(G8_SB(1, 1), 1, 1);
  G8_WAIT_V(6); G8_BAR;
#pragma unroll 1
  for (int t = 0; t < nt - 2; t += 2) {
    G8_LDB(Bq0, 0, 0); G8_SCHED; G8_LDA(At, 0, 0); G8_STAGE_A(G8_SA(1, 1), 1, t + 1);
    G8_WAIT_L(8); G8_BAR; G8_WAIT_L(0); G8_MMA(0, 0, At, Bq0); G8_BAR; G8_SCHED;
    G8_LDB(Bq1, 0, 1); G8_STAGE_B(G8_SB(0, 0), 0, t + 2);
    G8_BAR; G8_WAIT_L(0); G8_MMA(0, 1, At, Bq1); G8_BAR;
    G8_LDA(At, 0, 1); G8_STAGE_A(G8_SA(0, 0), 0, t + 2);
    G8_BAR; G8_WAIT_L(0); G8_MMA(1, 0, At, Bq0); G8_BAR; G8_SCHED;
    G8_STAGE_B(G8_SB(0, 1), 1, t + 2);
    G8_WAIT_V(6); G8_BAR; G8_MMA(1, 1, At, Bq1); G8_BAR;
    G8_LDB(Bq0, 1, 0); G8_SCHED; G8_LDA(At, 1, 0); G8_STAGE_A(G8_SA(0, 1), 1, t + 2);
    G8_WAIT_L(8); G8_BAR; G8_WAIT_L(0); G8_MMA(0, 0, At, Bq0); G8_BAR; G8_SCHED;
    G8_LDB(Bq1, 1, 1); G8_STAGE_B(G8_SB(1, 0), 0, t + 3);
    G8_BAR; G8_WAIT_L(0); G8_MMA(0, 1, At, Bq1); G8_BAR;
    G8_LDA(At, 1, 1); G8_STAGE_A(G8_SA(1, 0), 0, t + 3);
    G8_BAR; G8_WAIT_L(0); G8_MMA(1, 0, At, Bq0); G8_BAR; G8_SCHED;
    G8_STAGE_B(G8_SB(1, 1), 1, t + 3);
    G8_WAIT_V(6); G8_BAR; G8_MMA(1, 1, At, Bq1); G8_BAR;
  }
  { int t2 = tz; asm volatile("" : "+v"(t2)); tz = t2; wid = tz >> 6; lane = tz & 63; wr = wid >> 2; wc = wid & 3; fr = lane & 15; fq = lane >> 4; }
  { G8_LDB(Bq0, 0, 0); G8_WAIT_V(0); G8_LDA(At, 0, 0); G8_STAGE_A(G8_SA(1, 1), 1, nt - 1);
    G8_BAR; G8_WAIT_L(0); G8_MMA(0, 0, At, Bq0); G8_BAR;
    G8_LDB(Bq1, 0, 1); G8_BAR; G8_WAIT_L(0); G8_MMA(0, 1, At, Bq1); G8_BAR;
    G8_LDA(At, 0, 1); G8_WAIT_V(4); G8_BAR; G8_WAIT_L(0); G8_MMA(1, 0, At, Bq0); G8_MMA(1, 1, At, Bq1); G8_BAR; }
  { G8_LDB(Bq0, 1, 0); G8_LDA(At, 1, 0); G8_WAIT_V(2); G8_BAR; G8_WAIT_L(0); G8_MMA(0, 0, At, Bq0); G8_BAR;
    G8_LDB(Bq1, 1, 1); G8_WAIT_V(0); G8_BAR; G8_WAIT_L(0); G8_MMA(0, 1, At, Bq1); G8_BAR;
    G8_LDA(At, 1, 1); G8_BAR; G8_WAIT_L(0); G8_MMA(1, 0, At, Bq0); G8_MMA(1, 1, At, Bq1); G8_BAR; }
  if (wr == 0) G8_BAR;
#undef G8_SA
#undef G8_SB
#undef G8_STAGE_A
#undef G8_STAGE_B
#undef G8_LDA
#undef G8_LDB
#undef G8_MMA
#undef G8_WAIT_V
#undef G8_WAIT_L
#undef G8_BAR
#undef G8_SCHED
}
DI void zero_acc8(f32x4 (&acc)[2][2][4][2]) {
#pragma unroll
  for (int a = 0; a < 2; ++a)
#pragma unroll
    for (int b = 0; b < 2; ++b)
#pragma unroll
      for (int m = 0; m < 4; ++m)
#pragma unroll
        for (int n = 0; n < 2; ++n) acc[a][b][m][n] = f32x4{0.f, 0.f, 0.f, 0.f};
}
struct UM {
  int x, r, R, NT, nloc;
  DI UM(int NM, int NT_) { x = blockIdx.x & 7; r = blockIdx.x >> 3; R = gridDim.x >> 3; NT = NT_; nloc = ((NM - x + 7) >> 3) * NT_; if (NM <= x) nloc = 0; }
  DI bool get(int k, int& mt, int& nt) const { const int v = r + k * R; if (k < 0 || v >= nloc) return false; mt = x + 8 * (v / NT); nt = v % NT; return true; }
};
DI u32x2 pack4(const f32x4& v) { u32x2 r; r[0] = pack2(v[0], v[1]); r[1] = pack2(v[2], v[3]); return r; }
DI void zero_acc(f32x4 (&acc)[4][4]) {
#pragma unroll
  for (int m = 0; m < 4; ++m)
#pragma unroll
    for (int n = 0; n < 4; ++n) acc[m][n] = f32x4{0.f, 0.f, 0.f, 0.f};
}

DI float rope_apply(float v, float partner, int fr, int half, int t, const float2* roper, const float2* ropec) {
  const int i = fr & 7;
  const float2 cs = half ? ropec[(t & 63) * 8 + i] : roper[(t >> 6) * 8 + i];
  return (fr & 8) ? (partner * cs.y + v * cs.x) : (v * cs.x - partner * cs.y);
}

DI void phase_p0(const Params& p, char* lds) {
  const int tid = otid(), gtid = blockIdx.x * NTHR + tid, gsz = gridDim.x * NTHR;
  float* sl = (float*)lds;
  for (int i = tid; i < 3072; i += NTHR) { float v = i < 2048 ? p.c[i] : p.c_ctx[i - 2048]; sl[i] = v / (1.f + __expf(-v)); }
  __syncthreads();
  float* adap = (float*)(p.ws + O_ACT);
  for (int w = gtid; w < DEPTH * 6144 * 4; w += gsz) {
    const int kp = w / (DEPTH * 6144), o = w % (DEPTH * 6144);
    const int l = o / 6144, col = o % 6144;
    const float* wp = p.w_ada + ((size_t)l * 1024 + kp * 256) * 6144 + col;
    const float* s0 = sl + kp * 256;
    float a0 = 0.f, a1 = 0.f, a2 = 0.f;
#pragma unroll 16
    for (int k = 0; k < 256; ++k) { const float wv = wp[(size_t)k * 6144]; a0 += s0[k] * wv; a1 += s0[1024 + k] * wv; a2 += s0[2048 + k] * wv; }
    float* dst = adap + (size_t)kp * (DEPTH * 3 * 6144);
    dst[(l * 3 + 0) * 6144 + col] = a0; dst[(l * 3 + 1) * 6144 + col] = a1; dst[(l * 3 + 2) * 6144 + col] = a2;
  }
  float2* rr = (float2*)(p.ws + O_ROPER);
  float2* rc = (float2*)(p.ws + O_ROPEC);
  for (int i = gtid; i < 2048 + 512; i += gsz) {
    const int j = i < 2048 ? i : i - 2048;
    const int pos = j >> 3, f = j & 7;
    double freq = 1.0;
    switch (f) { case 1: freq = 0.31622776601683794; break; case 2: freq = 0.1; break; case 3: freq = 0.031622776601683794; break; case 4: freq = 0.01; break;
      case 5: freq = 0.0031622776601683794; break; case 6: freq = 0.001; break; case 7: freq = 0.00031622776601683794; break; default: break; }
    double rev = (double)pos * freq * 0.15915494309189535; rev -= floor(rev);
    const float rf = (float)rev;
    const float2 cs = make_float2(__builtin_amdgcn_cosf(rf), __builtin_amdgcn_sinf(rf));
    if (i < 2048) rr[j] = cs; else rc[j] = cs;
  }
  float2* pw = (float2*)(p.ws + O_S5PW);
  float2* bb = (float2*)(p.ws + O_S5BB);
  for (int i = gtid; i < DEPTH * 2 * 16 * 64; i += gsz) {
    const int ldg = i >> 6, pp = i & 63;
    const float lr = p.s5_lam_re[i], li = p.s5_lam_im[i];
    const float step = expf(p.s5_log_step[ldg]);
    float ar = 1.f, ai = 0.f;
    for (int tau = 0; tau <= 64; ++tau) {
      double rev = (double)li * (double)step * (double)tau * 0.15915494309189535; rev -= floor(rev);
      const float rf = (float)rev;
      const float mag = expf(lr * step * (float)tau);
      const float2 v = make_float2(mag * __builtin_amdgcn_cosf(rf), mag * __builtin_amdgcn_sinf(rf));
      pw[((size_t)ldg * 65 + tau) * 64 + pp] = v;
      if (tau == 1) { ar = v.x; ai = v.y; }
    }
    const float den = lr * lr + li * li;
    const float fr_ = ((ar - 1.f) * lr + ai * li) / den, fi_ = (ai * lr - (ar - 1.f) * li) / den;
    for (int j = 0; j < 16; ++j) {
      const float br = p.s5_b_re[(size_t)i * 16 + j], bi = p.s5_b_im[(size_t)i * 16 + j];
      bb[(size_t)i * 16 + j] = make_float2(fr_ * br - fi_ * bi, fr_ * bi + fi_ * br);
    }
  }
  if (gtid < DEPTH) {
    const float* lf = p.diff_lambda + gtid * 128;
    float s1 = 0.f, s2 = 0.f;
    for (int k = 0; k < 32; ++k) { s1 += lf[k] * lf[32 + k]; s2 += lf[64 + k] * lf[96 + k]; }
    const float lam_init = 0.8f - 0.6f * expf(-0.3f * (float)gtid);
    ((float*)(p.ws + O_LAMF))[gtid] = expf(s1) - expf(s2) + lam_init;
  }
  if (gtid < 64) ((int*)(p.ws + O_CNT))[gtid] = 0;
}

DI void phase_p1(const Params& p) {
  const int gtid = blockIdx.x * NTHR + otid(), gsz = gridDim.x * NTHR;
  {
    const float* adap = (const float*)(p.ws + O_ACT);
    float* ada = (float*)(p.ws + O_ADA);
    for (int i = gtid; i < DEPTH * 3 * 6144; i += gsz) {
      const int l = i / (3 * 6144), col = i % 6144;
      ada[i] = ((adap[i] + adap[i + DEPTH * 3 * 6144]) + (adap[i + 2 * DEPTH * 3 * 6144] + adap[i + 3 * DEPTH * 3 * 6144])) + p.b_ada[l * 6144 + col];
    }
  }
  const float2* pw = (const float2*)(p.ws + O_S5PW);
  const float2* bb = (const float2*)(p.ws + O_S5BB);
  float* km = (float*)(p.ws + O_S5K);
  for (int o = gtid; o < DEPTH * 2 * 16 * 64 * 256; o += gsz) {
    const int j2 = o & 15, j = (o >> 4) & 15, tau = (o >> 8) & 63, ldg = o >> 14;
    const float* cr = p.s5_c_re + ((size_t)ldg * 16 + j) * 64;
    const float* ci = p.s5_c_im + ((size_t)ldg * 16 + j) * 64;
    const float2* pwr = pw + ((size_t)ldg * 65 + tau) * 64;
    const float2* bbr = bb + (size_t)ldg * 64 * 16 + j2;
    float s = 0.f;
    for (int pp = 0; pp < 64; ++pp) {
      const float2 a = pwr[pp], b = bbr[pp * 16];
      const float wr_ = cr[pp] * a.x - ci[pp] * a.y, wi_ = cr[pp] * a.y + ci[pp] * a.x;
      s += wr_ * b.x - wi_ * b.y;
    }
    km[o] = s;
  }
}

template <int LOPART = 0>
DI void conv_tile(const float* __restrict__ in, int ld_in, bf16_t* __restrict__ out, int ld_out, const float* __restrict__ rs, int k0, int n0, float* sm) {
  const int tid = otid();
  {
    const int k = tid >> 3, n4 = (tid & 7) * 4;
    float4 v = *(const float4*)(in + (size_t)(k0 + k) * ld_in + n0 + n4);
    if (rs) { const float s = rs[k0 + k]; v.x *= s; v.y *= s; v.z *= s; v.w *= s; }
    sm[(n4 + 0) * 65 + k] = v.x; sm[(n4 + 1) * 65 + k] = v.y; sm[(n4 + 2) * 65 + k] = v.z; sm[(n4 + 3) * 65 + k] = v.w;
  }
  __syncthreads();
  {
    const int n = tid >> 4, k4 = (tid & 15) * 4;
    const float* s = sm + n * 65 + k4;
    float v0 = s[0], v1 = s[1], v2 = s[2], v3 = s[3];
    if (LOPART) { v0 -= bf2f(f2bf(v0)); v1 -= bf2f(f2bf(v1)); v2 -= bf2f(f2bf(v2)); v3 -= bf2f(f2bf(v3)); }
    u32x2 o; o[0] = pack2(v0, v1); o[1] = pack2(v2, v3);
    *(u32x2*)(out + (size_t)(n0 + n) * ld_out + k0 + k4) = o;
  }
  __syncthreads();
}
DI void conv_job(const float* in, int ld_in, size_t in_ms, bf16_t* out, int ld_out, size_t out_ms, const float* rs, int K, int N, int multi, float* sm) {
  const int tk = K >> 6, tn = N >> 5, per = tk * tn, total = per * multi;
  const int tid = otid();
  const int k = tid >> 3, n4 = (tid & 7) * 4, n = tid >> 4, k4 = (tid & 15) * 4;
  for (int t0 = blockIdx.x * 4; t0 < total; t0 += gridDim.x * 4) {
    float4 v[4];
#pragma unroll
    for (int q = 0; q < 4; ++q) {
      const int t = t0 + q;
      if (t < total) {
        const int mi = t / per, tt = t % per, k0 = (tt / tn) * 64, n0 = (tt % tn) * 32;
        v[q] = *(const float4*)(in + (size_t)mi * in_ms + (size_t)(k0 + k) * ld_in + n0 + n4);
        if (rs) { const float sc = rs[k0 + k]; v[q].x *= sc; v[q].y *= sc; v[q].z *= sc; v[q].w *= sc; }
      } else v[q] = make_float4(0.f, 0.f, 0.f, 0.f);
    }
#pragma unroll
    for (int q = 0; q < 4; ++q) { float* s_ = sm + q * 2080; s_[(n4 + 0) * 65 + k] = v[q].x; s_[(n4 + 1) * 65 + k] = v[q].y; s_[(n4 + 2) * 65 + k] = v[q].z; s_[(n4 + 3) * 65 + k] = v[q].w; }
    __syncthreads();
#pragma unroll
    for (int q = 0; q < 4; ++q) {
      const int t = t0 + q;
      if (t < total) {
        const int mi = t / per, tt = t % per, k0 = (tt / tn) * 64, n0 = (tt % tn) * 32;
        const float* s_ = sm + q * 2080 + n * 65 + k4;
        u32x2 o; o[0] = pack2(s_[0], s_[1]); o[1] = pack2(s_[2], s_[3]);
        *(u32x2*)(out + (size_t)mi * out_ms + (size_t)(n0 + n) * ld_out + k0 + k4) = o;
      }
    }
    __syncthreads();
  }
}
DI void phase_prep(const Params& p, int l, char* lds) {
  float* sm = (float*)lds;
  char* ws = p.ws; asm volatile("" : "+s"(ws));
  const int tid = otid(), gtid = blockIdx.x * NTHR + tid, gsz = gridDim.x * NTHR;
  unsigned z0_ = 0u; asm volatile("" : "+v"(z0_));
  const u32x4 zero4 = u32x4{z0_, z0_, z0_, z0_};
  conv_job(p.w_in + (size_t)l * 1024 * INW, INW, 0, (bf16_t*)(ws + O_WIN), 1024, 0, nullptr, 1024, 2208, 1, sm);
  for (int i = gtid; i < 96 * 1024 / 8; i += gsz) ((u32x4*)(ws + O_WIN + (size_t)2208 * 1024 * 2))[i] = zero4;
  conv_job(p.w_in + (size_t)l * 1024 * INW + 2208, INW, 0, (bf16_t*)(ws + O_WG), 1024, 0, nullptr, 1024, 4096, 1, sm);
  conv_job(p.w_mla_uq + (size_t)l * 256 * 384, 384, 0, (bf16_t*)(ws + O_WUQ), 256, 0, p.g_mla_q + l * 256, 256, 384, 1, sm);
  conv_job(p.w_mla_ukv + (size_t)l * 128 * 512, 512, 0, (bf16_t*)(ws + O_WUKV), 128, 0, p.g_mla_kv + l * 128, 128, 512, 1, sm);
  conv_job(p.w_glu + (size_t)l * 65536, 256, 0, (bf16_t*)(ws + O_WGLU), 256, 0, nullptr, 256, 256, 1, sm);
  conv_job(p.w_branch + (size_t)l * 4 * 262144, 1024, 262144, (bf16_t*)(ws + O_WBR), 256, 262144, nullptr, 256, 1024, 4, sm);
  conv_job(p.w_out + (size_t)l * 1048576, 1024, 0, (bf16_t*)(ws + O_WOUT), 1024, 0, nullptr, 1024, 1024, 1, sm);
  conv_job(p.w_e1 + (size_t)l * 64 * 262144, 256, 262144, (bf16_t*)(ws + O_WE1), 1024, 262144, nullptr, 1024, 256, 64, sm);
  conv_job(p.w_e3 + (size_t)l * 64 * 262144, 256, 262144, (bf16_t*)(ws + O_WE3), 1024, 262144, nullptr, 1024, 256, 64, sm);
  conv_job(p.w_e2 + (size_t)l * 64 * 262144, 1024, 262144, (bf16_t*)(ws + O_WE2), 256, 262144, nullptr, 256, 1024, 64, sm);
  conv_job(p.w_s1 + (size_t)l * 262144, 256, 0, (bf16_t*)(ws + O_WE1) + (size_t)64 * 262144, 1024, 0, nullptr, 1024, 256, 1, sm);
  conv_job(p.w_s3 + (size_t)l * 262144, 256, 0, (bf16_t*)(ws + O_WE3) + (size_t)64 * 262144, 1024, 0, nullptr, 1024, 256, 1, sm);
  conv_job(p.w_s2 + (size_t)l * 262144, 1024, 0, (bf16_t*)(ws + O_WE2) + (size_t)64 * 262144, 256, 0, nullptr, 256, 1024, 1, sm);
  for (int t = blockIdx.x; t < 32; t += gridDim.x) {
    conv_tile<0>(p.w_router + (size_t)l * 65536, 64, (bf16_t*)(ws + O_WRHI), 1024, nullptr, (t >> 1) * 64, (t & 1) * 32, sm);
    conv_tile<1>(p.w_router + (size_t)l * 65536, 64, (bf16_t*)(ws + O_WRLO), 1024, nullptr, (t >> 1) * 64, (t & 1) * 32, sm);
  }
  for (int i = gtid; i < 64 * 1024 / 8; i += gsz) { ((u32x4*)(ws + O_WRHI + 64 * 1024 * 2))[i] = zero4; ((u32x4*)(ws + O_WRLO + 64 * 1024 * 2))[i] = zero4; }
  const float2* pw = (const float2*)(ws + O_S5PW) + (size_t)l * 2 * 16 * 65 * 64;
  const float2* bbv = (const float2*)(ws + O_S5BB) + (size_t)l * 2 * 16 * 64 * 16;
  const float* km = (const float*)(ws + O_S5K) + (size_t)l * 2 * 16 * 64 * 256;
  const float* cre = p.s5_c_re + (size_t)l * 2 * 16 * 16 * 64;
  const float* cim = p.s5_c_im + (size_t)l * 2 * 16 * 16 * 64;
  bf16_t* b2 = (bf16_t*)(ws + O_S5B2);
#pragma unroll 1
  for (int it0 = gtid; it0 < 16 * 1024 * 128; it0 += gsz * 4) {
    float4 fa[4][2], fb[4][2]; float dd[4];
#pragma unroll
    for (int u = 0; u < 4; ++u) {
      const int it = it0 + u * gsz;
      const float4 z4 = make_float4(0.f, 0.f, 0.f, 0.f);
      fa[u][0] = z4; fa[u][1] = z4; fb[u][0] = z4; fb[u][1] = z4; dd[u] = 0.f;
      if (it < 16 * 1024 * 128) {
        const int kc = it & 127, gn = it >> 7, n = gn & 1023, g = gn >> 10, i = n >> 4, j = n & 15, k0 = kc * 8, i2 = k0 >> 4, jb = k0 & 15;
        if (i2 <= i) { const float4* q_ = (const float4*)(km + ((((size_t)0 * 16 + g) * 64 + (i - i2)) * 16 + j) * 16 + jb); fa[u][0] = q_[0]; fa[u][1] = q_[1]; }
        if (i2 >= i) { const float4* q_ = (const float4*)(km + ((((size_t)1 * 16 + g) * 64 + (i2 - i)) * 16 + j) * 16 + jb); fb[u][0] = q_[0]; fb[u][1] = q_[1]; }
        if (i2 == i && (j >> 3) == (jb >> 3)) dd[u] = p.s5_d[(l * 16 + g) * 16 + j];
      }
    }
#pragma unroll
    for (int u = 0; u < 4; ++u) {
      const int it = it0 + u * gsz;
      if (it < 16 * 1024 * 128) {
        const int kc = it & 127, gn = it >> 7, j = gn & 15, k0 = kc * 8;
        float v[8] = {0.f + fa[u][0].x + fb[u][0].x, 0.f + fa[u][0].y + fb[u][0].y, 0.f + fa[u][0].z + fb[u][0].z, 0.f + fa[u][0].w + fb[u][0].w,
                      0.f + fa[u][1].x + fb[u][1].x, 0.f + fa[u][1].y + fb[u][1].y, 0.f + fa[u][1].z + fb[u][1].z, 0.f + fa[u][1].w + fb[u][1].w};
#pragma unroll
        for (int e = 0; e < 8; ++e) if (e == (j & 7)) v[e] += dd[u];
        u32x4 o; o[0] = pack2(v[0], v[1]); o[1] = pack2(v[2], v[3]); o[2] = pack2(v[4], v[5]); o[3] = pack2(v[6], v[7]);
        *(u32x4*)(b2 + ((size_t)gn * 1280 + k0)) = o;
      }
    }
  }
#pragma unroll 1
  for (int it0 = gtid; it0 < 16 * 1024 * 32; it0 += gsz * 2) {
    float4 cr4[2][2], ci4[2][2], pw4[2][4];
#pragma unroll
    for (int u = 0; u < 2; ++u) {
      const int it = it0 + u * gsz;
      if (it < 16 * 1024 * 32) {
        const int kq = it & 31, gn = it >> 5, n = gn & 1023, g = gn >> 10, i = n >> 4, j = n & 15;
        const int d = kq >> 4, kk = (kq & 15) * 8, p0 = kk & 63, tau = d ? 64 - i : i + 1;
        const float4* c1 = (const float4*)(cre + (((size_t)d * 16 + g) * 16 + j) * 64 + p0);
        const float4* c2 = (const float4*)(cim + (((size_t)d * 16 + g) * 16 + j) * 64 + p0);
        const float4* c3 = (const float4*)(pw + (((size_t)d * 16 + g) * 65 + tau) * 64 + p0);
        cr4[u][0] = c1[0]; cr4[u][1] = c1[1]; ci4[u][0] = c2[0]; ci4[u][1] = c2[1];
        pw4[u][0] = c3[0]; pw4[u][1] = c3[1]; pw4[u][2] = c3[2]; pw4[u][3] = c3[3];
      }
    }
#pragma unroll
    for (int u = 0; u < 2; ++u) {
      const int it = it0 + u * gsz;
      if (it < 16 * 1024 * 32) {
        const int kq = it & 31, gn = it >> 5, kk = (kq & 15) * 8, ri = kk >> 6;
        const float cr[8] = {cr4[u][0].x, cr4[u][0].y, cr4[u][0].z, cr4[u][0].w, cr4[u][1].x, cr4[u][1].y, cr4[u][1].z, cr4[u][1].w};
        const float ci[8] = {ci4[u][0].x, ci4[u][0].y, ci4[u][0].z, ci4[u][0].w, ci4[u][1].x, ci4[u][1].y, ci4[u][1].z, ci4[u][1].w};
        const float ax[8] = {pw4[u][0].x, pw4[u][0].z, pw4[u][1].x, pw4[u][1].z, pw4[u][2].x, pw4[u][2].z, pw4[u][3].x, pw4[u][3].z};
        const float ay[8] = {pw4[u][0].y, pw4[u][0].w, pw4[u][1].y, pw4[u][1].w, pw4[u][2].y, pw4[u][2].w, pw4[u][3].y, pw4[u][3].w};
        float v[8];
#pragma unroll
        for (int e = 0; e < 8; ++e) {
          const float wr_ = cr[e] * ax[e] - ci[e] * ay[e], wi_ = cr[e] * ay[e] + ci[e] * ax[e];
          v[e] = ri == 0 ? wr_ : -wi_;
        }
        u32x4 o; o[0] = pack2(v[0], v[1]); o[1] = pack2(v[2], v[3]); o[2] = pack2(v[4], v[5]); o[3] = pack2(v[6], v[7]);
        *(u32x4*)(b2 + ((size_t)gn * 1280 + 1024 + kq * 8)) = o;
      }
    }
  }
  bf16_t* b1 = (bf16_t*)(ws + O_S5B1);
#pragma unroll 1
  for (int it0 = gtid; it0 < 16 * 256 * 128; it0 += gsz * 2) {
    float2 a2[2]; float4 b4[2][4];
#pragma unroll
    for (int u = 0; u < 2; ++u) {
      const int it = it0 + u * gsz;
      if (it < 16 * 256 * 128) {
        const int kc = it & 127, gn = it >> 7, n = gn & 255, g = gn >> 8;
        const int d = n >> 7, pp = n & 63, k0 = kc * 8, s = k0 >> 4, jb = k0 & 15;
        a2[u] = pw[(((size_t)d * 16 + g) * 65 + (d ? s : 63 - s)) * 64 + pp];
        const float4* q_ = (const float4*)(bbv + (((size_t)d * 16 + g) * 64 + pp) * 16 + jb);
        b4[u][0] = q_[0]; b4[u][1] = q_[1]; b4[u][2] = q_[2]; b4[u][3] = q_[3];
      }
    }
#pragma unroll
    for (int u = 0; u < 2; ++u) {
      const int it = it0 + u * gsz;
      if (it < 16 * 256 * 128) {
        const int kc = it & 127, gn = it >> 7, n = gn & 255, ri = (n >> 6) & 1, k0 = kc * 8;
        const float2 a = a2[u];
        const float bx[8] = {b4[u][0].x, b4[u][0].z, b4[u][1].x, b4[u][1].z, b4[u][2].x, b4[u][2].z, b4[u][3].x, b4[u][3].z};
        const float by[8] = {b4[u][0].y, b4[u][0].w, b4[u][1].y, b4[u][1].w, b4[u][2].y, b4[u][2].w, b4[u][3].y, b4[u][3].w};
        float v[8];
#pragma unroll
        for (int e = 0; e < 8; ++e) v[e] = ri == 0 ? (a.x * bx[e] - a.y * by[e]) : (a.x * by[e] + a.y * bx[e]);
        u32x4 o; o[0] = pack2(v[0], v[1]); o[1] = pack2(v[2], v[3]); o[2] = pack2(v[4], v[5]); o[3] = pack2(v[6], v[7]);
        *(u32x4*)(b1 + ((size_t)gn * 1024 + k0)) = o;
      }
    }
  }
}

DI void phase_rows(const Params& p, int l, float rscale = 1.f) {
  char* ws = p.ws; asm volatile("" : "+s"(ws));
  const int tid_ = otid(), lane = tid_ & 63, gw = blockIdx.x * 8 + (tid_ >> 6), nw = gridDim.x * 8;
  bf16_t* X = (bf16_t*)(ws + O_X);
  bf16_t* H1 = (bf16_t*)(ws + O_H1);
  const unsigned char* Y = (const unsigned char*)(ws + O_R);
  const int* slot = (const int*)(ws + O_SLOT);
  const float* gwt = (const float*)(ws + O_GW);
  const int* cnt = (const int*)(ws + O_CNT);
  const float* ada = (const float*)(ws + O_ADA);
  int poff64 = 0;
  if (l > 0) { for (int e = 0; e < 64; ++e) poff64 += (cnt[e] + 255) & ~255; }
  for (int row = gw; row < NTOK; row += nw) {
    int b, isctx, t; tokinfo(row, b, isctx, t);
    const int cv = isctx ? 2 : b;
    float xv[16];
    if (l == 0) {
      const float* src = isctx ? p.ctx + (size_t)(b * 256 + t) * 1024 : p.x + (size_t)row * 1024;
#pragma unroll
      for (int i = 0; i < 4; ++i) { const float4 v = *(const float4*)(src + i * 256 + lane * 4); xv[i * 4] = v.x; xv[i * 4 + 1] = v.y; xv[i * 4 + 2] = v.z; xv[i * 4 + 3] = v.w; }
    } else {
      const bf16_t* src = X + (size_t)row * 1024;
#pragma unroll
      for (int i = 0; i < 4; ++i) { const u32x2 v = *(const u32x2*)(src + i * 256 + lane * 4);
        xv[i * 4] = __uint_as_float(v[0] << 16); xv[i * 4 + 1] = __uint_as_float(v[0] & 0xffff0000u); xv[i * 4 + 2] = __uint_as_float(v[1] << 16); xv[i * 4 + 3] = __uint_as_float(v[1] & 0xffff0000u); }
      float f[16];
      typedef float fl2v __attribute__((ext_vector_type(2)));
      {
        const bf16_t* ys = (const bf16_t*)(ws + O_R + (size_t)YROWS * 1024) + (size_t)row * 1024;
#pragma unroll
        for (int i = 0; i < 4; ++i) { const u32x2 v = *(const u32x2*)(ys + i * 256 + lane * 4);
          f[i * 4] = rscale * __uint_as_float(v[0] << 16); f[i * 4 + 1] = rscale * __uint_as_float(v[0] & 0xffff0000u); f[i * 4 + 2] = rscale * __uint_as_float(v[1] << 16); f[i * 4 + 3] = rscale * __uint_as_float(v[1] & 0xffff0000u); }
      }
      int sv = 0; float wv = 0.f;
      if (lane < 6) { sv = slot[row * 6 + lane]; wv = gwt[row * 6 + lane] * rscale * 0.0625f; }
      int yv[6][4];
#pragma unroll
      for (int k = 0; k < 6; ++k) {
        const int s = __builtin_amdgcn_readlane(sv, k);
        const unsigned char* ys = Y + (size_t)s * 1024;
#pragma unroll
        for (int i = 0; i < 4; ++i) yv[k][i] = *(const int*)(ys + i * 256 + lane * 4);
      }
#pragma unroll
      for (int k = 0; k < 6; ++k) {
        const float w = __int_as_float(__builtin_amdgcn_readlane(__float_as_int(wv), k));
#pragma unroll
        for (int i = 0; i < 4; ++i) {
          const fl2v lo = __builtin_amdgcn_cvt_pk_f32_fp8(yv[k][i], false), hi = __builtin_amdgcn_cvt_pk_f32_fp8(yv[k][i], true);
          f[i * 4] += w * lo[0]; f[i * 4 + 1] += w * lo[1]; f[i * 4 + 2] += w * hi[0]; f[i * 4 + 3] += w * hi[1]; }
      }
      const float* gt2 = ada + ((l - 1) * 3 + cv) * 6144 + 5 * 1024;
#pragma unroll
      for (int i = 0; i < 4; ++i) { const float4 g = *(const float4*)(gt2 + i * 256 + lane * 4);
        xv[i * 4] += g.x * f[i * 4]; xv[i * 4 + 1] += g.y * f[i * 4 + 1]; xv[i * 4 + 2] += g.z * f[i * 4 + 2]; xv[i * 4 + 3] += g.w * f[i * 4 + 3]; }
    }
    float ss = 0.f;
#pragma unroll
    for (int i = 0; i < 16; ++i) ss += xv[i] * xv[i];
    ss = wave_sum(ss, lane);
    const float rstd = rsqrtf(ss * (1.f / 1024.f) + EPS);
    if (l < DEPTH) {
      bf16_t* dst = X + (size_t)row * 1024;
#pragma unroll
      for (int i = 0; i < 4; ++i) { u32x2 o2; o2[0] = pack2(xv[i * 4], xv[i * 4 + 1]); o2[1] = pack2(xv[i * 4 + 2], xv[i * 4 + 3]); *(u32x2*)(dst + i * 256 + lane * 4) = o2; }
      const float* gn = p.g_norm1 + l * 1024;
      const float* sh = ada + (l * 3 + cv) * 6144;
      const float* sc = sh + 1024;
      bf16_t* hd = H1 + (size_t)row * 1024;
#pragma unroll
      for (int i = 0; i < 4; ++i) {
        const int o = i * 256 + lane * 4;
        const float4 g = *(const float4*)(gn + o), s1 = *(const float4*)(sh + o), s2 = *(const float4*)(sc + o);
        const float h0 = xv[i * 4] * rstd * g.x * (1.f + s2.x) + s1.x, h1 = xv[i * 4 + 1] * rstd * g.y * (1.f + s2.y) + s1.y;
        const float h2 = xv[i * 4 + 2] * rstd * g.z * (1.f + s2.z) + s1.z, h3 = xv[i * 4 + 3] * rstd * g.w * (1.f + s2.w) + s1.w;
        u32x2 o2; o2[0] = pack2(h0, h1); o2[1] = pack2(h2, h3);
        *(u32x2*)(hd + o) = o2;
      }
    } else if (!isctx) {
      float* dst = p.out + (size_t)row * 1024;
#pragma unroll
      for (int i = 0; i < 4; ++i) {
        const int o = i * 256 + lane * 4;
        const float4 g = *(const float4*)(p.g_final + o);
        *(float4*)(dst + o) = make_float4(xv[i * 4] * rstd * g.x, xv[i * 4 + 1] * rstd * g.y, xv[i * 4 + 2] * rstd * g.z, xv[i * 4 + 3] * rstd * g.w);
      }
    }
  }
}

#define EPI_ROW_BEGIN \
  _Pragma("unroll") for (int m = 0; m < 4; ++m) { \
    int row = m0 + wr * 64 + m * 16 + fr; asm volatile("" : "+v"(row)); \
    int b, isctx, t; tokinfo(row, b, isctx, t); const int kidx = isctx ? SEQ + t : t; (void)kidx;
#define EPI_ROW_END }
DI f32x4 rope4(const f32x4& v, int c4, int half, int t, const float2* roper, const float2* ropec) {
  f32x4 r;
#pragma unroll
  for (int j = 0; j < 4; ++j) { const float partner = xhalf_get(v[j], c4 >> 3); r[j] = rope_apply(v[j], partner, c4 + j, half, t, roper, ropec); }
  return r;
}
DI void phase_proj(const Params& p, char* lds) {
  char* ws = p.ws; asm volatile("" : "+s"(ws));
  const float2* roper = (const float2*)(ws + O_ROPER);
  const float2* ropec = (const float2*)(ws + O_ROPEC);
  const UM um(130, 9);
  int mt, ntile;
  for (int k = 0; um.get(k, mt, ntile); ++k) {
    const int m0 = mt * 256, n0 = ntile * 256;
    f32x4 acc[2][2][4][2]; zero_acc8(acc);
    asm volatile("s_waitcnt vmcnt(0)" ::: "memory");
    gemm8<false>(acc, (const bf16_t*)(ws + O_H1), nullptr, m0, (const bf16_t*)(ws + O_WIN) + (size_t)n0 * 1024, (const bf16_t*)(ws + O_WIN) + (size_t)(n0 + 128) * 1024, 1024, lds);
    const int tid = otid(), lane = tid & 63, wid = tid >> 6, wr = wid >> 2, wc = wid & 3, fr = lane & 15, fq = lane >> 4, c4 = fq * 4;
#define EPI8_BEGIN \
    _Pragma("unroll") for (int ai = 0; ai < 2; ++ai) _Pragma("unroll") for (int m = 0; m < 4; ++m) { \
      int row = m0 + ai * 128 + wr * 64 + m * 16 + fr; asm volatile("" : "+v"(row)); \
      int b, isctx, t; tokinfo(row, b, isctx, t); const int kidx = isctx ? SEQ + t : t; (void)kidx; \
      _Pragma("unroll") for (int n = 0; n < 2; ++n) { const int c16 = cb + wc * 32 + n * 16; const f32x4 v = acc[ai][bj][m][n];
#define EPI8_END } }
#pragma unroll
    for (int bj = 0; bj < 2; ++bj) {
      const int cb = n0 + bj * 128, ont = cb >> 7;
      if (ont < 6) {
        const int which = cb >> 8;
        bf16_t* dst = (bf16_t*)(ws + (which == 0 ? O_QN : (which == 1 ? O_KN : O_VN)));
        const float sc = which == 0 ? NA_QS : 1.f;
        EPI8_BEGIN
          const int head = (c16 >> 6) & 3, d = (c16 & 63) + c4;
          bf16_t* hb = dst + (size_t)(b * 4 + head) * KLEN * 64;
          const size_t off = which == 0 ? (size_t)kidx * 64 + d : (which == 1 ? kimg<64>(kidx, d) : vimg(kidx, d));
          *(u32x2*)(hb + off) = pack4(v * sc);
        EPI8_END
      } else if (ont < 10) {
        const int isk = ont >= 8;
        bf16_t *QdL = (bf16_t*)(ws + O_QDL), *QdR = (bf16_t*)(ws + O_QDR), *Kd = (bf16_t*)(ws + O_KD);
        EPI8_BEGIN
          const int cc = c16 - (isk ? 1024 : 768), head8 = cc >> 5, half = (cc >> 4) & 1, d = half * 16 + c4;
          const f32x4 rv = rope4(v, c4, half, t, roper, ropec);
          if (!isk) {
            *(u32x2*)(QdR + ((size_t)(b * 8 + head8) * KLEN + kidx) * 32 + d) = pack4(v * DIFF_QS);
            if (!isctx) *(u32x2*)(QdL + ((size_t)(b * 8 + head8) * SEQ + t) * 32 + d) = pack4(rv * DIFF_QS);
          } else {
            *(u32x2*)(Kd + (size_t)(b * 8 + head8) * KLEN * 32 + kimg<32>(kidx, d)) = pack4(isctx ? v : rv);
          }
        EPI8_END
      } else if (ont < 12) {
        bf16_t* Vd = (bf16_t*)(ws + O_VD);
        EPI8_BEGIN
          const int cc = c16 - 1280, head = cc >> 6, d = (cc & 63) + c4;
          *(u32x2*)(Vd + (size_t)(b * 4 + head) * KLEN * 64 + vimg(kidx, d)) = pack4(v);
        EPI8_END
      } else if (ont < 15) {
        bf16_t* dst = ont < 14 ? (bf16_t*)(ws + O_CQ) : (bf16_t*)(ws + O_CKV);
        const int ldd = ont < 14 ? 256 : 128, base = ont < 14 ? 1536 : 1792;
        EPI8_BEGIN
          *(u32x2*)(dst + (size_t)row * ldd + (c16 - base) + c4) = pack4(v);
        EPI8_END
      } else {
        bf16_t *Km = (bf16_t*)(ws + O_KM), *Uc = (bf16_t*)(ws + O_UCAT);
        EPI8_BEGIN
          if (c16 < 1952) {
            const int half = ((c16 - 1920) >> 4) & 1, d = half * 16 + c4;
            const f32x4 rv = rope4(v, c4, half, t, roper, ropec);
            const u32x2 o = pack4(isctx ? v : rv);
#pragma unroll
            for (int h = 0; h < 4; ++h) *(u32x2*)(Km + (size_t)(b * 4 + h) * KLEN * 96 + kimg<96>(kidx, 64 + d)) = o;
          } else if (c16 < 2208) {
            const int g = (c16 - 1952) >> 4;
            const int sp = isctx ? t : 256 + t;
            *(u32x2*)(Uc + ((size_t)(g * 520 + b * NCHUNK + (sp >> 6)) * 1280) + (sp & 63) * 16 + c4) = pack4(v);
          }
        EPI8_END
      }
    }
#undef EPI8_BEGIN
#undef EPI8_END
  }
}

template <int NI>
DI void row_scales(const bf16_t* A, int row0, int kd, float* rs, int lane) {
  const int r_ = lane >> 2, q_ = lane & 3;
  u32x4 v[2][NI];
#pragma unroll
  for (int ps = 0; ps < 2; ++ps)
#pragma unroll
    for (int i = 0; i < NI; ++i) v[ps][i] = *(const u32x4*)(A + (size_t)(row0 + ps * 16 + r_) * kd + (i * 4 + q_) * 8);
#pragma unroll
  for (int ps = 0; ps < 2; ++ps) {
    float s = 0.f;
#pragma unroll
    for (int i = 0; i < NI; ++i)
#pragma unroll
      for (int e = 0; e < 4; ++e) { const float a = __uint_as_float(v[ps][i][e] << 16), b_ = __uint_as_float(v[ps][i][e] & 0xffff0000u); s += a * a; s += b_ * b_; }
    s += bperm(s, lane ^ 1); s += bperm(s, lane ^ 2);
    if (q_ == 0) rs[ps * 16 + r_] = rsqrtf(s / (float)kd + EPS);
  }
}
DI void phase_up(const Params& p, char* lds) {
  char* ws = p.ws; asm volatile("" : "+s"(ws));
  const int tid = otid(), lane = tid & 63, wid = tid >> 6, wr = wid >> 1, wc = wid & 1, fr = lane & 15, fq = lane >> 4, c4 = fq * 4;
  const float2* roper = (const float2*)(ws + O_ROPER);
  const float2* ropec = (const float2*)(ws + O_ROPEC);
  const bf16_t *CQ = (const bf16_t*)(ws + O_CQ), *CKV = (const bf16_t*)(ws + O_CKV);
  bf16_t *QmL = (bf16_t*)(ws + O_QML), *QmR = (bf16_t*)(ws + O_QMR), *Km = (bf16_t*)(ws + O_KM), *Vm = (bf16_t*)(ws + O_VM);
  float* rs = (float*)(lds + GEMM_LDS);
  auto job = [&](int u) {
    if (u < 390) return gj_make(CQ, nullptr, 256, (u / 3) * 256, (const bf16_t*)(ws + O_WUQ), 256, (u % 3) * 128, 256);
    if (u < 910) { const int uu = u - 390; return gj_make(CKV, nullptr, 128, (uu / 4) * 256, (const bf16_t*)(ws + O_WUKV), 128, (uu % 4) * 128, 128); }
    if (u < 1006) { const int uu = u - 910, g = uu / 6; return gj_make((const bf16_t*)(ws + O_UCAT) + (size_t)g * 520 * 1280, nullptr, 1280, ((uu % 6) >> 1) * 256, (const bf16_t*)(ws + O_S5B1) + (size_t)g * 256 * 1024, 1024, (uu & 1) * 128, 1024); }
    return gj_none();
  };
  GStream<GNST> gs; gs.start(job(blockIdx.x), lds, tid);
  for (int u = blockIdx.x; u < 1006; u += gridDim.x) {
    f32x4 acc[4][4]; zero_acc(acc);
    if (u < 910) {
      const bool isq = u < 390;
      const int uu = isq ? u : u - 390;
      const int mt = isq ? uu / 3 : uu / 4, ntile = isq ? uu % 3 : uu % 4, m0 = mt * 256, n0 = ntile * 128;
      const int kd = isq ? 256 : 128;
      const bf16_t* A = isq ? CQ : CKV;
      if (isq) row_scales<8>(A, m0 + wid * 32, 256, rs + wid * 32, lane); else row_scales<4>(A, m0 + wid * 32, 128, rs + wid * 32, lane);
      gs.run2(acc, job(u + gridDim.x));
#pragma unroll
      for (int m = 0; m < 4; ++m) {
        int lr = wr * 64 + m * 16 + fr;
        asm volatile("" : "+v"(lr));
        const int row = m0 + lr;
        int b, isctx, t; tokinfo(row, b, isctx, t);
        const int kidx = isctx ? SEQ + t : t;
        const float rsc = rs[lr];
#pragma unroll
        for (int n = 0; n < 4; ++n) {
          const int c16 = n0 + wc * 64 + n * 16;
          if (isq) {
            const int head = c16 / 96, dd = c16 % 96, d = dd + c4;
            const f32x4 v = acc[m][n] * (rsc * MLA_QS);
            bf16_t* qr_ = QmR + ((size_t)(b * 4 + head) * KLEN + kidx) * 96 + d;
            bf16_t* ql_ = QmL + ((size_t)(b * 4 + head) * SEQ + t) * 96 + d;
            if (dd < 64) {
              const u32x2 o = pack4(v);
              *(u32x2*)qr_ = o;
              if (!isctx) *(u32x2*)ql_ = o;
            } else {
              const f32x4 rv = rope4(v, c4, (dd >> 4) & 1, t, roper, ropec);
              *(u32x2*)qr_ = pack4(v);
              if (!isctx) *(u32x2*)ql_ = pack4(rv);
            }
          } else {
            const int head = c16 >> 7, dd = c16 & 127, d = dd + c4;
            const f32x4 v = acc[m][n] * rsc;
            if (dd < 64) *(u32x2*)(Km + (size_t)(b * 4 + head) * KLEN * 96 + kimg<96>(kidx, d)) = pack4(v);
            else *(u32x2*)(Vm + (size_t)(b * 4 + head) * KLEN * 64 + vimg(kidx, d - 64)) = pack4(v);
          }
        }
      }
      asm volatile("s_waitcnt lgkmcnt(0)" ::: "memory"); __builtin_amdgcn_s_barrier();
    } else {
      const int uu = u - 910, g = uu / 6, mt = (uu % 6) >> 1, ntile = uu & 1, m0 = mt * 256, n0 = ntile * 128;
      gs.run2(acc, job(u + gridDim.x));
      float* sloc = (float*)(ws + O_SLOC) + (size_t)g * 520 * 256;
#pragma unroll
      for (int m = 0; m < 4; ++m) {
        const int row = m0 + wr * 64 + m * 16 + fr;
        if (row < 520) {
#pragma unroll
          for (int n = 0; n < 4; ++n) *(f32x4*)(sloc + (size_t)row * 256 + n0 + wc * 64 + n * 16 + c4) = acc[m][n];
        }
      }
    }
  }
}

constexpr int ATT_NST = 4, ATT_STG = 20480, ATT_RPB = ATT_NST * ATT_STG, ATT_LDS = ATT_RPB + 2048;
template <int DK, int NMAP, int MODE, bool FAST>
DI void attn_unit(const bf16_t* const (&Qlat)[NMAP], const bf16_t* const (&Qraw)[NMAP], const bf16_t* const (&Kp)[NMAP], const bf16_t* Vp,
                  int qb, char* lds, float (&lout)[NMAP], f32x16 (&o)[NMAP][2], const float* rpbL) {
  constexpr int KS = DK / 16, KMAP = DK * 128, KBYTES = NMAP * KMAP;
  constexpr int NPOS = KBYTES / 16, KR = (NPOS + NTHR - 1) / NTHR, LPS = KR + 1;
  const int tid = otid(), lane = tid & 63, wid = tid >> 6, r32 = lane & 31, hi = lane >> 5;
  const int qrow = (MODE == 2 ? SEQ : qb * 256) + wid * 32 + r32;
  bf16x8 qf[NMAP][KS];
#pragma unroll
  for (int m = 0; m < NMAP; ++m)
#pragma unroll
    for (int s = 0; s < KS; ++s) qf[m][s] = *(const bf16x8*)((MODE == 0 ? Qlat[m] : Qraw[m]) + (size_t)qrow * DK + s * 16 + hi * 8);
  float mrun[NMAP], lrun[NMAP];
#pragma unroll
  for (int m = 0; m < NMAP; ++m) { mrun[m] = -1e30f; lrun[m] = 0.f; o[m][0] = f32x16{}; o[m][1] = f32x16{}; }
  int kt_lo = 0, kt_hi = 260;
  const int rq = qb * 4 + (wid >> 1), cq = (wid & 1) * 32 + r32;
  if (MODE == 1) { int lo = qb * 4 - 4; lo = lo < 0 ? 0 : (lo > 248 ? 248 : lo); int hi_ = qb * 4 + 3 - 4; hi_ = hi_ < 0 ? 0 : (hi_ > 248 ? 248 : hi_); kt_lo = lo; kt_hi = hi_ + 8; }
  if (MODE == 2) { kt_lo = 256; kt_hi = 260; }
  const int ntile = (MODE == 1) ? (kt_hi - kt_lo + 4) : (kt_hi - kt_lo);
  auto tile_of = [&](int i) { return (MODE == 1 && i >= kt_hi - kt_lo) ? 256 + (i - (kt_hi - kt_lo)) : kt_lo + i; };
  const bf16_t* ksrc[KR];
  int kdst[KR];
#pragma unroll
  for (int i = 0; i < KR; ++i) {
    int q = tid + i * NTHR; if (q >= NPOS) q -= NTHR;
    const int m = q / (KMAP / 16), w = q % (KMAP / 16);
    ksrc[i] = ((NMAP == 2 && m == 1) ? Kp[NMAP - 1] : Kp[0]) + w * 8;
    kdst[i] = q * 16;
  }
  const bf16_t* vsrc = Vp + tid * 8;
  auto issue = [&](int i) {
    const int kt = tile_of(i);
    char* sb = lds + (i % ATT_NST) * ATT_STG;
#pragma unroll
    for (int r = 0; r < KR; ++r) glds16(ksrc[r] + (size_t)kt * 64 * DK, (unsigned)__builtin_amdgcn_readfirstlane((int)(unsigned)(uintptr_t)(sb + kdst[r])));
    glds16(vsrc + (size_t)kt * 4096, (unsigned)__builtin_amdgcn_readfirstlane((int)(unsigned)(uintptr_t)(sb + KBYTES + tid * 16)));
  };
  const int voff = KBYTES + ((lane >> 4) & 1) * 32 + (lane & 3) * 8 + (4 * hi + ((lane & 15) >> 2)) * 64;
#pragma unroll
  for (int m = 0; m < NMAP; ++m)
#pragma unroll
    for (int s = 0; s < KS; ++s) asm volatile("" :: "v"(qf[m][s]));
  asm volatile("s_waitcnt vmcnt(0)" ::: "memory");
#pragma unroll
  for (int i = 0; i < ATT_NST - 1; ++i) if (i < ntile) issue(i);
  auto step = [&](int it) {
    const int kt = tile_of(it);
    {
      const int infl = (ntile - 1 - it) < (ATT_NST - 2) ? (ntile - 1 - it) : (ATT_NST - 2);
      if (infl >= 2) { if (LPS == 2) asm volatile("s_waitcnt vmcnt(4)" ::: "memory"); else asm volatile("s_waitcnt vmcnt(6)" ::: "memory"); }
      else if (infl == 1) { if (LPS == 2) asm volatile("s_waitcnt vmcnt(2)" ::: "memory"); else asm volatile("s_waitcnt vmcnt(3)" ::: "memory"); }
      else asm volatile("s_waitcnt vmcnt(0)" ::: "memory");
    }
    __builtin_amdgcn_s_barrier();
    char* buf = lds + (it % ATT_NST) * ATT_STG;
    bool active = true;
    int dr = 0;
    if (MODE == 1 && kt < 256) { int rs_ = rq - 4; rs_ = rs_ < 0 ? 0 : (rs_ > 248 ? 248 : rs_); active = (kt >= rs_) && (kt < rs_ + 8); dr = kt - rq + 7; }
    if (!active) { if (it + ATT_NST - 1 < ntile) issue(it + ATT_NST - 1); }
    if (active) {
      const char* vp0 = buf + voff;
      bf16x8 pf[NMAP][4];
#pragma unroll
      for (int m = 0; m < NMAP; ++m) {
        f32x16 s0 = f32x16{}, s1 = f32x16{};
        const char* kb = buf + m * KMAP + hi * 1024 + r32 * 16;
#pragma unroll
        for (int s = 0; s < KS; ++s) {
          const bf16x8 k0 = *(const bf16x8*)(kb + s * 2048);
          const bf16x8 k1 = *(const bf16x8*)(kb + s * 2048 + 512);
          s0 = MFMA32(k0, qf[m][s], s0);
          s1 = MFMA32(k1, qf[m][s], s1);
        }
        if (MODE == 1 && kt < 256) {
          int cs = cq - 8; cs = cs < 0 ? 0 : (cs > 48 ? 48 : cs);
#pragma unroll
          for (int r = 0; r < 16; ++r) {
            const int ck0 = crow(r, hi), ck1 = 32 + ck0;
            s0[r] = (ck0 >= cs && ck0 < cs + 16) ? s0[r] + rpbL[dr * 31 + (ck0 - cq + 15)] : -1e30f;
            s1[r] = (ck1 >= cs && ck1 < cs + 16) ? s1[r] + rpbL[dr * 31 + (ck1 - cq + 15)] : -1e30f;
          }
        }
        float ps = 0.f;
        if (FAST) {
#pragma unroll
          for (int r = 0; r < 16; ++r) { s0[r] = __builtin_amdgcn_exp2f(s0[r]); s1[r] = __builtin_amdgcn_exp2f(s1[r]); ps += s0[r] + s1[r]; }
          lrun[m] += ps;
        } else {
          float mx = fmaxf(s0[0], s1[0]);
#pragma unroll
          for (int r = 1; r < 16; ++r) mx = fmaxf(mx, fmaxf(s0[r], s1[r]));
          mx = xhalf_max(mx);
          const float mnew = fmaxf(mrun[m], mx);
          const float alpha = __builtin_amdgcn_exp2f(mrun[m] - mnew);
          mrun[m] = mnew;
#pragma unroll
          for (int r = 0; r < 16; ++r) { s0[r] = __builtin_amdgcn_exp2f(s0[r] - mnew); s1[r] = __builtin_amdgcn_exp2f(s1[r] - mnew); ps += s0[r] + s1[r]; }
          lrun[m] = lrun[m] * alpha + ps;
#pragma unroll
          for (int r = 0; r < 16; ++r) { o[m][0][r] *= alpha; o[m][1][r] *= alpha; }
        }
#pragma unroll
        for (int ks = 0; ks < 4; ++ks) {
          u32x4 pk;
#pragma unroll
          for (int e = 0; e < 4; ++e) {
            const int r = (ks & 1) * 8 + e * 2;
            pk[e] = (ks < 2) ? pack2(s0[r], s0[r + 1]) : pack2(s1[r], s1[r + 1]);
          }
          pf[m][ks] = __builtin_bit_cast(bf16x8, pk);
        }
      }
      if (it + ATT_NST - 1 < ntile) issue(it + ATT_NST - 1);
#pragma unroll
      for (int d0 = 0; d0 < 2; ++d0) {
        bf16x8 vf[4];
#pragma unroll
        for (int ks = 0; ks < 4; ++ks) {
          const s16x4 lo = __builtin_bit_cast(s16x4, __builtin_amdgcn_ds_read_tr16_b64_v4i16((__attribute__((address_space(3))) v4i16_t*)(vp0 + d0 * 4096 + ks * 1024)));
          const s16x4 hh = __builtin_bit_cast(s16x4, __builtin_amdgcn_ds_read_tr16_b64_v4i16((__attribute__((address_space(3))) v4i16_t*)(vp0 + d0 * 4096 + ks * 1024 + 512)));
          vf[ks] = bf16x8{lo[0], lo[1], lo[2], lo[3], hh[0], hh[1], hh[2], hh[3]};
        }
#pragma unroll
        for (int m = 0; m < NMAP; ++m)
#pragma unroll
          for (int ks = 0; ks < 4; ++ks) o[m][d0] = MFMA32(vf[ks], pf[m][ks], o[m][d0]);
      }
    }
  };
  const int n1 = MODE == 0 ? 256 : ntile;
#pragma unroll 1
  for (int it = 0; it < n1; ++it) step(it);
  if (MODE == 0) {
#pragma unroll
    for (int m = 0; m < NMAP; ++m)
#pragma unroll
      for (int s = 0; s < KS; ++s) qf[m][s] = *(const bf16x8*)(Qraw[m] + (size_t)qrow * DK + s * 16 + hi * 8);
#pragma unroll
    for (int m = 0; m < NMAP; ++m)
#pragma unroll
      for (int s = 0; s < KS; ++s) asm volatile("" :: "v"(qf[m][s]));
#pragma unroll 1
    for (int it = 256; it < ntile; ++it) step(it);
  }
#pragma unroll
  for (int m = 0; m < NMAP; ++m) lout[m] = xhalf(lrun[m]);
  __syncthreads();
}
DI bool lsum_bad(float l) { return !(l > 1e-18f && l < 1e18f); }
DI bool block_any(bool v, char* lds) {
  volatile LAS int* flg = (volatile LAS int*)(lds + ATT_RPB + 2032);
  if (otid() == 0) *flg = 0;
  __syncthreads();
  if (v) *flg = 1;
  __syncthreads();
  const int r = *flg;
  __syncthreads();
  return r != 0;
}

DI void attn_store(const float (&val)[2][16], bf16_t* ycat, int token, int colbase, int hi) {
#pragma unroll
  for (int d0 = 0; d0 < 2; ++d0)
#pragma unroll
    for (int g = 0; g < 4; ++g) {
      u32x2 v; v[0] = pack2(val[d0][4 * g], val[d0][4 * g + 1]); v[1] = pack2(val[d0][4 * g + 2], val[d0][4 * g + 3]);
      *(u32x2*)(ycat + (size_t)token * 1024 + colbase + d0 * 32 + 8 * g + 4 * hi) = v;
    }
}

template <int MODE>
DI void attn_diff(const Params& p, int l, int b, int h, int qb, char* lds) {
  char* ws = p.ws; asm volatile("" : "+s"(ws));
  const bf16_t* const ql[2] = {(const bf16_t*)(ws + O_QDL) + (size_t)(b * 8 + 2 * h) * SEQ * 32, (const bf16_t*)(ws + O_QDL) + (size_t)(b * 8 + 2 * h + 1) * SEQ * 32};
  const bf16_t* const qr[2] = {(const bf16_t*)(ws + O_QDR) + (size_t)(b * 8 + 2 * h) * KLEN * 32, (const bf16_t*)(ws + O_QDR) + (size_t)(b * 8 + 2 * h + 1) * KLEN * 32};
  const bf16_t* const kp[2] = {(const bf16_t*)(ws + O_KD) + (size_t)(b * 8 + 2 * h) * KLEN * 32, (const bf16_t*)(ws + O_KD) + (size_t)(b * 8 + 2 * h + 1) * KLEN * 32};
  const bf16_t* vp = (const bf16_t*)(ws + O_VD) + (size_t)(b * 4 + h) * KLEN * 64;
  float lo[2]; f32x16 o[2][2];
  attn_unit<32, 2, MODE, true>(ql, qr, kp, vp, qb, lds, lo, o, nullptr);
  if (block_any(lsum_bad(lo[0]) || lsum_bad(lo[1]), lds)) attn_unit<32, 2, MODE, false>(ql, qr, kp, vp, qb, lds, lo, o, nullptr);
  const int tid_ = otid(), lane = tid_ & 63, wid = tid_ >> 6, r32 = lane & 31, hi = lane >> 5;
  int lq = l; asm volatile("" : "+s"(lq));
  const float lam = ((const float*)(ws + O_LAMF))[lq];
  const float lam_init = 0.8f - 0.6f * expf(-0.3f * (float)lq);
  const float i0 = 1.f / lo[0], i1 = lam / lo[1];
  float d[2][16]; float ss = 0.f;
#pragma unroll
  for (int d0 = 0; d0 < 2; ++d0)
#pragma unroll
    for (int r = 0; r < 16; ++r) { d[d0][r] = o[0][d0][r] * i0 - o[1][d0][r] * i1; ss += d[d0][r] * d[d0][r]; }
  ss = xhalf(ss);
  const float rstd = rsqrtf(ss * (1.f / 64.f) + EPS) * (1.f - lam_init);
  const float* gs = p.g_diff + lq * 64;
#pragma unroll
  for (int d0 = 0; d0 < 2; ++d0)
#pragma unroll
    for (int r = 0; r < 16; ++r) d[d0][r] *= rstd * gs[d0 * 32 + crow(r, hi)];
  const int token = MODE == 2 ? NL + b * 256 + wid * 32 + r32 : b * SEQ + qb * 256 + wid * 32 + r32;
  attn_store(d, (bf16_t*)(ws + O_YCAT), token, 256 + h * 64, hi);
}
template <int MODE>
DI void attn_mla(const Params& p, int b, int h, int qb, char* lds) {
  char* ws = p.ws; asm volatile("" : "+s"(ws));
  const bf16_t* const ql[1] = {(const bf16_t*)(ws + O_QML) + (size_t)(b * 4 + h) * SEQ * 96};
  const bf16_t* const qr[1] = {(const bf16_t*)(ws + O_QMR) + (size_t)(b * 4 + h) * KLEN * 96};
  const bf16_t* const kp[1] = {(const bf16_t*)(ws + O_KM) + (size_t)(b * 4 + h) * KLEN * 96};
  const bf16_t* vp = (const bf16_t*)(ws + O_VM) + (size_t)(b * 4 + h) * KLEN * 64;
  float lo[1]; f32x16 o[1][2];
  attn_unit<96, 1, MODE, true>(ql, qr, kp, vp, qb, lds, lo, o, nullptr);
  if (block_any(lsum_bad(lo[0]), lds)) attn_unit<96, 1, MODE, false>(ql, qr, kp, vp, qb, lds, lo, o, nullptr);
  const int tid_ = otid(), lane = tid_ & 63, wid = tid_ >> 6, r32 = lane & 31, hi = lane >> 5;
  const float inv = 1.f / lo[0];
  float d[2][16];
#pragma unroll
  for (int d0 = 0; d0 < 2; ++d0)
#pragma unroll
    for (int r = 0; r < 16; ++r) d[d0][r] = o[0][d0][r] * inv;
  const int token = MODE == 2 ? NL + b * 256 + wid * 32 + r32 : b * SEQ + qb * 256 + wid * 32 + r32;
  attn_store(d, (bf16_t*)(ws + O_YCAT), token, 512 + h * 64, hi);
}
template <int MODE>
DI void attn_na(const Params& p, int l, int b, int h, int qb, char* lds) {
  char* ws = p.ws; asm volatile("" : "+s"(ws));
  float* rpbL = (float*)(lds + ATT_RPB);
  if (MODE == 1) {
    __syncthreads();
    for (int i = otid(); i < 465; i += NTHR) rpbL[i] = p.na_rpb[(size_t)(l * 4 + h) * 465 + i] * LOG2E;
    __syncthreads();
  }
  const bf16_t* const qr[1] = {(const bf16_t*)(ws + O_QN) + (size_t)(b * 4 + h) * KLEN * 64};
  const bf16_t* const kp[1] = {(const bf16_t*)(ws + O_KN) + (size_t)(b * 4 + h) * KLEN * 64};
  const bf16_t* vp = (const bf16_t*)(ws + O_VN) + (size_t)(b * 4 + h) * KLEN * 64;
  float lo[1]; f32x16 o[1][2];
  attn_unit<64, 1, MODE, true>(qr, qr, kp, vp, qb, lds, lo, o, rpbL);
  if (block_any(lsum_bad(lo[0]), lds)) attn_unit<64, 1, MODE, false>(qr, qr, kp, vp, qb, lds, lo, o, rpbL);
  const int tid_ = otid(), lane = tid_ & 63, wid = tid_ >> 6, r32 = lane & 31, hi = lane >> 5;
  const float inv = 1.f / lo[0];
  float d[2][16];
#pragma unroll
  for (int d0 = 0; d0 < 2; ++d0)
#pragma unroll
    for (int r = 0; r < 16; ++r) d[d0][r] = o[0][d0][r] * inv;
  const int token = MODE == 2 ? NL + b * 256 + wid * 32 + r32 : b * SEQ + qb * 256 + wid * 32 + r32;
  attn_store(d, (bf16_t*)(ws + O_YCAT), token, h * 64, hi);
}

DI void phase_attn(const Params& p, int l, char* lds) {
  char* ws = p.ws; asm volatile("" : "+s"(ws));
  if (blockIdx.x < 8) {
    const int id = blockIdx.x * NTHR + otid();
    const int pp = id & 63, d = (id >> 6) & 1, g = (id >> 7) & 15, b = id >> 11;
    const float2 a64 = ((const float2*)(ws + O_S5PW))[((((size_t)l * 2 + d) * 16 + g) * 65 + 64) * 64 + pp];
    const float* sloc = (const float*)(ws + O_SLOC) + ((size_t)g * 520 + b * NCHUNK) * 256 + d * 128 + pp;
    bf16_t* uc = (bf16_t*)(ws + O_UCAT) + ((size_t)g * 520 + b * NCHUNK) * 1280 + 1024 + d * 128 + pp;
    float hr = 0.f, hi_ = 0.f;
#pragma unroll 1
    for (int s0 = 0; s0 < NCHUNK; s0 += 26) {
      float sr[26], si[26];
#pragma unroll
      for (int j = 0; j < 26; ++j) { const int s = s0 + j, c = d == 0 ? s : (s < 4 ? 3 - s : 263 - s); sr[j] = sloc[(size_t)c * 256]; si[j] = sloc[(size_t)c * 256 + 64]; }
#pragma unroll
      for (int j = 0; j < 26; ++j) {
        const int s = s0 + j, c = d == 0 ? s : (s < 4 ? 3 - s : 263 - s);
        uc[(size_t)c * 1280] = f2bf(hr); uc[(size_t)c * 1280 + 64] = f2bf(hi_);
        const float nr = a64.x * hr - a64.y * hi_ + sr[j], ni = a64.x * hi_ + a64.y * hr + si[j];
        hr = nr; hi_ = ni;
      }
    }
  }
  int x = blockIdx.x & 7; asm volatile("" : "+s"(x));
  const int b = x >> 2, h = x & 3;
  int* qctr = (int*)(ws + O_QCTR) + x * 64;
  volatile LAS int* qw = (volatile LAS int*)(lds + ATT_RPB + 2040);
#pragma unroll 1
  for (;;) {
    if (otid() == 0) *qw = atomicAdd(qctr, 1);
    __syncthreads();
    const int item = *qw;
    __syncthreads();
    if (item >= 195) break;
    if (item < 64) attn_diff<0>(p, l, b, h, item, lds);
    else if (item < 128) attn_mla<0>(p, b, h, item - 64, lds);
    else if (item < 192) attn_na<1>(p, l, b, h, item - 128, lds);
    else if (item == 192) attn_diff<2>(p, l, b, h, 0, lds);
    else if (item == 193) attn_mla<2>(p, b, h, 0, lds);
    else attn_na<2>(p, l, b, h, 0, lds);
  }
}

DI void phase_s5out(const Params& p, char* lds) {
  char* ws = p.ws; asm volatile("" : "+s"(ws));
  bf16_t* G5 = (bf16_t*)(ws + O_G5);
  const UM um(48, 4);
  int gm, ntile;
  for (int k = 0; um.get(k, gm, ntile); ++k) {
    const int g = gm / 3, m0 = (gm % 3) * 256, n0 = ntile * 256;
    f32x4 acc[2][2][4][2]; zero_acc8(acc);
    asm volatile("s_waitcnt vmcnt(0)" ::: "memory");
    const bf16_t* bw = (const bf16_t*)(ws + O_S5B2) + ((size_t)g * 1024 + n0) * 1280;
    gemm8<false>(acc, (const bf16_t*)(ws + O_UCAT) + (size_t)g * 520 * 1280, nullptr, m0, bw, bw + (size_t)128 * 1280, 1280, lds);
    const int tid = otid(), lane = tid & 63, wid = tid >> 6, wr = wid >> 2, wc = wid & 3, fr = lane & 15, fq = lane >> 4, c4 = fq * 4;
#pragma unroll
    for (int ai = 0; ai < 2; ++ai)
#pragma unroll
      for (int m = 0; m < 4; ++m) {
        int row = m0 + ai * 128 + wr * 64 + m * 16 + fr; asm volatile("" : "+v"(row));
        if (row < 520) {
          const int b = row >= NCHUNK ? 1 : 0, chunk = row - b * NCHUNK;
#pragma unroll
          for (int bj = 0; bj < 2; ++bj)
#pragma unroll
            for (int n = 0; n < 2; ++n) {
              const int sp = chunk * 64 + ((n0 + bj * 128 + wc * 32) >> 4) + n;
              const int token = sp < 256 ? NL + b * 256 + sp : b * SEQ + sp - 256;
              f32x4 v = acc[ai][bj][m][n];
#pragma unroll
              for (int j = 0; j < 4; ++j) v[j] = gelu_tanh(v[j]);
              *(u32x2*)(G5 + (size_t)token * 256 + g * 16 + c4) = pack4(v);
            }
        }
      }
  }
}
DI void phase_glu(const Params& p, int l, char* lds) {
  char* ws = p.ws; asm volatile("" : "+s"(ws));
  const int tid = otid(), lane = tid & 63, wid = tid >> 6, wr = wid >> 1, wc = wid & 1, fr = lane & 15, fq = lane >> 4, c4 = fq * 4;
  const bf16_t* G5 = (const bf16_t*)(ws + O_G5);
  bf16_t* Yc = (bf16_t*)(ws + O_YCAT);
  const UM um(128, 2);
  auto job = [&](int k) { int mt, nt; return um.get(k, mt, nt) ? gj_make(G5, nullptr, 256, mt * 256, (const bf16_t*)(ws + O_WGLU), 256, nt * 128, 256) : gj_none(); };
  GStream<GNST> gs; gs.start(job(0), lds, tid);
  int mt, ntile;
  for (int k = 0; um.get(k, mt, ntile); ++k) {
    const int m0 = mt * 256, n0 = ntile * 128;
    f32x4 acc[4][4]; zero_acc(acc);
    gs.run2(acc, job(k + 1));
#pragma unroll
    for (int m = 0; m < 4; ++m) {
      const int row = m0 + wr * 64 + m * 16 + fr;
#pragma unroll
      for (int n = 0; n < 4; ++n) {
        const int col = n0 + wc * 64 + n * 16 + c4;
        const u32x2 gq = *(const u32x2*)(G5 + (size_t)row * 256 + col);
        const float4 bb = *(const float4*)(p.b_glu + l * 256 + col);
        f32x4 o;
        o[0] = __uint_as_float(gq[0] << 16) * sigm(acc[m][n][0] + bb.x);
        o[1] = __uint_as_float(gq[0] & 0xffff0000u) * sigm(acc[m][n][1] + bb.y);
        o[2] = __uint_as_float(gq[1] << 16) * sigm(acc[m][n][2] + bb.z);
        o[3] = __uint_as_float(gq[1] & 0xffff0000u) * sigm(acc[m][n][3] + bb.w);
        *(u32x2*)(Yc + (size_t)row * 1024 + 768 + col) = pack4(o);
      }
    }
  }
  {
    const int t2 = otid(), ln = t2 & 63, wv = t2 >> 6;
    for (int w = blockIdx.x * 8 + wv; w < 512; w += gridDim.x * 8) {
      const int row0 = NL + (w >> 4) * 16, col = (w & 15) * 16 + (ln & 15);
      f32x4 a4 = f32x4{0.f, 0.f, 0.f, 0.f};
      mini_gemm16(a4, G5 + (size_t)row0 * 256, 256, (const bf16_t*)(ws + O_WGLU) + (size_t)(w & 15) * 16 * 256, 256, 256, ln);
      const float bb = p.b_glu[l * 256 + col];
#pragma unroll
      for (int j = 0; j < 4; ++j) {
        const int row = row0 + 4 * (ln >> 4) + j;
        Yc[(size_t)row * 1024 + 768 + col] = f2bf(bf2f(G5[(size_t)row * 256 + col]) * sigm(a4[j] + bb));
      }
    }
  }
}
DI void phase_merge(const Params& p, char* lds) {
  char* ws = p.ws; asm volatile("" : "+s"(ws));
  const int tid = otid(), lane = tid & 63, wid = tid >> 6, wr = wid >> 1, wc = wid & 1, fr = lane & 15, fq = lane >> 4, c4 = fq * 4;
  bf16_t* Mb = (bf16_t*)(ws + O_MBUF);
  const UM um(128, 8);
  auto job = [&](int seq) {
    const int i = (seq >> 1) & 3; int mt_, nt_;
    if (!um.get(seq >> 3, mt_, nt_)) return gj_none();
    const int m0 = mt_ * 256, n0 = nt_ * 128;
    if (seq & 1) return gj_make((const bf16_t*)(ws + O_H1), nullptr, 1024, m0, (const bf16_t*)(ws + O_WG) + (size_t)i * 1024 * 1024, 1024, n0, 1024);
    return gj_make((const bf16_t*)(ws + O_YCAT) + i * 256, nullptr, 1024, m0, (const bf16_t*)(ws + O_WBR) + (size_t)i * 262144, 256, n0, 256);
  };
  GStream<GNST> gs; gs.start(job(0), lds, tid);
  int seq = 0, mt, ntile;
  for (int k = 0; um.get(k, mt, ntile); ++k) {
    const int m0 = mt * 256, n0 = ntile * 128;
    u32x2 mpk[4][4];
    for (int i = 0; i < 4; ++i) {
      u32x2 pk[4][4];
      {
        f32x4 acc[4][4]; zero_acc(acc);
        gs.run<true>(acc, job(seq + 1)); ++seq;
#pragma unroll
        for (int m = 0; m < 4; ++m)
#pragma unroll
          for (int n = 0; n < 4; ++n) pk[m][n] = pack4(acc[m][n]);
      }
      f32x4 acc[4][4]; zero_acc(acc);
      gs.run<true>(acc, job(seq + 1)); ++seq;
#pragma unroll
      for (int m = 0; m < 4; ++m)
#pragma unroll
        for (int n = 0; n < 4; ++n) {
          f32x4 t;
          t[0] = sigm(acc[m][n][0]) * __uint_as_float(pk[m][n][0] << 16);
          t[1] = sigm(acc[m][n][1]) * __uint_as_float(pk[m][n][0] & 0xffff0000u);
          t[2] = sigm(acc[m][n][2]) * __uint_as_float(pk[m][n][1] << 16);
          t[3] = sigm(acc[m][n][3]) * __uint_as_float(pk[m][n][1] & 0xffff0000u);
          if (i > 0) {
            t[0] += __uint_as_float(mpk[m][n][0] << 16); t[1] += __uint_as_float(mpk[m][n][0] & 0xffff0000u);
            t[2] += __uint_as_float(mpk[m][n][1] << 16); t[3] += __uint_as_float(mpk[m][n][1] & 0xffff0000u);
          }
          mpk[m][n] = pack4(t);
        }
    }
#pragma unroll
    for (int m = 0; m < 4; ++m) {
      const int row = m0 + wr * 64 + m * 16 + fr;
#pragma unroll
      for (int n = 0; n < 4; ++n) *(u32x2*)(Mb + (size_t)row * 1024 + n0 + wc * 64 + n * 16 + c4) = mpk[m][n];
    }
  }
  {
    const int t2 = otid(), lane = t2 & 63, wid = t2 >> 6;
    for (int w = blockIdx.x * 8 + wid; w < 2048; w += gridDim.x * 8) {
      const int row0 = NL + (w >> 6) * 16, col0 = (w & 63) * 16;
      f32x4 macc = f32x4{0.f, 0.f, 0.f, 0.f};
      for (int i = 0; i < 4; ++i) {
        f32x4 ab = f32x4{0.f, 0.f, 0.f, 0.f}, ag = f32x4{0.f, 0.f, 0.f, 0.f};
        mini_gemm16(ab, (const bf16_t*)(ws + O_YCAT) + (size_t)row0 * 1024 + i * 256, 1024, (const bf16_t*)(ws + O_WBR) + (size_t)i * 262144 + (size_t)col0 * 256, 256, 256, lane);
        mini_gemm16(ag, (const bf16_t*)(ws + O_H1) + (size_t)row0 * 1024, 1024, (const bf16_t*)(ws + O_WG) + ((size_t)i * 1024 + col0) * 1024, 1024, 1024, lane);
#pragma unroll
        for (int j = 0; j < 4; ++j) macc[j] += sigm(ag[j]) * ab[j];
      }
#pragma unroll
      for (int j = 0; j < 4; ++j) Mb[(size_t)(row0 + 4 * (lane >> 4) + j) * 1024 + col0 + (lane & 15)] = f2bf(macc[j]);
    }
  }
}
DI void phase_outproj(const Params& p, int l, char* lds, float rscale = 1.f) {
  char* ws = p.ws; asm volatile("" : "+s"(ws));
  bf16_t* X = (bf16_t*)(ws + O_X);
  const float* ada = (const float*)(ws + O_ADA);
  const UM um(128, 4);
  int mt, ntile;
  for (int k = 0; um.get(k, mt, ntile); ++k) {
    const int m0 = mt * 256, n0 = ntile * 256;
    f32x4 acc[2][2][4][2]; zero_acc8(acc);
    asm volatile("s_waitcnt vmcnt(0)" ::: "memory");
    gemm8<false>(acc, (const bf16_t*)(ws + O_MBUF), nullptr, m0, (const bf16_t*)(ws + O_WOUT) + (size_t)n0 * 1024, (const bf16_t*)(ws + O_WOUT) + (size_t)(n0 + 128) * 1024, 1024, lds);
    const int tid = otid(), lane = tid & 63, wid = tid >> 6, wr = wid >> 2, wc = wid & 3, fr = lane & 15, fq = lane >> 4;
#pragma unroll
    for (int ai = 0; ai < 2; ++ai)
#pragma unroll
      for (int m = 0; m < 4; ++m) {
        const int row = m0 + ai * 128 + wr * 64 + m * 16 + fr;
        const int cv = row < NL ? (row >> 14) : 2;
        const float* gt = ada + (l * 3 + cv) * 6144 + 2 * 1024;
#pragma unroll
        for (int bj = 0; bj < 2; ++bj)
#pragma unroll
          for (int n = 0; n < 2; ++n) {
            const int col = n0 + bj * 128 + wc * 32 + n * 16 + fq * 4;
            u32x2* xp = (u32x2*)(X + (size_t)row * 1024 + col);
            const float4 g = *(const float4*)(gt + col);
            const u32x2 xo = *xp;
            const f32x4 av = acc[ai][bj][m][n];
            u32x2 xn;
            xn[0] = pack2(__uint_as_float(xo[0] << 16) + rscale * g.x * av[0], __uint_as_float(xo[0] & 0xffff0000u) + rscale * g.y * av[1]);
            xn[1] = pack2(__uint_as_float(xo[1] << 16) + rscale * g.z * av[2], __uint_as_float(xo[1] & 0xffff0000u) + rscale * g.w * av[3]);
            *xp = xn;
          }
      }
  }
  const int tid = otid(), lane = tid & 63, wid = tid >> 6;
  (void)lane; (void)wid;
  {
    const int t2 = otid(), lane = t2 & 63, wid = t2 >> 6;
    for (int w = blockIdx.x * 8 + wid; w < 2048; w += gridDim.x * 8) {
      const int row0 = NL + (w >> 6) * 16, col0 = (w & 63) * 16;
      f32x4 acc = f32x4{0.f, 0.f, 0.f, 0.f};
      mini_gemm16(acc, (const bf16_t*)(ws + O_MBUF) + (size_t)row0 * 1024, 1024, (const bf16_t*)(ws + O_WOUT) + (size_t)col0 * 1024, 1024, 1024, lane);
      const float g = ada[(l * 3 + 2) * 6144 + 2 * 1024 + col0 + (lane & 15)];
#pragma unroll
      for (int j = 0; j < 4; ++j) { bf16_t* xp = X + (size_t)(row0 + 4 * (lane >> 4) + j) * 1024 + col0 + (lane & 15); *xp = f2bf(bf2f(*xp) + rscale * g * acc[j]); }
    }
  }
}
DI void phase_norm2(const Params& p, int l, char* lds) {
  char* ws = p.ws; asm volatile("" : "+s"(ws));
  const int tid = otid(), lane = tid & 63, w = tid >> 6, fr = lane & 15, fq = lane >> 4;
  const bf16_t* X = (const bf16_t*)(ws + O_X);
  bf16_t* H2 = (bf16_t*)(ws + O_H2);
  const float* ada = (const float*)(ws + O_ADA);
  float* ssq = (float*)lds;
  float* red = (float*)(lds + 1024);
  int* lcnt = (int*)(lds + 35840);
  int* lbase = lcnt + 64;
  float* lgt = (float*)(lds + 36864);
  int* IDX = (int*)(ws + O_IDX); float* GW = (float*)(ws + O_GW); int* RANK = (int*)(ws + O_SLOT);
  if (tid < 64) lcnt[tid] = 0;
  const float eb = p.e_bias[l * 64 + lane];
  float* tabG = (float*)(lds + 40960);
  float* tabS = tabG + 3072;
  for (int i = tid; i < 3072; i += NTHR) {
    const int cv_ = i >> 10, k_ = i & 1023;
    const float* a_ = ada + (l * 3 + cv_) * 6144 + 3 * 1024 + k_;
    tabG[i] = p.g_norm2[l * 1024 + k_] * (1.f + a_[1024]); tabS[i] = a_[0];
  }
  __syncthreads();
  const int kb = w * 128 + fq * 8;
  bf16x8 bh[4][4], bl[4][4];
#pragma unroll
  for (int e = 0; e < 4; ++e)
#pragma unroll
    for (int s_ = 0; s_ < 4; ++s_) {
      const size_t off = (size_t)(e * 16 + fr) * 1024 + kb + s_ * 32;
      bh[e][s_] = *(const bf16x8*)((const bf16_t*)(ws + O_WRHI) + off);
      bl[e][s_] = *(const bf16x8*)((const bf16_t*)(ws + O_WRLO) + off);
    }
  const int ng = NTOK / 16;
  u32x4 xn[4];
  if ((int)blockIdx.x < ng) {
#pragma unroll
    for (int s_ = 0; s_ < 4; ++s_) xn[s_] = *(const u32x4*)(X + (size_t)(blockIdx.x * 16 + fr) * 1024 + kb + s_ * 32);
  }
#pragma unroll 1
  for (int gi = blockIdx.x; gi < ng; gi += gridDim.x) {
    const int row0 = gi * 16, row = row0 + fr, cv = row0 < NL ? (row0 >> 14) : 2;
    u32x4 xr[4];
#pragma unroll
    for (int s_ = 0; s_ < 4; ++s_) xr[s_] = xn[s_];
    if (gi + (int)gridDim.x < ng) {
#pragma unroll
      for (int s_ = 0; s_ < 4; ++s_) xn[s_] = *(const u32x4*)(X + (size_t)((gi + gridDim.x) * 16 + fr) * 1024 + kb + s_ * 32);
    }
    float ss = 0.f;
#pragma unroll
    for (int s_ = 0; s_ < 4; ++s_)
#pragma unroll
      for (int j = 0; j < 4; ++j) { const float a0 = __uint_as_float(xr[s_][j] << 16), a1 = __uint_as_float(xr[s_][j] & 0xffff0000u); ss += a0 * a0; ss += a1 * a1; }
    ss = xhalf(ss); ss += bperm(ss, lane ^ 16);
    if (fq == 0) ssq[w * 16 + fr] = ss;
    __syncthreads();
    float tot = 0.f;
#pragma unroll
    for (int w2 = 0; w2 < 8; ++w2) tot += ssq[w2 * 16 + fr];
    const float rstd = rsqrtf(tot * (1.f / 1024.f) + EPS);
    const float* gn = tabG + cv * 1024 + kb;
    const float* sh = tabS + cv * 1024 + kb;
    f32x4 acc[4];
#pragma unroll
    for (int e = 0; e < 4; ++e) acc[e] = f32x4{0.f, 0.f, 0.f, 0.f};
#pragma unroll
    for (int s_ = 0; s_ < 4; ++s_) {
      u32x4 ahi, alo;
#pragma unroll
      for (int q = 0; q < 2; ++q) {
        const float4 g = *(const float4*)(gn + s_ * 32 + q * 4), s1 = *(const float4*)(sh + s_ * 32 + q * 4);
        const unsigned u0 = xr[s_][q * 2], u1 = xr[s_][q * 2 + 1];
        const float h0 = __uint_as_float(u0 << 16) * rstd * g.x + s1.x, h1 = __uint_as_float(u0 & 0xffff0000u) * rstd * g.y + s1.y;
        const float h2 = __uint_as_float(u1 << 16) * rstd * g.z + s1.z, h3 = __uint_as_float(u1 & 0xffff0000u) * rstd * g.w + s1.w;
        const unsigned p0 = pack2(h0, h1), p1 = pack2(h2, h3);
        ahi[q * 2] = p0; ahi[q * 2 + 1] = p1;
        alo[q * 2] = pack2(h0 - __uint_as_float(p0 << 16), h1 - __uint_as_float(p0 & 0xffff0000u));
        alo[q * 2 + 1] = pack2(h2 - __uint_as_float(p1 << 16), h3 - __uint_as_float(p1 & 0xffff0000u));
      }
      *(u32x4*)(H2 + (size_t)row * 1024 + kb + s_ * 32) = ahi;
      const bf16x8 fh = __builtin_bit_cast(bf16x8, ahi), fl = __builtin_bit_cast(bf16x8, alo);
#pragma unroll
      for (int e = 0; e < 4; ++e) { acc[e] = MFMA16(fh, bh[e][s_], acc[e]); acc[e] = MFMA16(fl, bh[e][s_], acc[e]); acc[e] = MFMA16(fh, bl[e][s_], acc[e]); }
    }
#pragma unroll
    for (int e = 0; e < 4; ++e) *(f32x4*)(red + ((w * 4 + e) * 64 + lane) * 4) = acc[e];
    __syncthreads();
    if (tid < 256) {
      const int e = tid >> 6, ln = tid & 63;
      f32x4 sum = *(const f32x4*)(red + (e * 64 + ln) * 4);
#pragma unroll
      for (int w2 = 1; w2 < 8; ++w2) sum += *(const f32x4*)(red + ((w2 * 4 + e) * 64 + ln) * 4);
#pragma unroll
      for (int j = 0; j < 4; ++j) lgt[((ln >> 4) * 4 + j) * 64 + e * 16 + (ln & 15)] = sum[j];
    }
    __syncthreads();
    {
      float score[2], sel[2], gsum[2]; int myk[2];
#pragma unroll
      for (int r = 0; r < 2; ++r) { score[r] = sigm(lgt[(2 * w + r) * 64 + lane]); sel[r] = score[r] + eb; gsum[r] = 0.f; myk[r] = -1; }
#pragma unroll
      for (int k = 0; k < 6; ++k) {
        float mx[2] = {sel[0], sel[1]};
#pragma unroll
        for (int o = 16; o > 0; o >>= 1)
#pragma unroll
          for (int r = 0; r < 2; ++r) mx[r] = fmaxf(mx[r], bperm(mx[r], lane ^ o));
        int win[2];
#pragma unroll
        for (int r = 0; r < 2; ++r) { mx[r] = xhalf_max(mx[r]); const unsigned long long bal = __ballot(sel[r] == mx[r]); win[r] = __ffsll((long long)bal) - 1; }
#pragma unroll
        for (int r = 0; r < 2; ++r) { gsum[r] += bperm(score[r], win[r]); if (lane == win[r]) { sel[r] = -1e30f; myk[r] = k; } }
      }
#pragma unroll
      for (int r = 0; r < 2; ++r) {
        const int trow = row0 + 2 * w + r;
        if (myk[r] >= 0) {
          const int lr = atomicAdd(&lcnt[lane], 1);
          IDX[trow * 6 + myk[r]] = lane; GW[trow * 6 + myk[r]] = score[r] / gsum[r]; RANK[trow * 6 + myk[r]] = lr;
        }
      }
    }
  }
  __syncthreads();
  if (tid < 64) lbase[tid] = atomicAdd((int*)(ws + O_CNT) + tid, lcnt[tid]);
  __syncthreads();
  for (int gi = blockIdx.x; gi < ng; gi += gridDim.x)
    for (int i = tid; i < 96; i += NTHR) { const int q = gi * 96 + i; RANK[q] += lbase[IDX[q]]; }
}
DI void phase_topk(const Params& p, int l, char* lds) {
  char* ws = p.ws; asm volatile("" : "+s"(ws));
  const int tid = otid(), lane = tid & 63, wid = tid >> 6;
  int* lcnt = (int*)lds;
  int* lbase = lcnt + 64;
  const float* LG = (const float*)(ws + O_LOGIT);
  int* IDX = (int*)(ws + O_IDX); float* GW = (float*)(ws + O_GW); int* RANK = (int*)(ws + O_SLOT);
  if (tid < 64) lcnt[tid] = 0;
  __syncthreads();
  const int rows_per = (NTOK + gridDim.x - 1) / gridDim.x;
  const int r0 = blockIdx.x * rows_per, r1 = min(NTOK, r0 + rows_per);
  const float eb = p.e_bias[l * 64 + lane];
  float lgv[17];
#pragma unroll
  for (int i = 0; i < 17; ++i) { const int row = r0 + wid + i * 8; lgv[i] = row < r1 ? LG[(size_t)row * 64 + lane] : 0.f; }
#pragma unroll
  for (int i = 0; i < 17; ++i) {
    const int row = r0 + wid + i * 8;
    if (row >= r1) break;
    const float score = sigm(lgv[i]);
    float sel = score + eb;
    float gsum = 0.f; int myk = -1;
    for (int k = 0; k < 6; ++k) {
      const float mx = wave_max(sel, lane);
      const unsigned long long bal = __ballot(sel == mx);
      const int win = __ffsll((long long)bal) - 1;
      const float sc_w = bperm(score, win);
      gsum += sc_w;
      if (lane == win) { sel = -1e30f; myk = k; }
    }
    if (myk >= 0) {
      const int lr = atomicAdd(&lcnt[lane], 1);
      IDX[row * 6 + myk] = lane; GW[row * 6 + myk] = score / gsum; RANK[row * 6 + myk] = lr;
    }
  }
  __syncthreads();
  if (tid < 64) lbase[tid] = atomicAdd((int*)(ws + O_CNT) + tid, lcnt[tid]);
  __syncthreads();
  for (int i = r0 * 6 + tid; i < r1 * 6; i += NTHR) RANK[i] += lbase[IDX[i]];
}

DI void phase_lists(const Params& p, char* lds) {
  char* ws = p.ws; asm volatile("" : "+s"(ws));
  const int tid = otid();
  int* poff = (int*)lds;
  const int* cnt = (const int*)(ws + O_CNT);
  if (tid == 0) { int a = 0; for (int e = 0; e < 64; ++e) { poff[e] = a; a += (cnt[e] + 255) & ~255; } poff[64] = a; }
  __syncthreads();
  int* SLOT = (int*)(ws + O_SLOT); const int* IDX = (const int*)(ws + O_IDX); int* ROWIDX = (int*)(ws + O_ROWIDX);
  for (int i = blockIdx.x * NTHR + tid; i < NTOK * 6; i += gridDim.x * NTHR) {
    const int s = poff[IDX[i]] + SLOT[i];
    SLOT[i] = s; ROWIDX[s] = i / 6;
  }
  for (int e = blockIdx.x; e < 64; e += gridDim.x) {
    const int c = cnt[e], pc = (c + 255) & ~255;
    for (int s = c + tid; s < pc; s += NTHR) ROWIDX[poff[e] + s] = 0;
  }
  for (int t = blockIdx.x * NTHR + tid; t < NTOK; t += gridDim.x * NTHR) ROWIDX[poff[64] + t] = t;
}
DI int find_expert(const int* poff, int slot0) { int e = 0; for (int i = 1; i < 64; ++i) e = (poff[i] <= slot0) ? i : e; return e; }

DI void phase_moe1(const Params& p, char* lds) {
  char* ws = p.ws; asm volatile("" : "+s"(ws));
  int* poff = (int*)(lds + LDS_POFF);
  {
    const int tid = otid();
    const int* cnt = (const int*)(ws + O_CNT);
    if (tid == 0) { int a = 0; for (int e = 0; e < 64; ++e) { poff[e] = a; a += (cnt[e] + 255) & ~255; } poff[64] = a; }
    __syncthreads();
  }
  const int TR = poff[64] >> 8;
  bf16_t* ACT = (bf16_t*)(ws + O_ACT);
  const bf16_t* H2 = (const bf16_t*)(ws + O_H2);
  const UM um(TR + 130, 2);
  int ti, ntile;
  for (int k = 0; um.get(k, ti, ntile); ++k) {
    const int f0 = ntile * 128, slot0 = ti * 256;
    const int e = ti < TR ? find_expert(poff, slot0) : 64;
    f32x4 acc[2][2][4][2]; zero_acc8(acc);
    asm volatile("s_waitcnt vmcnt(0)" ::: "memory");
    gemm8<true>(acc, H2, (const int*)(ws + O_ROWIDX), slot0, (const bf16_t*)(ws + O_WE1) + (size_t)e * 262144 + (size_t)f0 * 1024, (const bf16_t*)(ws + O_WE3) + (size_t)e * 262144 + (size_t)f0 * 1024, 1024, lds);
    const int tid = otid(), lane = tid & 63, wid = tid >> 6, wr = wid >> 2, wc = wid & 3, fr = lane & 15, fq = lane >> 4;
#pragma unroll
    for (int ai = 0; ai < 2; ++ai)
#pragma unroll
      for (int m = 0; m < 4; ++m) {
        const int row = slot0 + ai * 128 + wr * 64 + m * 16 + fr;
#pragma unroll
        for (int n = 0; n < 2; ++n) {
          const f32x4 g = acc[ai][0][m][n], u = acc[ai][1][m][n];
          f32x4 o;
#pragma unroll
          for (int j = 0; j < 4; ++j) o[j] = g[j] * sigm(g[j]) * u[j];
          *(u32x2*)(ACT + (size_t)row * 256 + f0 + wc * 32 + n * 16 + fq * 4) = pack4(o);
        }
      }
  }
}
DI void phase_moe2(const Params& p, char* lds) {
  char* ws = p.ws; asm volatile("" : "+s"(ws));
  const int tid = otid(), lane = tid & 63, wid = tid >> 6, wr = wid >> 1, wc = wid & 1, fr = lane & 15, fq = lane >> 4;
  int* poff = (int*)(lds + LDS_POFF);
  const int* cnt = (const int*)(ws + O_CNT);
  if (tid == 0) { int a = 0; for (int e = 0; e < 64; ++e) { poff[e] = a; a += (cnt[e] + 255) & ~255; } poff[64] = a; }
  __syncthreads();
  const int TR = poff[64] >> 8;
  const bf16_t* ACT = (const bf16_t*)(ws + O_ACT);
  unsigned char* Y = (unsigned char*)(ws + O_R);
  const UM um(TR + 130, 4);
  auto job = [&](int k) {
    int ti, nt_;
    if (!um.get(k, ti, nt_)) return gj_none();
    const int slot0 = ti * 256, e = ti < TR ? find_expert(poff, slot0) : 64;
    return gj_make(ACT, nullptr, 256, slot0, (const bf16_t*)(ws + O_WE2) + (size_t)e * 262144, 256, nt_ * 256, 256);
  };
  GStreamW gs; gs.start(job(0), lds, tid);
  int ti, ntile;
  for (int k = 0; um.get(k, ti, ntile); ++k) {
    const int n0 = ntile * 256, slot0 = ti * 256;
    f32x4 acc[4][8]; zero_accw(acc);
    gs.run(acc, job(k + 1));
    if (ti >= TR) {
      bf16_t* Ysh = (bf16_t*)(ws + O_R + (size_t)YROWS * 1024);
#pragma unroll
      for (int m = 0; m < 4; ++m) {
        const int row = (ti - TR) * 256 + wr * 64 + m * 16 + fr;
#pragma unroll
        for (int n = 0; n < 8; ++n) *(u32x2*)(Ysh + (size_t)row * 1024 + n0 + wc * 128 + n * 16 + fq * 4) = pack4(acc[m][n]);
      }
    } else
#pragma unroll
    for (int m = 0; m < 4; ++m) {
      const int row = slot0 + wr * 64 + m * 16 + fr;
#pragma unroll
      for (int hf = 0; hf < 2; ++hf) {
        unsigned a[4];
#pragma unroll
        for (int n = 0; n < 4; ++n) {
          const f32x4 v = acc[m][hf * 4 + n];
          const float q0 = __builtin_amdgcn_fmed3f(v[0] * 16.f, -448.f, 448.f), q1 = __builtin_amdgcn_fmed3f(v[1] * 16.f, -448.f, 448.f);
          const float q2 = __builtin_amdgcn_fmed3f(v[2] * 16.f, -448.f, 448.f), q3 = __builtin_amdgcn_fmed3f(v[3] * 16.f, -448.f, 448.f);
          int w = __builtin_amdgcn_cvt_pk_fp8_f32(q0, q1, 0, false);
          w = __builtin_amdgcn_cvt_pk_fp8_f32(q2, q3, w, true);
          a[n] = (unsigned)w;
        }
        const auto r01 = __builtin_amdgcn_permlane16_swap(a[0], a[1], false, false);
        const auto r23 = __builtin_amdgcn_permlane16_swap(a[2], a[3], false, false);
        const auto s02 = __builtin_amdgcn_permlane32_swap(r01[0], r23[0], false, false);
        const auto s13 = __builtin_amdgcn_permlane32_swap(r01[1], r23[1], false, false);
        *(u32x4*)(Y + (size_t)row * 1024 + n0 + wc * 128 + hf * 64 + fq * 16) = u32x4{s02[0], s13[0], s02[1], s13[1]};
      }
    }
  }
}

#define XB_TMO      128
#define XB_XCNT(j)  (256  + 64 * (j))
#define XB_XSUB(j)  (1280 + 64 * (j))
#define XB_XGEN(j)  (2304 + 64 * (j))
#define XB_TOP      3328
#define XB_TOPGEN   3392
#define XCD_BAR_WORDS 3456
#define XB_SPIN_CAP (1u << 21)
__device__ __forceinline__ unsigned xb_ld(unsigned* p)              { return __hip_atomic_load(p, __ATOMIC_RELAXED, __HIP_MEMORY_SCOPE_AGENT); }
__device__ __forceinline__ unsigned xb_add(unsigned* p, unsigned v) { return __hip_atomic_fetch_add(p, v, __ATOMIC_RELAXED, __HIP_MEMORY_SCOPE_AGENT); }
__device__ __forceinline__ unsigned xb_xcc_id() { return (unsigned)__builtin_amdgcn_s_getreg((3 << 11) | 20) & 0xFu; }
#define XB_SPIN(cond, bar) do { unsigned _sp = 0; while (cond) { __builtin_amdgcn_s_sleep(1); \
    if ((++_sp & 255u) == 0u) { if (xb_ld(&(bar)[XB_TMO])) break; if (_sp > XB_SPIN_CAP) { atomicAdd(&(bar)[XB_TMO], 1u); break; } } } } while (0)
struct XcdBarrier { unsigned* bar; unsigned x; volatile LAS unsigned* st; };
__device__ __forceinline__ XcdBarrier xcd_barrier_post(unsigned* bar, volatile LAS unsigned* st) {
    XcdBarrier b; b.bar = bar; b.x = xb_xcc_id(); b.st = st;
    if (threadIdx.x == 0) (void)xb_add(&bar[XB_XCNT(b.x)], 1u);
    return b;
}
__device__ __forceinline__ void xcd_barrier_complete(unsigned* bar, unsigned x, unsigned& nloc, unsigned& nx) {
    const unsigned G = gridDim.x * gridDim.y * gridDim.z;
    unsigned sum, cnt, mine, sp = 0u;
    for (;;) {
        sum = 0u; cnt = 0u; mine = 0u;
#pragma unroll
        for (unsigned j = 0; j < 16; ++j) { const unsigned c = xb_ld(&bar[XB_XCNT(j)]); sum += c; cnt += (c > 0u) ? 1u : 0u; mine = (j == x) ? c : mine; }
        if (sum == G) break;
        __builtin_amdgcn_s_sleep(1);
        if ((++sp & 255u) == 0u) { if (xb_ld(&bar[XB_TMO])) break; if (sp > XB_SPIN_CAP) { atomicAdd(&bar[XB_TMO], 1u); break; } }
    }
    nloc = mine > 0u ? mine : 1u; nx = cnt > 0u ? cnt : 1u;
}
__device__ __forceinline__ void xcd_barrier(const XcdBarrier& b) {
    asm volatile("s_waitcnt vmcnt(0)" ::: "memory");
    __syncthreads();
    if (threadIdx.x == 0) {
        unsigned* bar = b.bar;
        __builtin_amdgcn_s_waitcnt(0);
        unsigned nloc = b.st[0], nx = b.st[1];
        if (nloc == 0u) { xcd_barrier_complete(bar, b.x, nloc, nx); b.st[0] = nloc; b.st[1] = nx; }
        const unsigned old = xb_add(&bar[XB_XSUB(b.x)], 1u);
        const unsigned gen = old / nloc;
        if (old + 1u == (gen + 1u) * nloc) {
            __builtin_amdgcn_fence(__ATOMIC_RELEASE, "agent");
            asm volatile("s_waitcnt vmcnt(0)" ::: "memory");
            const unsigned og = xb_add(&bar[XB_TOP], 1u);
            const unsigned tg = og / nx;
            if (og + 1u == (tg + 1u) * nx) xb_add(&bar[XB_TOPGEN], 1u);
            else XB_SPIN(xb_ld(&bar[XB_TOPGEN]) == tg, bar);
            __builtin_amdgcn_fence(__ATOMIC_ACQUIRE, "agent");
            xb_add(&bar[XB_XGEN(b.x)], 1u);
            asm volatile("s_waitcnt vmcnt(0)" ::: "memory");
        } else {
            XB_SPIN(xb_ld(&bar[XB_XGEN(b.x)]) == gen, bar);
            __builtin_amdgcn_fence(__ATOMIC_ACQUIRE, "agent");
            asm volatile("s_waitcnt vmcnt(0)" ::: "memory");
        }
    }
    __syncthreads();
}

__global__ void __launch_bounds__(NTHR, 2) k_mega(Params_ p_unused) {
#define p (*kargs())
  extern __shared__ __attribute__((aligned(16))) char lds[];
  uint4* xbw = (uint4*)(lds + LDS_BYTES);
  if (threadIdx.x == 0) *xbw = make_uint4(0u, 0u, 0u, 0u);
  __syncthreads();
  (void)xcd_barrier_post((unsigned*)(p.ws + O_BAR), (volatile LAS unsigned*)xbw);
#define GRID_BAR() do { XcdBarrier b_; unsigned long long bp_ = (unsigned long long)(p.ws + O_BAR); asm volatile("" : "+s"(bp_)); b_.bar = (unsigned*)bp_; b_.x = xb_xcc_id(); b_.st = (volatile LAS unsigned*)(lds + LDS_BYTES); xcd_barrier(b_); } while (0)
#if PROBE_GROUP
#define REPS(g) int reps_ = 1 + ((g) == PROBE_GROUP ? 1 : 0); asm volatile("" : "+s"(reps_)); _Pragma("unroll 1") for (int r_ = 0; r_ < reps_; ++r_)
#define RSC (r_ == 0 ? 1.f : 0.f)
#else
#define REPS(g)
#define RSC 1.f
#endif
  { REPS(11) { phase_p0(p, lds); GRID_BAR(); phase_p1(p); GRID_BAR(); } }
  for (int l = 0; l < DEPTH; ++l) {
    { REPS(1) { phase_rows(p, l, RSC); } }
    { REPS(10) { phase_prep(p, l, lds); GRID_BAR(); } }
    if (blockIdx.x == 0) { const int t_ = otid(); if (t_ < 64) ((int*)(p.ws + O_CNT))[t_] = 0; if (t_ < 8) ((int*)(p.ws + O_QCTR))[t_ * 64] = 0; }
    phase_proj(p, lds); GRID_BAR(); phase_up(p, lds); GRID_BAR();
    phase_attn(p, l, lds); GRID_BAR();
    { REPS(4) { phase_s5out(p, lds); GRID_BAR(); phase_glu(p, l, lds); GRID_BAR(); } }
    { REPS(5) { phase_merge(p, lds); GRID_BAR(); } }
    { REPS(6) { phase_outproj(p, l, lds, RSC); GRID_BAR(); } }
    { REPS(7) { phase_norm2(p, l, lds); GRID_BAR(); } }
    { REPS(12) {
#if PROBE_GROUP == 12
      if (r_ > 0) { if (blockIdx.x == 0) { const int t_ = otid(); if (t_ < 64) ((int*)(p.ws + O_CNT))[t_] = 0; } GRID_BAR(); }
#endif
      phase_lists(p, lds); GRID_BAR(); } }
    { REPS(8) { phase_moe1(p, lds); GRID_BAR(); } }
    { REPS(9) { phase_moe2(p, lds); GRID_BAR(); } }
  }
  phase_rows(p, DEPTH);
#undef p
}

extern "C" void kernel_launch(void* const* d_in, const int* in_sizes, int n_in, void* d_out, int out_size, void* d_ws, size_t ws_size, hipStream_t stream) {
  if (ws_size < WS_NEED) { fprintf(stderr, "workspace too small: %zu < %zu\n", ws_size, (size_t)WS_NEED); return; }
  Params_ p{};
  const float** pp = (const float**)&p;
  for (int i = 0; i < 37; ++i) pp[i] = (const float*)d_in[i];
  p.out = (float*)d_out; p.ws = (char*)d_ws;
  constexpr int kDynLds = LDS_TOTAL;
  static int grid = 0;
  if (!grid) {
    int dev = 0, cus = 0, per_cu = 0;
    hipGetDevice(&dev);
    hipDeviceGetAttribute(&cus, hipDeviceAttributeMultiprocessorCount, dev);
    hipFuncSetAttribute((const void*)k_mega, hipFuncAttributeMaxDynamicSharedMemorySize, kDynLds);
    hipOccupancyMaxActiveBlocksPerMultiprocessor(&per_cu, (const void*)k_mega, NTHR, kDynLds);
    grid = cus * (per_cu < 1 ? per_cu : 1);
    if (grid > 256) grid = 256;
  }
  if (grid <= 0) { fprintf(stderr, "k_mega does not fit\n"); return; }
  hipMemsetAsync((char*)d_ws + O_BAR, 0, 16384, stream);
  hipLaunchKernelGGL(k_mega, dim3(grid), dim3(NTHR), kDynLds, stream, p);
}
```

```cpp
#include <hip/hip_runtime.h>
#include <stdint.h>
#include <stdio.h>
#ifndef PROBE_GROUP
#define PROBE_GROUP 0
#endif

#define DI __device__ __forceinline__
#define LAS __attribute__((address_space(3)))
typedef unsigned short bf16_t;
using bf16x8 = __attribute__((ext_vector_type(8))) short;
using s16x4 = __attribute__((ext_vector_type(4))) short;
using f32x4 = __attribute__((ext_vector_type(4))) float;
using f32x16 = __attribute__((ext_vector_type(16))) float;
using u32x4 = __attribute__((ext_vector_type(4))) unsigned;
using u32x2 = __attribute__((ext_vector_type(2))) unsigned;
typedef __bf16 bf2_t __attribute__((ext_vector_type(2)));
typedef float fl2_t __attribute__((ext_vector_type(2)));
typedef short v4i16_t __attribute__((ext_vector_type(4)));

constexpr int NL = 32768, NC = 512, NTOK = 33280, DM = 1024, SEQ = 16384, CTXL = 256, KLEN = 16640, DEPTH = 4;
constexpr int INW = 6304, NTHR = 512;
constexpr int NCHUNK = 260;
constexpr int YROWS = 216064 + 33280;
constexpr float LOG2E = 1.4426950408889634f;
constexpr float NA_QS = 0.125f * LOG2E;
constexpr float DIFF_QS = 0.17677669529663687f * LOG2E;
constexpr float MLA_QS = 0.10206207261596577f * LOG2E;
constexpr float EPS = 1e-6f;

constexpr size_t O_BAR = 0;
constexpr size_t O_TP = O_BAR + 14336;
constexpr size_t O_CNT = O_BAR + 16384;
constexpr size_t O_QCTR = O_CNT + 1024;
constexpr size_t O_LAMF = O_QCTR + 2048;
constexpr size_t O_ADA = O_LAMF + 256;
constexpr size_t O_ROPER = O_ADA + 294912;
constexpr size_t O_ROPEC = O_ROPER + 16384;
constexpr size_t O_S5PW = O_ROPEC + 4096;
constexpr size_t O_S5BB = O_S5PW + 4259840;
constexpr size_t O_S5K = O_S5BB + 1048576;
constexpr size_t O_X = O_S5K + 8388608;
constexpr size_t O_H1 = O_X + 136314880;
constexpr size_t O_R = O_H1 + 68157440;
constexpr size_t O_H2 = O_R;
constexpr size_t O_YCAT = O_H2 + 68157440;
constexpr size_t O_MBUF = O_YCAT + 68157440;
constexpr size_t O_QN = O_MBUF + 68157440;
constexpr size_t O_KN = O_QN + 17039360;
constexpr size_t O_VN = O_KN + 17039360;
constexpr size_t O_QDL = O_VN + 17039360;
constexpr size_t O_QDR = O_QDL + 16777216;
constexpr size_t O_KD = O_QDR + 17039360;
constexpr size_t O_VD = O_KD + 17039360;
constexpr size_t O_QML = O_VD + 17039360;
constexpr size_t O_QMR = O_QML + 25165824;
constexpr size_t O_KM = O_QMR + 25559040;
constexpr size_t O_VM = O_KM + 25559040;
constexpr size_t O_CQ = O_VM + 17039360;
constexpr size_t O_CKV = O_CQ + 17039360;
constexpr size_t O_UCAT = O_CKV + 8519680;
constexpr size_t O_SLOC = O_UCAT + 21954560;
constexpr size_t O_G5 = O_SLOC + 8519680;
constexpr size_t R_END1 = O_G5 + 17039360;
constexpr size_t R_END2 = O_R + (size_t)YROWS * 2048;
constexpr size_t O_ACT = R_END1 > R_END2 ? R_END1 : R_END2;
constexpr size_t O_IDX = O_ACT + (size_t)YROWS * 512;
constexpr size_t O_GW = O_IDX + 798720;
constexpr size_t O_SLOT = O_GW + 798720;
constexpr size_t O_ROWIDX = O_SLOT + 798720;
constexpr size_t O_WIN = O_ROWIDX + 997376;
constexpr size_t O_WG = O_WIN + 2304 * 1024 * 2;
constexpr size_t O_WUQ = O_WG + 4096 * 1024 * 2;
constexpr size_t O_WUKV = O_WUQ + 384 * 256 * 2;
constexpr size_t O_WGLU = O_WUKV + 512 * 128 * 2;
constexpr size_t O_WBR = O_WGLU + 256 * 256 * 2;
constexpr size_t O_WOUT = O_WBR + 4 * 1024 * 256 * 2;
constexpr size_t O_WE1 = O_WOUT + 1024 * 1024 * 2;
constexpr size_t O_WE3 = O_WE1 + (size_t)65 * 256 * 1024 * 2;
constexpr size_t O_WE2 = O_WE3 + (size_t)65 * 256 * 1024 * 2;
constexpr size_t O_S5B2 = O_WE2 + (size_t)65 * 1024 * 256 * 2;
constexpr size_t O_S5B1 = O_S5B2 + (size_t)16 * 1024 * 1280 * 2;
constexpr size_t O_WRHI = O_S5B1 + (size_t)16 * 256 * 1024 * 2;
constexpr size_t O_WRLO = O_WRHI + 128 * 1024 * 2;
constexpr size_t WS_NEED = O_WRLO + 128 * 1024 * 2;
constexpr size_t O_H2LO = O_MBUF;
constexpr size_t O_LOGIT = O_YCAT;

struct Params_ {
  const float *x, *c, *ctx, *c_ctx, *w_ada, *b_ada, *g_norm1, *g_norm2, *w_in, *na_rpb, *diff_lambda, *g_diff, *g_mla_q, *g_mla_kv,
      *w_mla_uq, *w_mla_ukv, *s5_lam_re, *s5_lam_im, *s5_log_step, *s5_b_re, *s5_b_im, *s5_c_re, *s5_c_im, *s5_d, *w_glu, *b_glu,
      *w_branch, *w_out, *w_router, *e_bias, *w_e1, *w_e3, *w_e2, *w_s1, *w_s3, *w_s2, *g_final;
  float* out;
  char* ws;
};
typedef const __attribute__((address_space(4))) Params_ Params;
DI Params* kargs() { Params* k = (Params*)__builtin_amdgcn_kernarg_segment_ptr(); asm volatile("" : "+s"(k)); return k; }

DI float bf2f(bf16_t b) { return __uint_as_float((unsigned)b << 16); }
DI bf16_t f2bf(float x) { unsigned u = __float_as_uint(x); u += 0x7fffu + ((u >> 16) & 1u); return (bf16_t)(u >> 16); }
DI unsigned pack2(float a, float b) { fl2_t f = {a, b}; bf2_t r = __builtin_convertvector(f, bf2_t); return __builtin_bit_cast(unsigned, r); }
DI float sigm(float x) { return __builtin_amdgcn_rcpf(1.f + __builtin_amdgcn_exp2f(-LOG2E * x)); }
DI float gelu_tanh(float x) { float u = 0.7978845608028654f * (x + 0.044715f * x * x * x); return x * (1.f - __builtin_amdgcn_rcpf(__builtin_amdgcn_exp2f((2.f * LOG2E) * u) + 1.f)); }
DI float bperm(float v, int srclane) { return __int_as_float(__builtin_amdgcn_ds_bpermute(srclane << 2, __float_as_int(v))); }
DI float xhalf(float v) { auto rr = __builtin_amdgcn_permlane32_swap(__float_as_uint(v), __float_as_uint(v), false, false); return __uint_as_float(rr[0]) + __uint_as_float(rr[1]); }
DI float xhalf_max(float v) { auto rr = __builtin_amdgcn_permlane32_swap(__float_as_uint(v), __float_as_uint(v), false, false); return fmaxf(__uint_as_float(rr[0]), __uint_as_float(rr[1])); }
DI float xhalf_get(float v, int hi) { auto rr = __builtin_amdgcn_permlane32_swap(__float_as_uint(v), __float_as_uint(v), false, false); return __uint_as_float(hi ? rr[0] : rr[1]); }
DI float wave_sum(float v, int lane) {
#pragma unroll
  for (int o = 16; o > 0; o >>= 1) v += bperm(v, lane ^ o);
  return xhalf(v);
}
DI float wave_max(float v, int lane) {
#pragma unroll
  for (int o = 16; o > 0; o >>= 1) v = fmaxf(v, bperm(v, lane ^ o));
  return xhalf_max(v);
}
DI void tokinfo(int row, int& b, int& isctx, int& t) {
  if (row < NL) { b = row >> 14; t = row & 16383; isctx = 0; }
  else { int r = row - NL; b = r >> 8; t = r & 255; isctx = 1; }
}
#define MFMA16(a, b, c) __builtin_amdgcn_mfma_f32_16x16x32_bf16((a), (b), (c), 0, 0, 0)
#define MFMA32(a, b, c) __builtin_amdgcn_mfma_f32_32x32x16_bf16((a), (b), (c), 0, 0, 0)
DI int otid() { int t = threadIdx.x; asm volatile("" : "+v"(t)); return t; }
template <int DK> DI size_t kimg(int kidx, int d) { return ((size_t)((kidx >> 6) * (DK / 8) + (d >> 3)) * 64 + (kidx & 63)) * 8 + (d & 7); }
DI size_t vimg(int kidx, int d) { return (size_t)(kidx >> 6) * 4096 + (d >> 5) * 2048 + (kidx & 63) * 32 + (d & 31); }
DI void glds16(const void* g, unsigned lds_base) {
  unsigned sv;
  asm volatile("s_mov_b32 %0, m0\n\ts_mov_b32 m0, %2\n\ts_nop 0\n\tglobal_load_lds_dwordx4 %1, off\n\ts_mov_b32 m0, %0" : "=&s"(sv) : "v"(g), "s"(lds_base) : "memory");
}
DI int crow(int r, int hi) { return (r & 3) + 8 * (r >> 2) + 4 * hi; }

constexpr int GSTAGE = 49152;
constexpr int GNST = 3;
constexpr int GEMM_LDS = GNST * GSTAGE;
constexpr int LDS_BYTES = GEMM_LDS + 2048;
constexpr int LDS_XBW = LDS_BYTES, LDS_POFF = LDS_BYTES + 16, LDS_TOTAL = LDS_BYTES + 16 + 512;
struct GJ { const bf16_t* A; const int* ridx; const bf16_t* Bt; int lda, m0, ldb, n0, nt; bool valid; };
DI GJ gj_none() { GJ j; j.A = nullptr; j.ridx = nullptr; j.Bt = nullptr; j.lda = 0; j.m0 = 0; j.ldb = 0; j.n0 = 0; j.nt = 0; j.valid = false; return j; }
DI GJ gj_make(const bf16_t* A, const int* ridx, int lda, int m0, const bf16_t* Bt, int ldb, int n0, int K) {
  GJ j; j.A = A; j.ridx = ridx; j.Bt = Bt; j.lda = lda; j.m0 = m0; j.ldb = ldb; j.n0 = n0; j.nt = K >> 6; j.valid = true; return j; }
struct GP { const bf16_t* p[6]; };
DI GP g_setup(const GJ& j, int tid) {
  const int r = tid >> 3, c = (((tid & 7) ^ ((r >> 1) & 7))) * 8;
  GP g;
#pragma unroll
  for (int i = 0; i < 4; ++i) { int rr = j.m0 + r + 64 * i; if (j.ridx) rr = j.ridx[rr]; g.p[i] = j.A + (size_t)rr * j.lda + c; }
#pragma unroll
  for (int i = 0; i < 2; ++i) g.p[4 + i] = j.Bt + (size_t)(j.n0 + r + 64 * i) * j.ldb + c;
  return g;
}
DI void g_issue1(const GP& g, int kt, char* base, int tid, int i) {
  __builtin_amdgcn_global_load_lds((const unsigned*)(g.p[i] + kt * 64), (unsigned*)(base + i * 8192 + tid * 16), 16, 0, 0);
}
DI const bf16_t* g_ptr1(const GJ& j, int tid, int i) {
  const int r = tid >> 3, c = (((tid & 7) ^ ((r >> 1) & 7))) * 8;
  if (i < 4) { int rr = j.m0 + r + 64 * i; if (j.ridx) rr = j.ridx[rr]; return j.A + (size_t)rr * j.lda + c; }
  return j.Bt + (size_t)(j.n0 + r + 64 * (i - 4)) * j.ldb + c;
}
DI void g_issue(const GP& g, int kt, char* base, int tid) {
#pragma unroll
  for (int i = 0; i < 6; ++i) g_issue1(g, kt, base, tid, i);
}
template <int NST>
struct GStream {
  GP cur; int cur_nt, ring, tid; char* lds;
  DI void start(const GJ& j, char* lds_, int tid_) {
    lds = lds_; tid = tid_; ring = 0; cur_nt = j.nt;
    if (j.valid) { cur = g_setup(j, tid);
#pragma unroll
      for (int i = 0; i < NST - 1; ++i) g_issue(cur, i, lds + i * GSTAGE, tid); }
  }
  template <bool LAZY = false, bool PF2 = true>
  DI void run(f32x4 (&acc)[4][4], const GJ& next) {
    const int lane = tid & 63, wid = tid >> 6, wr = wid >> 1, wc = wid & 1, fr = lane & 15, fq = lane >> 4;
    const int sw = (fr >> 1) & 7;
    const int aoff = (wr * 64 + fr) * 128, boff = 32768 + (wc * 64 + fr) * 128;
    const int c0 = ((fq ^ sw) * 16), c1 = (((4 + fq) ^ sw) * 16);
    const bool hn = next.valid;
    GP nxt = cur;
    if (!LAZY && hn) nxt = g_setup(next, tid);
    const int nt = cur_nt;
#pragma unroll 1
    for (int t = 0; t < nt; ++t) {
      int infl = nt - 1 - t + (hn ? NST - 1 : 0); infl = infl > NST - 2 ? NST - 2 : infl;
      if (infl >= 2) asm volatile("s_waitcnt vmcnt(12)" ::: "memory");
      else if (infl == 1) asm volatile("s_waitcnt vmcnt(6)" ::: "memory");
      else asm volatile("s_waitcnt vmcnt(0)" ::: "memory");
      __builtin_amdgcn_s_barrier();
      const int j = t + NST - 1;
      char* ib = lds + ((ring + j) % NST) * GSTAGE;
      const bool own = j < nt, doi = own || hn;
      const int ikt = own ? j : j - nt;
      GP src = cur;
      if (!LAZY && !own && hn) src = nxt;
#define G_ISSUE1(i_) do { if (LAZY && !own) __builtin_amdgcn_global_load_lds((const unsigned*)(g_ptr1(next, tid, (i_)) + ikt * 64), (unsigned*)(ib + (i_) * 8192 + tid * 16), 16, 0, 0); else g_issue1(src, ikt, ib, tid, (i_)); } while (0)
      const char* base = lds + ((ring + t) % NST) * GSTAGE;
      bf16x8 af[4], bfr[4], af1[4], bf1[4];
#pragma unroll
      for (int m = 0; m < 4; ++m) af[m] = *(const bf16x8*)(base + aoff + m * 2048 + c0);
#pragma unroll
      for (int n = 0; n < 4; ++n) bfr[n] = *(const bf16x8*)(base + boff + n * 2048 + c0);
      __builtin_amdgcn_sched_barrier(0);
#pragma unroll
      for (int m = 0; m < 4; ++m) {
#pragma unroll
        for (int n = 0; n < 4; ++n) acc[m][n] = MFMA16(bfr[n], af[m], acc[m][n]);
        if (doi) G_ISSUE1(m);
        if (!LAZY && PF2) {
          if (m == 0) {
#pragma unroll
            for (int n = 0; n < 4; ++n) bf1[n] = *(const bf16x8*)(base + boff + n * 2048 + c1);
          }
          if (m == 1) {
#pragma unroll
            for (int q = 0; q < 4; ++q) af1[q] = *(const bf16x8*)(base + aoff + q * 2048 + c1);
          }
        }
        __builtin_amdgcn_sched_barrier(0);
      }
      if (LAZY || !PF2) {
#pragma unroll
        for (int m = 0; m < 4; ++m) af1[m] = *(const bf16x8*)(base + aoff + m * 2048 + c1);
#pragma unroll
        for (int n = 0; n < 4; ++n) bf1[n] = *(const bf16x8*)(base + boff + n * 2048 + c1);
        __builtin_amdgcn_sched_barrier(0);
      }
#pragma unroll
      for (int m = 0; m < 4; ++m) {
#pragma unroll
        for (int n = 0; n < 4; ++n) acc[m][n] = MFMA16(bf1[n], af1[m], acc[m][n]);
        if (m < 2 && doi) G_ISSUE1(4 + m);
        __builtin_amdgcn_sched_barrier(0);
      }
    }
#undef G_ISSUE1
    ring = (ring + nt) % NST;
    if (LAZY) { if (hn) cur = g_setup(next, tid); } else cur = nxt;
    cur_nt = next.nt;
  }
  DI void run2(f32x4 (&acc)[4][4], const GJ& next) { run(acc, next); }
};
DI void mini_gemm16(f32x4& acc, const bf16_t* __restrict__ A, int lda, const bf16_t* __restrict__ Bt, int ldb, int K, int lane) {
  const bf16_t* ap = A + (size_t)(lane & 15) * lda + 8 * (lane >> 4);
  const bf16_t* bp = Bt + (size_t)(lane & 15) * ldb + 8 * (lane >> 4);
#pragma unroll 16
  for (int k0 = 0; k0 < K; k0 += 32) {
    const bf16x8 a = *(const bf16x8*)(ap + k0), b = *(const bf16x8*)(bp + k0);
    acc = MFMA16(a, b, acc);
  }
}
constexpr int WSTAGE = 32768, WNST = 4;
struct GPW { const bf16_t* p[4]; };
DI GPW gw_setup(const GJ& j, int tid) {
  const int r = tid >> 2, c = (((tid & 3) ^ ((0 - (r >> 2)) & 3))) * 8;
  GPW g;
#pragma unroll
  for (int i = 0; i < 2; ++i) { int rr = j.m0 + r + 128 * i; if (j.ridx) rr = j.ridx[rr]; g.p[i] = j.A + (size_t)rr * j.lda + c; }
#pragma unroll
  for (int i = 0; i < 2; ++i) g.p[2 + i] = j.Bt + (size_t)(j.n0 + r + 128 * i) * j.ldb + c;
  return g;
}
DI void gw_issue1(const GPW& g, int kt, char* base, int tid, int i) {
  __builtin_amdgcn_global_load_lds((const unsigned*)(g.p[i] + kt * 32), (unsigned*)(base + i * 8192 + tid * 16), 16, 0, 0);
}
struct GStreamW {
  GPW cur; int cur_nt, ring, tid; char* lds;
  DI void start(const GJ& j, char* lds_, int tid_) {
    lds = lds_; tid = tid_; ring = 0; cur_nt = j.nt * 2;
    if (j.valid) { cur = gw_setup(j, tid);
#pragma unroll
      for (int s = 0; s < WNST - 1; ++s)
#pragma unroll
        for (int i = 0; i < 4; ++i) gw_issue1(cur, s, lds + s * WSTAGE, tid, i); }
  }
  DI void run(f32x4 (&acc)[4][8], const GJ& next) {
    const int lane = tid & 63, wid = tid >> 6, wr = wid >> 1, wc = wid & 1, fr = lane & 15, fq = lane >> 4;
    const int fo = ((fq ^ ((0 - (fr >> 2)) & 3)) * 16);
    const int aoff = (wr * 64 + fr) * 64 + fo, boff = 16384 + (wc * 128 + fr) * 64 + fo;
    const bool hn = next.valid;
    GPW nxt = cur;
    if (hn) nxt = gw_setup(next, tid);
    const int nt = cur_nt;
#pragma unroll 1
    for (int t = 0; t < nt; ++t) {
      int infl = nt - 1 - t + (hn ? WNST - 1 : 0); infl = infl > WNST - 2 ? WNST - 2 : infl;
      if (infl >= 2) asm volatile("s_waitcnt vmcnt(8)" ::: "memory");
      else if (infl == 1) asm volatile("s_waitcnt vmcnt(4)" ::: "memory");
      else asm volatile("s_waitcnt vmcnt(0)" ::: "memory");
      __builtin_amdgcn_s_barrier();
      const int j = t + WNST - 1;
      char* ib = lds + ((ring + j) % WNST) * WSTAGE;
      const bool own = j < nt, doi = own || hn;
      const int ikt = own ? j : j - nt;
      GPW src = cur;
      if (!own && hn) src = nxt;
      const char* base = lds + ((ring + t) % WNST) * WSTAGE;
      bf16x8 af[4], bfr[8];
#pragma unroll
      for (int m = 0; m < 4; ++m) af[m] = *(const bf16x8*)(base + aoff + m * 1024);
#pragma unroll
      for (int n = 0; n < 8; ++n) bfr[n] = *(const bf16x8*)(base + boff + n * 1024);
      __builtin_amdgcn_sched_barrier(0);
#pragma unroll
      for (int m = 0; m < 4; ++m) {
#pragma unroll
        for (int n = 0; n < 8; ++n) acc[m][n] = MFMA16(bfr[n], af[m], acc[m][n]);
        if (doi) gw_issue1(src, ikt, ib, tid, m);
        __builtin_amdgcn_sched_barrier(0);
      }
    }
    ring = (ring + nt) % WNST;
    cur = nxt; cur_nt = next.nt * 2;
  }
};
DI void zero_accw(f32x4 (&acc)[4][8]) {
#pragma unroll
  for (int m = 0; m < 4; ++m)
#pragma unroll
    for (int n = 0; n < 8; ++n) acc[m][n] = f32x4{0.f, 0.f, 0.f, 0.f};
}
constexpr int G8_HT = 128 * 64;
DI int g8_lds_byte(int r, int c) { const int st = (r >> 4) * 2 + (c >> 5), rr = r & 15, cc = c & 31, ob = rr * 64 + cc * 2; return st * 1024 + (ob ^ (((ob >> 9) & 1) << 5)); }
DI void g8_stage_rc(int b, int& R, int& C) { const int st = b / 1024, sb = b % 1024, swz = sb ^ (((sb >> 9) & 1) << 5); R = (st >> 1) * 16 + swz / 64; C = (st & 1) * 32 + (swz % 64) / 2; }
template <bool GATHER>
DI void gemm8(f32x4 (&acc)[2][2][4][2], const bf16_t* __restrict__ A, const int* __restrict__ ridx, int brow, const bf16_t* __restrict__ B0, const bf16_t* __restrict__ B1, int K, char* shmc) {
  bf16_t* shm = (bf16_t*)shmc;
#define G8_SA(b, h) (shm + ((b) * 2 + (h)) * G8_HT)
#define G8_SB(b, h) (shm + (4 + (b) * 2 + (h)) * G8_HT)
  int tz = otid();
  int wid = tz >> 6, lane = tz & 63, wr = wid >> 2, wc = wid & 3, fr = lane & 15, fq = lane >> 4;
  int ar[2][2];
  if (GATHER) {
#pragma unroll
    for (int h = 0; h < 2; ++h)
#pragma unroll
      for (int i = 0; i < 2; ++i) { int r_, c_; g8_stage_rc(tz * 16 + i * 8192, r_, c_); ar[h][i] = ridx[brow + h * 128 + r_]; }
  }
#define G8_STAGE_A(P, h, kt) do { _Pragma("unroll") for (int i_ = 0; i_ < 2; ++i_) { const int b_ = tz * 16 + i_ * 8192; int r_, c_; g8_stage_rc(b_, r_, c_); \
      const long row_ = GATHER ? (long)ar[h][i_] : (long)(brow + (h) * 128 + r_); \
      __builtin_amdgcn_global_load_lds((const unsigned*)(A + row_ * K + (long)(kt) * 64 + c_), (unsigned*)((char*)(P) + b_), 16, 0, 0); } } while (0)
#define G8_STAGE_B(P, h, kt) do { const bf16_t* bb_ = (h) ? B1 : B0; _Pragma("unroll") for (int i_ = 0; i_ < 2; ++i_) { const int b_ = tz * 16 + i_ * 8192; int r_, c_; g8_stage_rc(b_, r_, c_); \
      __builtin_amdgcn_global_load_lds((const unsigned*)(bb_ + (long)r_ * K + (long)(kt) * 64 + c_), (unsigned*)((char*)(P) + b_), 16, 0, 0); } } while (0)
#define G8_LDA(dst, b, h) _Pragma("unroll") for (int m = 0; m < 4; ++m) _Pragma("unroll") for (int k = 0; k < 2; ++k) \
    dst[m][k] = *reinterpret_cast<const bf16x8*>((char*)G8_SA(b, h) + g8_lds_byte(wr * 64 + m * 16 + fr, k * 32 + fq * 8))
#define G8_LDB(dst, b, h) _Pragma("unroll") for (int n = 0; n < 2; ++n) _Pragma("unroll") for (int k = 0; k < 2; ++k) \
    dst[n][k] = *reinterpret_cast<const bf16x8*>((char*)G8_SB(b, h) + g8_lds_byte(wc * 32 + n * 16 + fr, k * 32 + fq * 8))
#define G8_MMA(ai, bj, At_, Bt_) do { __builtin_amdgcn_s_setprio(1); \
    _Pragma("unroll") for (int m = 0; m < 4; ++m) _Pragma("unroll") for (int n = 0; n < 2; ++n) _Pragma("unroll") for (int k = 0; k < 2; ++k) \
      acc[ai][bj][m][n] = MFMA16(Bt_[n][k], At_[m][k], acc[ai][bj][m][n]); \
    __builtin_amdgcn_s_setprio(0); } while (0)
#define G8_WAIT_V(n) asm volatile("s_waitcnt vmcnt(" #n ")" ::: "memory")
#define G8_WAIT_L(n) asm volatile("s_waitcnt lgkmcnt(" #n ")" ::: "memory")
#define G8_BAR __builtin_amdgcn_s_barrier()
#define G8_SCHED __builtin_amdgcn_sched_barrier(0)
  bf16x8 At[4][2], Bq0[2][2], Bq1[2][2];
  const int nt = K / 64;
  G8_STAGE_B(G8_SB(0, 0), 0, 0); G8_STAGE_A(G8_SA(0, 0), 0, 0);
  G8_STAGE_B(G8_SB(0, 1), 1, 0); G8_STAGE_A(G8_SA(0, 1), 1, 0);
  if (wr == 1) G8_BAR;
  G8_WAIT_V(4); G8_BAR;
  G8_STAGE_B(G8_SB(1, 0), 0, 1); G8_STAGE_A(G8_SA(1, 0), 0, 1); G8_STAGE_B(G8_SB(1, 1), 1, 1);
  G8_WAIT_V(6); G8_BAR;
#pragma unroll 1
  for (int t = 0; t < nt - 2; t += 2) {
    G8_LDB(Bq0, 0, 0); G8_SCHED; G8_LDA(At, 0, 0); G8_STAGE_A(G8_SA(1, 1), 1, t + 1);
    G8_WAIT_L(8); G8_BAR; G8_WAIT_L(0); G8_MMA(0, 0, At, Bq0); G8_BAR; G8_SCHED;
    G8_LDB(Bq1, 0, 1); G8_STAGE_B(G8_SB(0, 0), 0, t + 2);
    G8_BAR; G8_WAIT_L(0); G8_MMA(0, 1, At, Bq1); G8_BAR;
    G8_LDA(At, 0, 1); G8_STAGE_A(G8_SA(0, 0), 0, t + 2);
    G8_BAR; G8_WAIT_L(0); G8_MMA(1, 0, At, Bq0); G8_BAR; G8_SCHED;
    G8_STAGE_B(G8_SB(0, 1), 1, t + 2);
    G8_WAIT_V(6); G8_BAR; G8_MMA(1, 1, At, Bq1); G8_BAR;
    G8_LDB(Bq0, 1, 0); G8_SCHED; G8_LDA(At, 1, 0); G8_STAGE_A(G8_SA(0, 1), 1, t + 2);
    G8_WAIT_L(8); G8_BAR; G8_WAIT_L(0); G8_MMA(0, 0, At, Bq0); G8_BAR; G8_SCHED;
    G8_LDB(Bq1, 1, 1); G8_STAGE_B(G8_SB(1, 0), 0, t + 3);
    G8_BAR; G8_WAIT_L(0); G8_MMA(0, 1, At, Bq1); G8_BAR;
    G8_LDA(At, 1, 1); G8_STAGE_A(G8_SA(1, 0), 0, t + 3);
    G8_BAR; G8_WAIT_L(0); G8_MMA(1, 0, At, Bq0); G8_BAR; G8_SCHED;
    G8_STAGE_B(G8_SB(1, 1), 1, t + 3);
    G8_WAIT_V(6); G8_BAR; G8_MMA(1, 1, At, Bq1); G8_BAR;
  }
  { int t2 = tz; asm volatile("" : "+v"(t2)); tz = t2; wid = tz >> 6; lane = tz & 63; wr = wid >> 2; wc = wid & 3; fr = lane & 15; fq = lane >> 4; }
  { G8_LDB(Bq0, 0, 0); G8_WAIT_V(0); G8_LDA(At, 0, 0); G8_STAGE_A(G8_SA(1, 1), 1, nt - 1);
    G8_BAR; G8_WAIT_L(0); G8_MMA(0, 0, At, Bq0); G8_BAR;
    G8_LDB(Bq1, 0, 1); G8_BAR; G8_WAIT_L(0); G8_MMA(0, 1, At, Bq1); G8_BAR;
    G8_LDA(At, 0, 1); G8_WAIT_V(4); G8_BAR; G8_WAIT_L(0); G8_MMA(1, 0, At, Bq0); G8_MMA(1, 1, At, Bq1); G8_BAR; }
  { G8_LDB(Bq0, 1, 0); G8_LDA(At, 1, 0); G8_WAIT_V(2); G8_BAR; G8_WAIT_L(0); G8_MMA(0, 0, At, Bq0); G8_BAR;
    G8_LDB(Bq1, 1, 1); G8_WAIT_V(0); G8_BAR; G8_WAIT_L(0); G8_MMA(0, 1, At, Bq1); G8_BAR;
    G8_LDA(At, 1, 1); G8_BAR; G8_WAIT_L(0); G8_MMA(1, 0, At, Bq0); G8_MMA(1, 1, At, Bq1); G8_BAR; }
  if (wr == 0) G8_BAR;
#undef G8_SA
#undef G8_SB
#undef G8_STAGE_A
#undef G8_STAGE_B
#undef G8_LDA
#undef G8_LDB
#undef G8_MMA
#undef G8_WAIT_V
#undef G8_WAIT_L
#undef G8_BAR
#undef G8_SCHED
}
DI void zero_acc8(f32x4 (&acc)[2][2][4][2]) {
#pragma unroll
  for (int a = 0; a < 2; ++a)
#pragma unroll
    for (int b = 0; b < 2; ++b)
#pragma unroll
      for (int m = 0; m < 4; ++m)
#pragma unroll
        for (int n = 0; n < 2; ++n) acc[a][b][m][n] = f32x4{0.f, 0.f, 0.f, 0.f};
}
struct UM {
  int x, r, R, NT, nloc;
  DI UM(int NM, int NT_) { x = blockIdx.x & 7; r = blockIdx.x >> 3; R = gridDim.x >> 3; NT = NT_; nloc = ((NM - x + 7) >> 3) * NT_; if (NM <= x) nloc = 0; }
  DI bool get(int k, int& mt, int& nt) const { const int v = r + k * R; if (k < 0 || v >= nloc) return false; mt = x + 8 * (v / NT); nt = v % NT; return true; }
};
DI u32x2 pack4(const f32x4& v) { u32x2 r; r[0] = pack2(v[0], v[1]); r[1] = pack2(v[2], v[3]); return r; }
DI void zero_acc(f32x4 (&acc)[4][4]) {
#pragma unroll
  for (int m = 0; m < 4; ++m)
#pragma unroll
    for (int n = 0; n < 4; ++n) acc[m][n] = f32x4{0.f, 0.f, 0.f, 0.f};
}

DI float rope_apply(float v, float partner, int fr, int half, int t, const float2* roper, const float2* ropec) {
  const int i = fr & 7;
  const float2 cs = half ? ropec[(t & 63) * 8 + i] : roper[(t >> 6) * 8 + i];
  return (fr & 8) ? (partner * cs.y + v * cs.x) : (v * cs.x - partner * cs.y);
}

DI void phase_p0(const Params& p, char* lds) {
  const int tid = otid(), gtid = blockIdx.x * NTHR + tid, gsz = gridDim.x * NTHR;
  float* sl = (float*)lds;
  for (int i = tid; i < 3072; i += NTHR) { float v = i < 2048 ? p.c[i] : p.c_ctx[i - 2048]; sl[i] = v / (1.f + __expf(-v)); }
  __syncthreads();
  float* adap = (float*)(p.ws + O_ACT);
  for (int w = gtid; w < DEPTH * 6144 * 4; w += gsz) {
    const int kp = w / (DEPTH * 6144), o = w % (DEPTH * 6144);
    const int l = o / 6144, col = o % 6144;
    const float* wp = p.w_ada + ((size_t)l * 1024 + kp * 256) * 6144 + col;
    const float* s0 = sl + kp * 256;
    float a0 = 0.f, a1 = 0.f, a2 = 0.f;
#pragma unroll 16
    for (int k = 0; k < 256; ++k) { const float wv = wp[(size_t)k * 6144]; a0 += s0[k] * wv; a1 += s0[1024 + k] * wv; a2 += s0[2048 + k] * wv; }
    float* dst = adap + (size_t)kp * (DEPTH * 3 * 6144);
    dst[(l * 3 + 0) * 6144 + col] = a0; dst[(l * 3 + 1) * 6144 + col] = a1; dst[(l * 3 + 2) * 6144 + col] = a2;
  }
  float2* rr = (float2*)(p.ws + O_ROPER);
  float2* rc = (float2*)(p.ws + O_ROPEC);
  for (int i = gtid; i < 2048 + 512; i += gsz) {
    const int j = i < 2048 ? i : i - 2048;
    const int pos = j >> 3, f = j & 7;
    double freq = 1.0;
    switch (f) { case 1: freq = 0.31622776601683794; break; case 2: freq = 0.1; break; case 3: freq = 0.031622776601683794; break; case 4: freq = 0.01; break;
      case 5: freq = 0.0031622776601683794; break; case 6: freq = 0.001; break; case 7: freq = 0.00031622776601683794; break; default: break; }
    double rev = (double)pos * freq * 0.15915494309189535; rev -= floor(rev);
    const float rf = (float)rev;
    const float2 cs = make_float2(__builtin_amdgcn_cosf(rf), __builtin_amdgcn_sinf(rf));
    if (i < 2048) rr[j] = cs; else rc[j] = cs;
  }
  float2* pw = (float2*)(p.ws + O_S5PW);
  float2* bb = (float2*)(p.ws + O_S5BB);
  for (int i = gtid; i < DEPTH * 2 * 16 * 64; i += gsz) {
    const int ldg = i >> 6, pp = i & 63;
    const float lr = p.s5_lam_re[i], li = p.s5_lam_im[i];
    const float step = expf(p.s5_log_step[ldg]);
    float ar = 1.f, ai = 0.f;
    for (int tau = 0; tau <= 64; ++tau) {
      double rev = (double)li * (double)step * (double)tau * 0.15915494309189535; rev -= floor(rev);
      const float rf = (float)rev;
      const float mag = expf(lr * step * (float)tau);
      const float2 v = make_float2(mag * __builtin_amdgcn_cosf(rf), mag * __builtin_amdgcn_sinf(rf));
      pw[((size_t)ldg * 65 + tau) * 64 + pp] = v;
      if (tau == 1) { ar = v.x; ai = v.y; }
    }
    const float den = lr * lr + li * li;
    const float fr_ = ((ar - 1.f) * lr + ai * li) / den, fi_ = (ai * lr - (ar - 1.f) * li) / den;
    for (int j = 0; j < 16; ++j) {
      const float br = p.s5_b_re[(size_t)i * 16 + j], bi = p.s5_b_im[(size_t)i * 16 + j];
      bb[(size_t)i * 16 + j] = make_float2(fr_ * br - fi_ * bi, fr_ * bi + fi_ * br);
    }
  }
  if (gtid < DEPTH) {
    const float* lf = p.diff_lambda + gtid * 128;
    float s1 = 0.f, s2 = 0.f;
    for (int k = 0; k < 32; ++k) { s1 += lf[k] * lf[32 + k]; s2 += lf[64 + k] * lf[96 + k]; }
    const float lam_init = 0.8f - 0.6f * expf(-0.3f * (float)gtid);
    ((float*)(p.ws + O_LAMF))[gtid] = expf(s1) - expf(s2) + lam_init;
  }
  if (gtid < 64) ((int*)(p.ws + O_CNT))[gtid] = 0;
}

DI void phase_p1(const Params& p) {
  const int gtid = blockIdx.x * NTHR + otid(), gsz = gridDim.x * NTHR;
  {
    const float* adap = (const float*)(p.ws + O_ACT);
    float* ada = (float*)(p.ws + O_ADA);
    for (int i = gtid; i < DEPTH * 3 * 6144; i += gsz) {
      const int l = i / (3 * 6144), col = i % 6144;
      ada[i] = ((adap[i] + adap[i + DEPTH * 3 * 6144]) + (adap[i + 2 * DEPTH * 3 * 6144] + adap[i + 3 * DEPTH * 3 * 6144])) + p.b_ada[l * 6144 + col];
    }
  }
  const float2* pw = (const float2*)(p.ws + O_S5PW);
  const float2* bb = (const float2*)(p.ws + O_S5BB);
  float* km = (float*)(p.ws + O_S5K);
  for (int o = gtid; o < DEPTH * 2 * 16 * 64 * 256; o += gsz) {
    const int j2 = o & 15, j = (o >> 4) & 15, tau = (o >> 8) & 63, ldg = o >> 14;
    const float* cr = p.s5_c_re + ((size_t)ldg * 16 + j) * 64;
    const float* ci = p.s5_c_im + ((size_t)ldg * 16 + j) * 64;
    const float2* pwr = pw + ((size_t)ldg * 65 + tau) * 64;
    const float2* bbr = bb + (size_t)ldg * 64 * 16 + j2;
    float s = 0.f;
    for (int pp = 0; pp < 64; ++pp) {
      const float2 a = pwr[pp], b = bbr[pp * 16];
      const float wr_ = cr[pp] * a.x - ci[pp] * a.y, wi_ = cr[pp] * a.y + ci[pp] * a.x;
      s += wr_ * b.x - wi_ * b.y;
    }
    km[o] = s;
  }
}

template <int LOPART = 0>
DI void conv_tile(const float* __restrict__ in, int ld_in, bf16_t* __restrict__ out, int ld_out, const float* __restrict__ rs, int k0, int n0, float* sm) {
  const int tid = otid();
  {
    const int k = tid >> 3, n4 = (tid & 7) * 4;
    float4 v = *(const float4*)(in + (size_t)(k0 + k) * ld_in + n0 + n4);
    if (rs) { const float s = rs[k0 + k]; v.x *= s; v.y *= s; v.z *= s; v.w *= s; }
    sm[(n4 + 0) * 65 + k] = v.x; sm[(n4 + 1) * 65 + k] = v.y; sm[(n4 + 2) * 65 + k] = v.z; sm[(n4 + 3) * 65 + k] = v.w;
  }
  __syncthreads();
  {
    const int n = tid >> 4, k4 = (tid & 15) * 4;
    const float* s = sm + n * 65 + k4;
    float v0 = s[0], v1 = s[1], v2 = s[2], v3 = s[3];
    if (LOPART) { v0 -= bf2f(f2bf(v0)); v1 -= bf2f(f2bf(v1)); v2 -= bf2f(f2bf(v2)); v3 -= bf2f(f2bf(v3)); }
    u32x2 o; o[0] = pack2(v0, v1); o[1] = pack2(v2, v3);
    *(u32x2*)(out + (size_t)(n0 + n) * ld_out + k0 + k4) = o;
  }
  __syncthreads();
}
DI void conv_job(const float* in, int ld_in, size_t in_ms, bf16_t* out, int ld_out, size_t out_ms, const float* rs, int K, int N, int multi, float* sm) {
  const int tk = K >> 6, tn = N >> 5, per = tk * tn, total = per * multi;
  const int tid = otid();
  const int k = tid >> 3, n4 = (tid & 7) * 4, n = tid >> 4, k4 = (tid & 15) * 4;
  for (int t0 = blockIdx.x * 4; t0 < total; t0 += gridDim.x * 4) {
    float4 v[4];
#pragma unroll
    for (int q = 0; q < 4; ++q) {
      const int t = t0 + q;
      if (t < total) {
        const int mi = t / per, tt = t % per, k0 = (tt / tn) * 64, n0 = (tt % tn) * 32;
        v[q] = *(const float4*)(in + (size_t)mi * in_ms + (size_t)(k0 + k) * ld_in + n0 + n4);
        if (rs) { const float sc = rs[k0 + k]; v[q].x *= sc; v[q].y *= sc; v[q].z *= sc; v[q].w *= sc; }
      } else v[q] = make_float4(0.f, 0.f, 0.f, 0.f);
    }
#pragma unroll
    for (int q = 0; q < 4; ++q) { float* s_ = sm + q * 2080; s_[(n4 + 0) * 65 + k] = v[q].x; s_[(n4 + 1) * 65 + k] = v[q].y; s_[(n4 + 2) * 65 + k] = v[q].z; s_[(n4 + 3) * 65 + k] = v[q].w; }
    __syncthreads();
#pragma unroll
    for (int q = 0; q < 4; ++q) {
      const int t = t0 + q;
      if (t < total) {
        const int mi = t / per, tt = t % per, k0 = (tt / tn) * 64, n0 = (tt % tn) * 32;
        const float* s_ = sm + q * 2080 + n * 65 + k4;
        u32x2 o; o[0] = pack2(s_[0], s_[1]); o[1] = pack2(s_[2], s_[3]);
        *(u32x2*)(out + (size_t)mi * out_ms + (size_t)(n0 + n) * ld_out + k0 + k4) = o;
      }
    }
    __syncthreads();
  }
}
DI void phase_prep(const Params& p, int l, char* lds) {
  float* sm = (float*)lds;
  char* ws = p.ws; asm volatile("" : "+s"(ws));
  const int tid = otid(), gtid = blockIdx.x * NTHR + tid, gsz = gridDim.x * NTHR;
  unsigned z0_ = 0u; asm volatile("" : "+v"(z0_));
  const u32x4 zero4 = u32x4{z0_, z0_, z0_, z0_};
  conv_job(p.w_in + (size_t)l * 1024 * INW, INW, 0, (bf16_t*)(ws + O_WIN), 1024, 0, nullptr, 1024, 2208, 1, sm);
  for (int i = gtid; i < 96 * 1024 / 8; i += gsz) ((u32x4*)(ws + O_WIN + (size_t)2208 * 1024 * 2))[i] = zero4;
  conv_job(p.w_in + (size_t)l * 1024 * INW + 2208, INW, 0, (bf16_t*)(ws + O_WG), 1024, 0, nullptr, 1024, 4096, 1, sm);
  conv_job(p.w_mla_uq + (size_t)l * 256 * 384, 384, 0, (bf16_t*)(ws + O_WUQ), 256, 0, p.g_mla_q + l * 256, 256, 384, 1, sm);
  conv_job(p.w_mla_ukv + (size_t)l * 128 * 512, 512, 0, (bf16_t*)(ws + O_WUKV), 128, 0, p.g_mla_kv + l * 128, 128, 512, 1, sm);
  conv_job(p.w_glu + (size_t)l * 65536, 256, 0, (bf16_t*)(ws + O_WGLU), 256, 0, nullptr, 256, 256, 1, sm);
  conv_job(p.w_branch + (size_t)l * 4 * 262144, 1024, 262144, (bf16_t*)(ws + O_WBR), 256, 262144, nullptr, 256, 1024, 4, sm);
  conv_job(p.w_out + (size_t)l * 1048576, 1024, 0, (bf16_t*)(ws + O_WOUT), 1024, 0, nullptr, 1024, 1024, 1, sm);
  conv_job(p.w_e1 + (size_t)l * 64 * 262144, 256, 262144, (bf16_t*)(ws + O_WE1), 1024, 262144, nullptr, 1024, 256, 64, sm);
  conv_job(p.w_e3 + (size_t)l * 64 * 262144, 256, 262144, (bf16_t*)(ws + O_WE3), 1024, 262144, nullptr, 1024, 256, 64, sm);
  conv_job(p.w_e2 + (size_t)l * 64 * 262144, 1024, 262144, (bf16_t*)(ws + O_WE2), 256, 262144, nullptr, 256, 1024, 64, sm);
  conv_job(p.w_s1 + (size_t)l * 262144, 256, 0, (bf16_t*)(ws + O_WE1) + (size_t)64 * 262144, 1024, 0, nullptr, 1024, 256, 1, sm);
  conv_job(p.w_s3 + (size_t)l * 262144, 256, 0, (bf16_t*)(ws + O_WE3) + (size_t)64 * 262144, 1024, 0, nullptr, 1024, 256, 1, sm);
  conv_job(p.w_s2 + (size_t)l * 262144, 1024, 0, (bf16_t*)(ws + O_WE2) + (size_t)64 * 262144, 256, 0, nullptr, 256, 1024, 1, sm);
  for (int t = blockIdx.x; t < 32; t += gridDim.x) {
    conv_tile<0>(p.w_router + (size_t)l * 65536, 64, (bf16_t*)(ws + O_WRHI), 1024, nullptr, (t >> 1) * 64, (t & 1) * 32, sm);
    conv_tile<1>(p.w_router + (size_t)l * 65536, 64, (bf16_t*)(ws + O_WRLO), 1024, nullptr, (t >> 1) * 64, (t & 1) * 32, sm);
  }
  for (int i = gtid; i < 64 * 1024 / 8; i += gsz) { ((u32x4*)(ws + O_WRHI + 64 * 1024 * 2))[i] = zero4; ((u32x4*)(ws + O_WRLO + 64 * 1024 * 2))[i] = zero4; }
  const float2* pw = (const float2*)(ws + O_S5PW) + (size_t)l * 2 * 16 * 65 * 64;
  const float2* bbv = (const float2*)(ws + O_S5BB) + (size_t)l * 2 * 16 * 64 * 16;
  const float* km = (const float*)(ws + O_S5K) + (size_t)l * 2 * 16 * 64 * 256;
  const float* cre = p.s5_c_re + (size_t)l * 2 * 16 * 16 * 64;
  const float* cim = p.s5_c_im + (size_t)l * 2 * 16 * 16 * 64;
  bf16_t* b2 = (bf16_t*)(ws + O_S5B2);
#pragma unroll 1
  for (int it0 = gtid; it0 < 16 * 1024 * 128; it0 += gsz * 4) {
    float4 fa[4][2], fb[4][2]; float dd[4];
#pragma unroll
    for (int u = 0; u < 4; ++u) {
      const int it = it0 + u * gsz;
      const float4 z4 = make_float4(0.f, 0.f, 0.f, 0.f);
      fa[u][0] = z4; fa[u][1] = z4; fb[u][0] = z4; fb[u][1] = z4; dd[u] = 0.f;
      if (it < 16 * 1024 * 128) {
        const int kc = it & 127, gn = it >> 7, n = gn & 1023, g = gn >> 10, i = n >> 4, j = n & 15, k0 = kc * 8, i2 = k0 >> 4, jb = k0 & 15;
        if (i2 <= i) { const float4* q_ = (const float4*)(km + ((((size_t)0 * 16 + g) * 64 + (i - i2)) * 16 + j) * 16 + jb); fa[u][0] = q_[0]; fa[u][1] = q_[1]; }
        if (i2 >= i) { const float4* q_ = (const float4*)(km + ((((size_t)1 * 16 + g) * 64 + (i2 - i)) * 16 + j) * 16 + jb); fb[u][0] = q_[0]; fb[u][1] = q_[1]; }
        if (i2 == i && (j >> 3) == (jb >> 3)) dd[u] = p.s5_d[(l * 16 + g) * 16 + j];
      }
    }
#pragma unroll
    for (int u = 0; u < 4; ++u) {
      const int it = it0 + u * gsz;
      if (it < 16 * 1024 * 128) {
        const int kc = it & 127, gn = it >> 7, j = gn & 15, k0 = kc * 8;
        float v[8] = {0.f + fa[u][0].x + fb[u][0].x, 0.f + fa[u][0].y + fb[u][0].y, 0.f + fa[u][0].z + fb[u][0].z, 0.f + fa[u][0].w + fb[u][0].w,
                      0.f + fa[u][1].x + fb[u][1].x, 0.f + fa[u][1].y + fb[u][1].y, 0.f + fa[u][1].z + fb[u][1].z, 0.f + fa[u][1].w + fb[u][1].w};
#pragma unroll
        for (int e = 0; e < 8; ++e) if (e == (j & 7)) v[e] += dd[u];
        u32x4 o; o[0] = pack2(v[0], v[1]); o[1] = pack2(v[2], v[3]); o[2] = pack2(v[4], v[5]); o[3] = pack2(v[6], v[7]);
        *(u32x4*)(b2 + ((size_t)gn * 1280 + k0)) = o;
      }
    }
  }
#pragma unroll 1
  for (int it0 = gtid; it0 < 16 * 1024 * 32; it0 += gsz * 2) {
    float4 cr4[2][2], ci4[2][2], pw4[2][4];
#pragma unroll
    for (int u = 0; u < 2; ++u) {
      const int it = it0 + u * gsz;
      if (it < 16 * 1024 * 32) {
        const int kq = it & 31, gn = it >> 5, n = gn & 1023, g = gn >> 10, i = n >> 4, j = n & 15;
        const int d = kq >> 4, kk = (kq & 15) * 8, p0 = kk & 63, tau = d ? 64 - i : i + 1;
        const float4* c1 = (const float4*)(cre + (((size_t)d * 16 + g) * 16 + j) * 64 + p0);
        const float4* c2 = (const float4*)(cim + (((size_t)d * 16 + g) * 16 + j) * 64 + p0);
        const float4* c3 = (const float4*)(pw + (((size_t)d * 16 + g) * 65 + tau) * 64 + p0);
        cr4[u][0] = c1[0]; cr4[u][1] = c1[1]; ci4[u][0] = c2[0]; ci4[u][1] = c2[1];
        pw4[u][0] = c3[0]; pw4[u][1] = c3[1]; pw4[u][2] = c3[2]; pw4[u][3] = c3[3];
      }
    }
#pragma unroll
    for (int u = 0; u < 2; ++u) {
      const int it = it0 + u * gsz;
      if (it < 16 * 1024 * 32) {
        const int kq = it & 31, gn = it >> 5, kk = (kq & 15) * 8, ri = kk >> 6;
        const float cr[8] = {cr4[u][0].x, cr4[u][0].y, cr4[u][0].z, cr4[u][0].w, cr4[u][1].x, cr4[u][1].y, cr4[u][1].z, cr4[u][1].w};
        const float ci[8] = {ci4[u][0].x, ci4[u][0].y, ci4[u][0].z, ci4[u][0].w, ci4[u][1].x, ci4[u][1].y, ci4[u][1].z, ci4[u][1].w};
        const float ax[8] = {pw4[u][0].x, pw4[u][0].z, pw4[u][1].x, pw4[u][1].z, pw4[u][2].x, pw4[u][2].z, pw4[u][3].x, pw4[u][3].z};
        const float ay[8] = {pw4[u][0].y, pw4[u][0].w, pw4[u][1].y, pw4[u][1].w, pw4[u][2].y, pw4[u][2].w, pw4[u][3].y, pw4[u][3].w};
        float v[8];
#pragma unroll
        for (int e = 0; e < 8; ++e) {
          const float wr_ = cr[e] * ax[e] - ci[e] * ay[e], wi_ = cr[e] * ay[e] + ci[e] * ax[e];
          v[e] = ri == 0 ? wr_ : -wi_;
        }
        u32x4 o; o[0] = pack2(v[0], v[1]); o[1] = pack2(v[2], v[3]); o[2] = pack2(v[4], v[5]); o[3] = pack2(v[6], v[7]);
        *(u32x4*)(b2 + ((size_t)gn * 1280 + 1024 + kq * 8)) = o;
      }
    }
  }
  bf16_t* b1 = (bf16_t*)(ws + O_S5B1);
#pragma unroll 1
  for (int it0 = gtid; it0 < 16 * 256 * 128; it0 += gsz * 2) {
    float2 a2[2]; float4 b4[2][4];
#pragma unroll
    for (int u = 0; u < 2; ++u) {
      const int it = it0 + u * gsz;
      if (it < 16 * 256 * 128) {
        const int kc = it & 127, gn = it >> 7, n = gn & 255, g = gn >> 8;
        const int d = n >> 7, pp = n & 63, k0 = kc * 8, s = k0 >> 4, jb = k0 & 15;
        a2[u] = pw[(((size_t)d * 16 + g) * 65 + (d ? s : 63 - s)) * 64 + pp];
        const float4* q_ = (const float4*)(bbv + (((size_t)d * 16 + g) * 64 + pp) * 16 + jb);
        b4[u][0] = q_[0]; b4[u][1] = q_[1]; b4[u][2] = q_[2]; b4[u][3] = q_[3];
      }
    }
#pragma unroll
    for (int u = 0; u < 2; ++u) {
      const int it = it0 + u * gsz;
      if (it < 16 * 256 * 128) {
        const int kc = it & 127, gn = it >> 7, n = gn & 255, ri = (n >> 6) & 1, k0 = kc * 8;
        const float2 a = a2[u];
        const float bx[8] = {b4[u][0].x, b4[u][0].z, b4[u][1].x, b4[u][1].z, b4[u][2].x, b4[u][2].z, b4[u][3].x, b4[u][3].z};
        const float by[8] = {b4[u][0].y, b4[u][0].w, b4[u][1].y, b4[u][1].w, b4[u][2].y, b4[u][2].w, b4[u][3].y, b4[u][3].w};
        float v[8];
#pragma unroll
        for (int e = 0; e < 8; ++e) v[e] = ri == 0 ? (a.x * bx[e] - a.y * by[e]) : (a.x * by[e] + a.y * bx[e]);
        u32x4 o; o[0] = pack2(v[0], v[1]); o[1] = pack2(v[2], v[3]); o[2] = pack2(v[4], v[5]); o[3] = pack2(v[6], v[7]);
        *(u32x4*)(b1 + ((size_t)gn * 1024 + k0)) = o;
      }
    }
  }
}

DI void phase_rows(const Params& p, int l, float rscale = 1.f) {
  char* ws = p.ws; asm volatile("" : "+s"(ws));
  const int tid_ = otid(), lane = tid_ & 63, gw = blockIdx.x * 8 + (tid_ >> 6), nw = gridDim.x * 8;
  bf16_t* X = (bf16_t*)(ws + O_X);
  bf16_t* H1 = (bf16_t*)(ws + O_H1);
  const unsigned char* Y = (const unsigned char*)(ws + O_R);
  const int* slot = (const int*)(ws + O_SLOT);
  const float* gwt = (const float*)(ws + O_GW);
  const int* cnt = (const int*)(ws + O_CNT);
  const float* ada = (const float*)(ws + O_ADA);
  int poff64 = 0;
  if (l > 0) { for (int e = 0; e < 64; ++e) poff64 += (cnt[e] + 255) & ~255; }
  for (int row = gw; row < NTOK; row += nw) {
    int b, isctx, t; tokinfo(row, b, isctx, t);
    const int cv = isctx ? 2 : b;
    float xv[16];
    if (l == 0) {
      const float* src = isctx ? p.ctx + (size_t)(b * 256 + t) * 1024 : p.x + (size_t)row * 1024;
#pragma unroll
      for (int i = 0; i < 4; ++i) { const float4 v = *(const float4*)(src + i * 256 + lane * 4); xv[i * 4] = v.x; xv[i * 4 + 1] = v.y; xv[i * 4 + 2] = v.z; xv[i * 4 + 3] = v.w; }
    } else {
      const bf16_t* src = X + (size_t)row * 1024;
#pragma unroll
      for (int i = 0; i < 4; ++i) { const u32x2 v = *(const u32x2*)(src + i * 256 + lane * 4);
        xv[i * 4] = __uint_as_float(v[0] << 16); xv[i * 4 + 1] = __uint_as_float(v[0] & 0xffff0000u); xv[i * 4 + 2] = __uint_as_float(v[1] << 16); xv[i * 4 + 3] = __uint_as_float(v[1] & 0xffff0000u); }
      float f[16];
      typedef float fl2v __attribute__((ext_vector_type(2)));
      {
        const bf16_t* ys = (const bf16_t*)(ws + O_R + (size_t)YROWS * 1024) + (size_t)row * 1024;
#pragma unroll
        for (int i = 0; i < 4; ++i) { const u32x2 v = *(const u32x2*)(ys + i * 256 + lane * 4);
          f[i * 4] = rscale * __uint_as_float(v[0] << 16); f[i * 4 + 1] = rscale * __uint_as_float(v[0] & 0xffff0000u); f[i * 4 + 2] = rscale * __uint_as_float(v[1] << 16); f[i * 4 + 3] = rscale * __uint_as_float(v[1] & 0xffff0000u); }
      }
      int sv = 0; float wv = 0.f;
      if (lane < 6) { sv = slot[row * 6 + lane]; wv = gwt[row * 6 + lane] * rscale * 0.0625f; }
      int yv[6][4];
#pragma unroll
      for (int k = 0; k < 6; ++k) {
        const int s = __builtin_amdgcn_readlane(sv, k);
        const unsigned char* ys = Y + (size_t)s * 1024;
#pragma unroll
        for (int i = 0; i < 4; ++i) yv[k][i] = *(const int*)(ys + i * 256 + lane * 4);
      }
#pragma unroll
      for (int k = 0; k < 6; ++k) {
        const float w = __int_as_float(__builtin_amdgcn_readlane(__float_as_int(wv), k));
#pragma unroll
        for (int i = 0; i < 4; ++i) {
          const fl2v lo = __builtin_amdgcn_cvt_pk_f32_fp8(yv[k][i], false), hi = __builtin_amdgcn_cvt_pk_f32_fp8(yv[k][i], true);
          f[i * 4] += w * lo[0]; f[i * 4 + 1] += w * lo[1]; f[i * 4 + 2] += w * hi[0]; f[i * 4 + 3] += w * hi[1]; }
      }
      const float* gt2 = ada + ((l - 1) * 3 + cv) * 6144 + 5 * 1024;
#pragma unroll
      for (int i = 0; i < 4; ++i) { const float4 g = *(const float4*)(gt2 + i * 256 + lane * 4);
        xv[i * 4] += g.x * f[i * 4]; xv[i * 4 + 1] += g.y * f[i * 4 + 1]; xv[i * 4 + 2] += g.z * f[i * 4 + 2]; xv[i * 4 + 3] += g.w * f[i * 4 + 3]; }
    }
    float ss = 0.f;
#pragma unroll
    for (int i = 0; i < 16; ++i) ss += xv[i] * xv[i];
    ss = wave_sum(ss, lane);
    const float rstd = rsqrtf(ss * (1.f / 1024.f) + EPS);
    if (l < DEPTH) {
      bf16_t* dst = X + (size_t)row * 1024;
#pragma unroll
      for (int i = 0; i < 4; ++i) { u32x2 o2; o2[0] = pack2(xv[i * 4], xv[i * 4 + 1]); o2[1] = pack2(xv[i * 4 + 2], xv[i * 4 + 3]); *(u32x2*)(dst + i * 256 + lane * 4) = o2; }
      const float* gn = p.g_norm1 + l * 1024;
      const float* sh = ada + (l * 3 + cv) * 6144;
      const float* sc = sh + 1024;
      bf16_t* hd = H1 + (size_t)row * 1024;
#pragma unroll
      for (int i = 0; i < 4; ++i) {
        const int o = i * 256 + lane * 4;
        const float4 g = *(const float4*)(gn + o), s1 = *(const float4*)(sh + o), s2 = *(const float4*)(sc + o);
        const float h0 = xv[i * 4] * rstd * g.x * (1.f + s2.x) + s1.x, h1 = xv[i * 4 + 1] * rstd * g.y * (1.f + s2.y) + s1.y;
        const float h2 = xv[i * 4 + 2] * rstd * g.z * (1.f + s2.z) + s1.z, h3 = xv[i * 4 + 3] * rstd * g.w * (1.f + s2.w) + s1.w;
        u32x2 o2; o2[0] = pack2(h0, h1); o2[1] = pack2(h2, h3);
        *(u32x2*)(hd + o) = o2;
      }
    } else if (!isctx) {
      float* dst = p.out + (size_t)row * 1024;
#pragma unroll
      for (int i = 0; i < 4; ++i) {
        const int o = i * 256 + lane * 4;
        const float4 g = *(const float4*)(p.g_final + o);
        *(float4*)(dst + o) = make_float4(xv[i * 4] * rstd * g.x, xv[i * 4 + 1] * rstd * g.y, xv[i * 4 + 2] * rstd * g.z, xv[i * 4 + 3] * rstd * g.w);
      }
    }
  }
}

#define EPI_ROW_BEGIN \
  _Pragma("unroll") for (int m = 0; m < 4; ++m) { \
    int row = m0 + wr * 64 + m * 16 + fr; asm volatile("" : "+v"(row)); \
    int b, isctx, t; tokinfo(row, b, isctx, t); const int kidx = isctx ? SEQ + t : t; (void)kidx;
#define EPI_ROW_END }
DI f32x4 rope4(const f32x4& v, int c4, int half, int t, const float2* roper, const float2* ropec) {
  f32x4 r;
#pragma unroll
  for (int j = 0; j < 4; ++j) { const float partner = xhalf_get(v[j], c4 >> 3); r[j] = rope_apply(v[j], partner, c4 + j, half, t, roper, ropec); }
  return r;
}
DI void phase_proj(const Params& p, char* lds) {
  char* ws = p.ws; asm volatile("" : "+s"(ws));
  const float2* roper = (const float2*)(ws + O_ROPER);
  const float2* ropec = (const float2*)(ws + O_ROPEC);
  const UM um(130, 9);
  int mt, ntile;
  for (int k = 0; um.get(k, mt, ntile); ++k) {
    const int m0 = mt * 256, n0 = ntile * 256;
    f32x4 acc[2][2][4][2]; zero_acc8(acc);
    asm volatile("s_waitcnt vmcnt(0)" ::: "memory");
    gemm8<false>(acc, (const bf16_t*)(ws + O_H1), nullptr, m0, (const bf16_t*)(ws + O_WIN) + (size_t)n0 * 1024, (const bf16_t*)(ws + O_WIN) + (size_t)(n0 + 128) * 1024, 1024, lds);
    const int tid = otid(), lane = tid & 63, wid = tid >> 6, wr = wid >> 2, wc = wid & 3, fr = lane & 15, fq = lane >> 4, c4 = fq * 4;
#define EPI8_BEGIN \
    _Pragma("unroll") for (int ai = 0; ai < 2; ++ai) _Pragma("unroll") for (int m = 0; m < 4; ++m) { \
      int row = m0 + ai * 128 + wr * 64 + m * 16 + fr; asm volatile("" : "+v"(row)); \
      int b, isctx, t; tokinfo(row, b, isctx, t); const int kidx = isctx ? SEQ + t : t; (void)kidx; \
      _Pragma("unroll") for (int n = 0; n < 2; ++n) { const int c16 = cb + wc * 32 + n * 16; const f32x4 v = acc[ai][bj][m][n];
#define EPI8_END } }
#pragma unroll
    for (int bj = 0; bj < 2; ++bj) {
      const int cb = n0 + bj * 128, ont = cb >> 7;
      if (ont < 6) {
        const int which = cb >> 8;
        bf16_t* dst = (bf16_t*)(ws + (which == 0 ? O_QN : (which == 1 ? O_KN : O_VN)));
        const float sc = which == 0 ? NA_QS : 1.f;
        EPI8_BEGIN
          const int head = (c16 >> 6) & 3, d = (c16 & 63) + c4;
          bf16_t* hb = dst + (size_t)(b * 4 + head) * KLEN * 64;
          const size_t off = which == 0 ? (size_t)kidx * 64 + d : (which == 1 ? kimg<64>(kidx, d) : vimg(kidx, d));
          *(u32x2*)(hb + off) = pack4(v * sc);
        EPI8_END
      } else if (ont < 10) {
        const int isk = ont >= 8;
        bf16_t *QdL = (bf16_t*)(ws + O_QDL), *QdR = (bf16_t*)(ws + O_QDR), *Kd = (bf16_t*)(ws + O_KD);
        EPI8_BEGIN
          const int cc = c16 - (isk ? 1024 : 768), head8 = cc >> 5, half = (cc >> 4) & 1, d = half * 16 + c4;
          const f32x4 rv = rope4(v, c4, half, t, roper, ropec);
          if (!isk) {
            *(u32x2*)(QdR + ((size_t)(b * 8 + head8) * KLEN + kidx) * 32 + d) = pack4(v * DIFF_QS);
            if (!isctx) *(u32x2*)(QdL + ((size_t)(b * 8 + head8) * SEQ + t) * 32 + d) = pack4(rv * DIFF_QS);
          } else {
            *(u32x2*)(Kd + (size_t)(b * 8 + head8) * KLEN * 32 + kimg<32>(kidx, d)) = pack4(isctx ? v : rv);
          }
        EPI8_END
      } else if (ont < 12) {
        bf16_t* Vd = (bf16_t*)(ws + O_VD);
        EPI8_BEGIN
          const int cc = c16 - 1280, head = cc >> 6, d = (cc & 63) + c4;
          *(u32x2*)(Vd + (size_t)(b * 4 + head) * KLEN * 64 + vimg(kidx, d)) = pack4(v);
        EPI8_END
      } else if (ont < 15) {
        bf16_t* dst = ont < 14 ? (bf16_t*)(ws + O_CQ) : (bf16_t*)(ws + O_CKV);
        const int ldd = ont < 14 ? 256 : 128, base = ont < 14 ? 1536 : 1792;
        EPI8_BEGIN
          *(u32x2*)(dst + (size_t)row * ldd + (c16 - base) + c4) = pack4(v);
        EPI8_END
      } else {
        bf16_t *Km = (bf16_t*)(ws + O_KM), *Uc = (bf16_t*)(ws + O_UCAT);
        EPI8_BEGIN
          if (c16 < 1952) {
            const int half = ((c16 - 1920) >> 4) & 1, d = half * 16 + c4;
            const f32x4 rv = rope4(v, c4, half, t, roper, ropec);
            const u32x2 o = pack4(isctx ? v : rv);
#pragma unroll
            for (int h = 0; h < 4; ++h) *(u32x2*)(Km + (size_t)(b * 4 + h) * KLEN * 96 + kimg<96>(kidx, 64 + d)) = o;
          } else if (c16 < 2208) {
            const int g = (c16 - 1952) >> 4;
            const int sp = isctx ? t : 256 + t;
            *(u32x2*)(Uc + ((size_t)(g * 520 + b * NCHUNK + (sp >> 6)) * 1280) + (sp & 63) * 16 + c4) = pack4(v);
          }
        EPI8_END
      }
    }
#undef EPI8_BEGIN
#undef EPI8_END
  }
}

template <int NI>
DI void row_scales(const bf16_t* A, int row0, int kd, float* rs, int lane) {
  const int r_ = lane >> 2, q_ = lane & 3;
  u32x4 v[2][NI];
#pragma unroll
  for (int ps = 0; ps < 2; ++ps)
#pragma unroll
    for (int i = 0; i < NI; ++i) v[ps][i] = *(const u32x4*)(A + (size_t)(row0 + ps * 16 + r_) * kd + (i * 4 + q_) * 8);
#pragma unroll
  for (int ps = 0; ps < 2; ++ps) {
    float s = 0.f;
#pragma unroll
    for (int i = 0; i < NI; ++i)
#pragma unroll
      for (int e = 0; e < 4; ++e) { const float a = __uint_as_float(v[ps][i][e] << 16), b_ = __uint_as_float(v[ps][i][e] & 0xffff0000u); s += a * a; s += b_ * b_; }
    s += bperm(s, lane ^ 1); s += bperm(s, lane ^ 2);
    if (q_ == 0) rs[ps * 16 + r_] = rsqrtf(s / (float)kd + EPS);
  }
}
DI void phase_up(const Params& p, char* lds) {
  char* ws = p.ws; asm volatile("" : "+s"(ws));
  const int tid = otid(), lane = tid & 63, wid = tid >> 6, wr = wid >> 1, wc = wid & 1, fr = lane & 15, fq = lane >> 4, c4 = fq * 4;
  const float2* roper = (const float2*)(ws + O_ROPER);
  const float2* ropec = (const float2*)(ws + O_ROPEC);
  const bf16_t *CQ = (const bf16_t*)(ws + O_CQ), *CKV = (const bf16_t*)(ws + O_CKV);
  bf16_t *QmL = (bf16_t*)(ws + O_QML), *QmR = (bf16_t*)(ws + O_QMR), *Km = (bf16_t*)(ws + O_KM), *Vm = (bf16_t*)(ws + O_VM);
  float* rs = (float*)(lds + GEMM_LDS);
  auto job = [&](int u) {
    if (u < 390) return gj_make(CQ, nullptr, 256, (u / 3) * 256, (const bf16_t*)(ws + O_WUQ), 256, (u % 3) * 128, 256);
    if (u < 910) { const int uu = u - 390; return gj_make(CKV, nullptr, 128, (uu / 4) * 256, (const bf16_t*)(ws + O_WUKV), 128, (uu % 4) * 128, 128); }
    if (u < 1006) { const int uu = u - 910, g = uu / 6; return gj_make((const bf16_t*)(ws + O_UCAT) + (size_t)g * 520 * 1280, nullptr, 1280, ((uu % 6) >> 1) * 256, (const bf16_t*)(ws + O_S5B1) + (size_t)g * 256 * 1024, 1024, (uu & 1) * 128, 1024); }
    return gj_none();
  };
  GStream<GNST> gs; gs.start(job(blockIdx.x), lds, tid);
  for (int u = blockIdx.x; u < 1006; u += gridDim.x) {
    f32x4 acc[4][4]; zero_acc(acc);
    if (u < 910) {
      const bool isq = u < 390;
      const int uu = isq ? u : u - 390;
      const int mt = isq ? uu / 3 : uu / 4, ntile = isq ? uu % 3 : uu % 4, m0 = mt * 256, n0 = ntile * 128;
      const int kd = isq ? 256 : 128;
      const bf16_t* A = isq ? CQ : CKV;
      if (isq) row_scales<8>(A, m0 + wid * 32, 256, rs + wid * 32, lane); else row_scales<4>(A, m0 + wid * 32, 128, rs + wid * 32, lane);
      gs.run2(acc, job(u + gridDim.x));
#pragma unroll
      for (int m = 0; m < 4; ++m) {
        int lr = wr * 64 + m * 16 + fr;
        asm volatile("" : "+v"(lr));
        const int row = m0 + lr;
        int b, isctx, t; tokinfo(row, b, isctx, t);
        const int kidx = isctx ? SEQ + t : t;
        const float rsc = rs[lr];
#pragma unroll
        for (int n = 0; n < 4; ++n) {
          const int c16 = n0 + wc * 64 + n * 16;
          if (isq) {
            const int head = c16 / 96, dd = c16 % 96, d = dd + c4;
            const f32x4 v = acc[m][n] * (rsc * MLA_QS);
            bf16_t* qr_ = QmR + ((size_t)(b * 4 + head) * KLEN + kidx) * 96 + d;
            bf16_t* ql_ = QmL + ((size_t)(b * 4 + head) * SEQ + t) * 96 + d;
            if (dd < 64) {
              const u32x2 o = pack4(v);
              *(u32x2*)qr_ = o;
              if (!isctx) *(u32x2*)ql_ = o;
            } else {
              const f32x4 rv = rope4(v, c4, (dd >> 4) & 1, t, roper, ropec);
              *(u32x2*)qr_ = pack4(v);
              if (!isctx) *(u32x2*)ql_ = pack4(rv);
            }
          } else {
            const int head = c16 >> 7, dd = c16 & 127, d = dd + c4;
            const f32x4 v = acc[m][n] * rsc;
            if (dd < 64) *(u32x2*)(Km + (size_t)(b * 4 + head) * KLEN * 96 + kimg<96>(kidx, d)) = pack4(v);
            else *(u32x2*)(Vm + (size_t)(b * 4 + head) * KLEN * 64 + vimg(kidx, d - 64)) = pack4(v);
          }
        }
      }
      asm volatile("s_waitcnt lgkmcnt(0)" ::: "memory"); __builtin_amdgcn_s_barrier();
    } else {
      const int uu = u - 910, g = uu / 6, mt = (uu % 6) >> 1, ntile = uu & 1, m0 = mt * 256, n0 = ntile * 128;
      gs.run2(acc, job(u + gridDim.x));
      float* sloc = (float*)(ws + O_SLOC) + (size_t)g * 520 * 256;
#pragma unroll
      for (int m = 0; m < 4; ++m) {
        const int row = m0 + wr * 64 + m * 16 + fr;
        if (row < 520) {
#pragma unroll
          for (int n = 0; n < 4; ++n) *(f32x4*)(sloc + (size_t)row * 256 + n0 + wc * 64 + n * 16 + c4) = acc[m][n];
        }
      }
    }
  }
}

constexpr int ATT_NST = 4, ATT_STG = 20480, ATT_RPB = ATT_NST * ATT_STG, ATT_LDS = ATT_RPB + 2048;
template <int DK, int NMAP, int MODE, bool FAST>
DI void attn_unit(const bf16_t* const (&Qlat)[NMAP], const bf16_t* const (&Qraw)[NMAP], const bf16_t* const (&Kp)[NMAP], const bf16_t* Vp,
                  int qb, char* lds, float (&lout)[NMAP], f32x16 (&o)[NMAP][2], const float* rpbL) {
  constexpr int KS = DK / 16, KMAP = DK * 128, KBYTES = NMAP * KMAP;
  constexpr int NPOS = KBYTES / 16, KR = (NPOS + NTHR - 1) / NTHR, LPS = KR + 1;
  const int tid = otid(), lane = tid & 63, wid = tid >> 6, r32 = lane & 31, hi = lane >> 5;
  const int qrow = (MODE == 2 ? SEQ : qb * 256) + wid * 32 + r32;
  bf16x8 qf[NMAP][KS];
#pragma unroll
  for (int m = 0; m < NMAP; ++m)
#pragma unroll
    for (int s = 0; s < KS; ++s) qf[m][s] = *(const bf16x8*)((MODE == 0 ? Qlat[m] : Qraw[m]) + (size_t)qrow * DK + s * 16 + hi * 8);
  float mrun[NMAP], lrun[NMAP];
#pragma unroll
  for (int m = 0; m < NMAP; ++m) { mrun[m] = -1e30f; lrun[m] = 0.f; o[m][0] = f32x16{}; o[m][1] = f32x16{}; }
  int kt_lo = 0, kt_hi = 260;
  const int rq = qb * 4 + (wid >> 1), cq = (wid & 1) * 32 + r32;
  if (MODE == 1) { int lo = qb * 4 - 4; lo = lo < 0 ? 0 : (lo > 248 ? 248 : lo); int hi_ = qb * 4 + 3 - 4; hi_ = hi_ < 0 ? 0 : (hi_ > 248 ? 248 : hi_); kt_lo = lo; kt_hi = hi_ + 8; }
  if (MODE == 2) { kt_lo = 256; kt_hi = 260; }
  const int ntile = (MODE == 1) ? (kt_hi - kt_lo + 4) : (kt_hi - kt_lo);
  auto tile_of = [&](int i) { return (MODE == 1 && i >= kt_hi - kt_lo) ? 256 + (i - (kt_hi - kt_lo)) : kt_lo + i; };
  const bf16_t* ksrc[KR];
  int kdst[KR];
#pragma unroll
  for (int i = 0; i < KR; ++i) {
    int q = tid + i * NTHR; if (q >= NPOS) q -= NTHR;
    const int m = q / (KMAP / 16), w = q % (KMAP / 16);
    ksrc[i] = ((NMAP == 2 && m == 1) ? Kp[NMAP - 1] : Kp[0]) + w * 8;
    kdst[i] = q * 16;
  }
  const bf16_t* vsrc = Vp + tid * 8;
  auto issue = [&](int i) {
    const int kt = tile_of(i);
    char* sb = lds + (i % ATT_NST) * ATT_STG;
#pragma unroll
    for (int r = 0; r < KR; ++r) glds16(ksrc[r] + (size_t)kt * 64 * DK, (unsigned)__builtin_amdgcn_readfirstlane((int)(unsigned)(uintptr_t)(sb + kdst[r])));
    glds16(vsrc + (size_t)kt * 4096, (unsigned)__builtin_amdgcn_readfirstlane((int)(unsigned)(uintptr_t)(sb + KBYTES + tid * 16)));
  };
  const int voff = KBYTES + ((lane >> 4) & 1) * 32 + (lane & 3) * 8 + (4 * hi + ((lane & 15) >> 2)) * 64;
#pragma unroll
  for (int m = 0; m < NMAP; ++m)
#pragma unroll
    for (int s = 0; s < KS; ++s) asm volatile("" :: "v"(qf[m][s]));
  asm volatile("s_waitcnt vmcnt(0)" ::: "memory");
#pragma unroll
  for (int i = 0; i < ATT_NST - 1; ++i) if (i < ntile) issue(i);
  auto step = [&](int it) {
    const int kt = tile_of(it);
    {
      const int infl = (ntile - 1 - it) < (ATT_NST - 2) ? (ntile - 1 - it) : (ATT_NST - 2);
      if (infl >= 2) { if (LPS == 2) asm volatile("s_waitcnt vmcnt(4)" ::: "memory"); else asm volatile("s_waitcnt vmcnt(6)" ::: "memory"); }
      else if (infl == 1) { if (LPS == 2) asm volatile("s_waitcnt vmcnt(2)" ::: "memory"); else asm volatile("s_waitcnt vmcnt(3)" ::: "memory"); }
      else asm volatile("s_waitcnt vmcnt(0)" ::: "memory");
    }
    __builtin_amdgcn_s_barrier();
    char* buf = lds + (it % ATT_NST) * ATT_STG;
    bool active = true;
    int dr = 0;
    if (MODE == 1 && kt < 256) { int rs_ = rq - 4; rs_ = rs_ < 0 ? 0 : (rs_ > 248 ? 248 : rs_); active = (kt >= rs_) && (kt < rs_ + 8); dr = kt - rq + 7; }
    if (!active) { if (it + ATT_NST - 1 < ntile) issue(it + ATT_NST - 1); }
    if (active) {
      const char* vp0 = buf + voff;
      bf16x8 pf[NMAP][4];
#pragma unroll
      for (int m = 0; m < NMAP; ++m) {
        f32x16 s0 = f32x16{}, s1 = f32x16{};
        const char* kb = buf + m * KMAP + hi * 1024 + r32 * 16;
#pragma unroll
        for (int s = 0; s < KS; ++s) {
          const bf16x8 k0 = *(const bf16x8*)(kb + s * 2048);
          const bf16x8 k1 = *(const bf16x8*)(kb + s * 2048 + 512);
          s0 = MFMA32(k0, qf[m][s], s0);
          s1 = MFMA32(k1, qf[m][s], s1);
        }
        if (MODE == 1 && kt < 256) {
          int cs = cq - 8; cs = cs < 0 ? 0 : (cs > 48 ? 48 : cs);
#pragma unroll
          for (int r = 0; r < 16; ++r) {
            const int ck0 = crow(r, hi), ck1 = 32 + ck0;
            s0[r] = (ck0 >= cs && ck0 < cs + 16) ? s0[r] + rpbL[dr * 31 + (ck0 - cq + 15)] : -1e30f;
            s1[r] = (ck1 >= cs && ck1 < cs + 16) ? s1[r] + rpbL[dr * 31 + (ck1 - cq + 15)] : -1e30f;
          }
        }
        float ps = 0.f;
        if (FAST) {
#pragma unroll
          for (int r = 0; r < 16; ++r) { s0[r] = __builtin_amdgcn_exp2f(s0[r]); s1[r] = __builtin_amdgcn_exp2f(s1[r]); ps += s0[r] + s1[r]; }
          lrun[m] += ps;
        } else {
          float mx = fmaxf(s0[0], s1[0]);
#pragma unroll
          for (int r = 1; r < 16; ++r) mx = fmaxf(mx, fmaxf(s0[r], s1[r]));
          mx = xhalf_max(mx);
          const float mnew = fmaxf(mrun[m], mx);
          const float alpha = __builtin_amdgcn_exp2f(mrun[m] - mnew);
          mrun[m] = mnew;
#pragma unroll
          for (int r = 0; r < 16; ++r) { s0[r] = __builtin_amdgcn_exp2f(s0[r] - mnew); s1[r] = __builtin_amdgcn_exp2f(s1[r] - mnew); ps += s0[r] + s1[r]; }
          lrun[m] = lrun[m] * alpha + ps;
#pragma unroll
          for (int r = 0; r < 16; ++r) { o[m][0][r] *= alpha; o[m][1][r] *= alpha; }
        }
#pragma unroll
        for (int ks = 0; ks < 4; ++ks) {
          u32x4 pk;
#pragma unroll
          for (int e = 0; e < 4; ++e) {
            const int r = (ks & 1) * 8 + e * 2;
            pk[e] = (ks < 2) ? pack2(s0[r], s0[r + 1]) : pack2(s1[r], s1[r + 1]);
          }
          pf[m][ks] = __builtin_bit_cast(bf16x8, pk);
        }
      }
      if (it + ATT_NST - 1 < ntile) issue(it + ATT_NST - 1);
#pragma unroll
      for (int d0 = 0; d0 < 2; ++d0) {
        bf16x8 vf[4];
#pragma unroll
        for (int ks = 0; ks < 4; ++ks) {
          const s16x4 lo = __builtin_bit_cast(s16x4, __builtin_amdgcn_ds_read_tr16_b64_v4i16((__attribute__((address_space(3))) v4i16_t*)(vp0 + d0 * 4096 + ks * 1024)));
          const s16x4 hh = __builtin_bit_cast(s16x4, __builtin_amdgcn_ds_read_tr16_b64_v4i16((__attribute__((address_space(3))) v4i16_t*)(vp0 + d0 * 4096 + ks * 1024 + 512)));
          vf[ks] = bf16x8{lo[0], lo[1], lo[2], lo[3], hh[0], hh[1], hh[2], hh[3]};
        }
#pragma unroll
        for (int m = 0; m < NMAP; ++m)
#pragma unroll
          for (int ks = 0; ks < 4; ++ks) o[m][d0] = MFMA32(vf[ks], pf[m][ks], o[m][d0]);
      }
    }
  };
  const int n1 = MODE == 0 ? 256 : ntile;
#pragma unroll 1
  for (int it = 0; it < n1; ++it) step(it);
  if (MODE == 0) {
#pragma unroll
    for (int m = 0; m < NMAP; ++m)
#pragma unroll
      for (int s = 0; s < KS; ++s) qf[m][s] = *(const bf16x8*)(Qraw[m] + (size_t)qrow * DK + s * 16 + hi * 8);
#pragma unroll
    for (int m = 0; m < NMAP; ++m)
#pragma unroll
      for (int s = 0; s < KS; ++s) asm volatile("" :: "v"(qf[m][s]));
#pragma unroll 1
    for (int it = 256; it < ntile; ++it) step(it);
  }
#pragma unroll
  for (int m = 0; m < NMAP; ++m) lout[m] = xhalf(lrun[m]);
  __syncthreads();
}
DI bool lsum_bad(float l) { return !(l > 1e-18f && l < 1e18f); }
DI bool block_any(bool v, char* lds) {
  volatile LAS int* flg = (volatile LAS int*)(lds + ATT_RPB + 2032);
  if (otid() == 0) *flg = 0;
  __syncthreads();
  if (v) *flg = 1;
  __syncthreads();
  const int r = *flg;
  __syncthreads();
  return r != 0;
}

DI void attn_store(const float (&val)[2][16], bf16_t* ycat, int token, int colbase, int hi) {
#pragma unroll
  for (int d0 = 0; d0 < 2; ++d0)
#pragma unroll
    for (int g = 0; g < 4; ++g) {
      u32x2 v; v[0] = pack2(val[d0][4 * g], val[d0][4 * g + 1]); v[1] = pack2(val[d0][4 * g + 2], val[d0][4 * g + 3]);
      *(u32x2*)(ycat + (size_t)token * 1024 + colbase + d0 * 32 + 8 * g + 4 * hi) = v;
    }
}

template <int MODE>
DI void attn_diff(const Params& p, int l, int b, int h, int qb, char* lds) {
  char* ws = p.ws; asm volatile("" : "+s"(ws));
  const bf16_t* const ql[2] = {(const bf16_t*)(ws + O_QDL) + (size_t)(b * 8 + 2 * h) * SEQ * 32, (const bf16_t*)(ws + O_QDL) + (size_t)(b * 8 + 2 * h + 1) * SEQ * 32};
  const bf16_t* const qr[2] = {(const bf16_t*)(ws + O_QDR) + (size_t)(b * 8 + 2 * h) * KLEN * 32, (const bf16_t*)(ws + O_QDR) + (size_t)(b * 8 + 2 * h + 1) * KLEN * 32};
  const bf16_t* const kp[2] = {(const bf16_t*)(ws + O_KD) + (size_t)(b * 8 + 2 * h) * KLEN * 32, (const bf16_t*)(ws + O_KD) + (size_t)(b * 8 + 2 * h + 1) * KLEN * 32};
  const bf16_t* vp = (const bf16_t*)(ws + O_VD) + (size_t)(b * 4 + h) * KLEN * 64;
  float lo[2]; f32x16 o[2][2];
  attn_unit<32, 2, MODE, true>(ql, qr, kp, vp, qb, lds, lo, o, nullptr);
  if (block_any(lsum_bad(lo[0]) || lsum_bad(lo[1]), lds)) attn_unit<32, 2, MODE, false>(ql, qr, kp, vp, qb, lds, lo, o, nullptr);
  const int tid_ = otid(), lane = tid_ & 63, wid = tid_ >> 6, r32 = lane & 31, hi = lane >> 5;
  int lq = l; asm volatile("" : "+s"(lq));
  const float lam = ((const float*)(ws + O_LAMF))[lq];
  const float lam_init = 0.8f - 0.6f * expf(-0.3f * (float)lq);
  const float i0 = 1.f / lo[0], i1 = lam / lo[1];
  float d[2][16]; float ss = 0.f;
#pragma unroll
  for (int d0 = 0; d0 < 2; ++d0)
#pragma unroll
    for (int r = 0; r < 16; ++r) { d[d0][r] = o[0][d0][r] * i0 - o[1][d0][r] * i1; ss += d[d0][r] * d[d0][r]; }
  ss = xhalf(ss);
  const float rstd = rsqrtf(ss * (1.f / 64.f) + EPS) * (1.f - lam_init);
  const float* gs = p.g_diff + lq * 64;
#pragma unroll
  for (int d0 = 0; d0 < 2; ++d0)
#pragma unroll
    for (int r = 0; r < 16; ++r) d[d0][r] *= rstd * gs[d0 * 32 + crow(r, hi)];
  const int token = MODE == 2 ? NL + b * 256 + wid * 32 + r32 : b * SEQ + qb * 256 + wid * 32 + r32;
  attn_store(d, (bf16_t*)(ws + O_YCAT), token, 256 + h * 64, hi);
}
template <int MODE>
DI void attn_mla(const Params& p, int b, int h, int qb, char* lds) {
  char* ws = p.ws; asm volatile("" : "+s"(ws));
  const bf16_t* const ql[1] = {(const bf16_t*)(ws + O_QML) + (size_t)(b * 4 + h) * SEQ * 96};
  const bf16_t* const qr[1] = {(const bf16_t*)(ws + O_QMR) + (size_t)(b * 4 + h) * KLEN * 96};
  const bf16_t* const kp[1] = {(const bf16_t*)(ws + O_KM) + (size_t)(b * 4 + h) * KLEN * 96};
  const bf16_t* vp = (const bf16_t*)(ws + O_VM) + (size_t)(b * 4 + h) * KLEN * 64;
  float lo[1]; f32x16 o[1][2];
  attn_unit<96, 1, MODE, true>(ql, qr, kp, vp, qb, lds, lo, o, nullptr);
  if (block_any(lsum_bad(lo[0]), lds)) attn_unit<96, 1, MODE, false>(ql, qr, kp, vp, qb, lds, lo, o, nullptr);
  const int tid_ = otid(), lane = tid_ & 63, wid = tid_ >> 6, r32 = lane & 31, hi = lane >> 5;
  const float inv = 1.f / lo[0];
  float d[2][16];
#pragma unroll
  for (int d0 = 0; d0 < 2; ++d0)
#pragma unroll
    for (int r = 0; r < 16; ++r) d[d0][r] = o[0][d0][r] * inv;
  const int token = MODE == 2 ? NL + b * 256 + wid * 32 + r32 : b * SEQ + qb * 256 + wid * 32 + r32;
  attn_store(d, (bf16_t*)(ws + O_YCAT), token, 512 + h * 64, hi);
}
template <int MODE>
DI void attn_na(const Params& p, int l, int b, int h, int qb, char* lds) {
  char* ws = p.ws; asm volatile("" : "+s"(ws));
  float* rpbL = (float*)(lds + ATT_RPB);
  if (MODE == 1) {
    __syncthreads();
    for (int i = otid(); i < 465; i += NTHR) rpbL[i] = p.na_rpb[(size_t)(l * 4 + h) * 465 + i] * LOG2E;
    __syncthreads();
  }
  const bf16_t* const qr[1] = {(const bf16_t*)(ws + O_QN) + (size_t)(b * 4 + h) * KLEN * 64};
  const bf16_t* const kp[1] = {(const bf16_t*)(ws + O_KN) + (size_t)(b * 4 + h) * KLEN * 64};
  const bf16_t* vp = (const bf16_t*)(ws + O_VN) + (size_t)(b * 4 + h) * KLEN * 64;
  float lo[1]; f32x16 o[1][2];
  attn_unit<64, 1, MODE, true>(qr, qr, kp, vp, qb, lds, lo, o, rpbL);
  if (block_any(lsum_bad(lo[0]), lds)) attn_unit<64, 1, MODE, false>(qr, qr, kp, vp, qb, lds, lo, o, rpbL);
  const int tid_ = otid(), lane = tid_ & 63, wid = tid_ >> 6, r32 = lane & 31, hi = lane >> 5;
  const float inv = 1.f / lo[0];
  float d[2][16];
#pragma unroll
  for (int d0 = 0; d0 < 2; ++d0)
#pragma unroll
    for (int r = 0; r < 16; ++r) d[d0][r] = o[0][d0][r] * inv;
  const int token = MODE == 2 ? NL + b * 256 + wid * 32 + r32 : b * SEQ + qb * 256 + wid * 32 + r32;
  attn_store(d, (bf16_t*)(ws + O_YCAT), token, h * 64, hi);
}

DI void phase_attn(const Params& p, int l, char* lds) {
  char* ws = p.ws; asm volatile("" : "+s"(ws));
  if (blockIdx.x < 8) {
    const int id = blockIdx.x * NTHR + otid();
    const int pp = id & 63, d = (id >> 6) & 1, g = (id >> 7) & 15, b = id >> 11;
    const float2 a64 = ((const float2*)(ws + O_S5PW))[((((size_t)l * 2 + d) * 16 + g) * 65 + 64) * 64 + pp];
    const float* sloc = (const float*)(ws + O_SLOC) + ((size_t)g * 520 + b * NCHUNK) * 256 + d * 128 + pp;
    bf16_t* uc = (bf16_t*)(ws + O_UCAT) + ((size_t)g * 520 + b * NCHUNK) * 1280 + 1024 + d * 128 + pp;
    float hr = 0.f, hi_ = 0.f;
#pragma unroll 1
    for (int s0 = 0; s0 < NCHUNK; s0 += 26) {
      float sr[26], si[26];
#pragma unroll
      for (int j = 0; j < 26; ++j) { const int s = s0 + j, c = d == 0 ? s : (s < 4 ? 3 - s : 263 - s); sr[j] = sloc[(size_t)c * 256]; si[j] = sloc[(size_t)c * 256 + 64]; }
#pragma unroll
      for (int j = 0; j < 26; ++j) {
        const int s = s0 + j, c = d == 0 ? s : (s < 4 ? 3 - s : 263 - s);
        uc[(size_t)c * 1280] = f2bf(hr); uc[(size_t)c * 1280 + 64] = f2bf(hi_);
        const float nr = a64.x * hr - a64.y * hi_ + sr[j], ni = a64.x * hi_ + a64.y * hr + si[j];
        hr = nr; hi_ = ni;
      }
    }
  }
  int x = blockIdx.x & 7; asm volatile("" : "+s"(x));
  const int b = x >> 2, h = x & 3;
  int* qctr = (int*)(ws + O_QCTR) + x * 64;
  volatile LAS int* qw = (volatile LAS int*)(lds + ATT_RPB + 2040);
#pragma unroll 1
  for (;;) {
    if (otid() == 0) *qw = atomicAdd(qctr, 1);
    __syncthreads();
    const int item = *qw;
    __syncthreads();
    if (item >= 195) break;
    if (item < 64) attn_diff<0>(p, l, b, h, item, lds);
    else if (item < 128) attn_mla<0>(p, b, h, item - 64, lds);
    else if (item < 192) attn_na<1>(p, l, b, h, item - 128, lds);
    else if (item == 192) attn_diff<2>(p, l, b, h, 0, lds);
    else if (item == 193) attn_mla<2>(p, b, h, 0, lds);
    else attn_na<2>(p, l, b, h, 0, lds);
  }
}

DI void phase_s5out(const Params& p, char* lds) {
  char* ws = p.ws; asm volatile("" : "+s"(ws));
  bf16_t* G5 = (bf16_t*)(ws + O_G5);
  const UM um(48, 4);
  int gm, ntile;
  for (int k = 0; um.get(k, gm, ntile); ++k) {
    const int g = gm / 3, m0 = (gm % 3) * 256, n0 = ntile * 256;
    f32x4 acc[2][2][4][2]; zero_acc8(acc);
    asm volatile("s_waitcnt vmcnt(0)" ::: "memory");
    const bf16_t* bw = (const bf16_t*)(ws + O_S5B2) + ((size_t)g * 1024 + n0) * 1280;
    gemm8<false>(acc, (const bf16_t*)(ws + O_UCAT) + (size_t)g * 520 * 1280, nullptr, m0, bw, bw + (size_t)128 * 1280, 1280, lds);
    const int tid = otid(), lane = tid & 63, wid = tid >> 6, wr = wid >> 2, wc = wid & 3, fr = lane & 15, fq = lane >> 4, c4 = fq * 4;
#pragma unroll
    for (int ai = 0; ai < 2; ++ai)
#pragma unroll
      for (int m = 0; m < 4; ++m) {
        int row = m0 + ai * 128 + wr * 64 + m * 16 + fr; asm volatile("" : "+v"(row));
        if (row < 520) {
          const int b = row >= NCHUNK ? 1 : 0, chunk = row - b * NCHUNK;
#pragma unroll
          for (int bj = 0; bj < 2; ++bj)
#pragma unroll
            for (int n = 0; n < 2; ++n) {
              const int sp = chunk * 64 + ((n0 + bj * 128 + wc * 32) >> 4) + n;
              const int token = sp < 256 ? NL + b * 256 + sp : b * SEQ + sp - 256;
              f32x4 v = acc[ai][bj][m][n];
#pragma unroll
              for (int j = 0; j < 4; ++j) v[j] = gelu_tanh(v[j]);
              *(u32x2*)(G5 + (size_t)token * 256 + g * 16 + c4) = pack4(v);
            }
        }
      }
  }
}
DI void phase_glu(const Params& p, int l, char* lds) {
  char* ws = p.ws; asm volatile("" : "+s"(ws));
  const int tid = otid(), lane = tid & 63, wid = tid >> 6, wr = wid >> 1, wc = wid & 1, fr = lane & 15, fq = lane >> 4, c4 = fq * 4;
  const bf16_t* G5 = (const bf16_t*)(ws + O_G5);
  bf16_t* Yc = (bf16_t*)(ws + O_YCAT);
  const UM um(128, 2);
  auto job = [&](int k) { int mt, nt; return um.get(k, mt, nt) ? gj_make(G5, nullptr, 256, mt * 256, (const bf16_t*)(ws + O_WGLU), 256, nt * 128, 256) : gj_none(); };
  GStream<GNST> gs; gs.start(job(0), lds, tid);
  int mt, ntile;
  for (int k = 0; um.get(k, mt, ntile); ++k) {
    const int m0 = mt * 256, n0 = ntile * 128;
    f32x4 acc[4][4]; zero_acc(acc);
    gs.run2(acc, job(k + 1));
    u32x2 gqa[4][4];
#pragma unroll
    for (int m = 0; m < 4; ++m)
#pragma unroll
      for (int n = 0; n < 4; ++n) gqa[m][n] = *(const u32x2*)(G5 + (size_t)(m0 + wr * 64 + m * 16 + fr) * 256 + n0 + wc * 64 + n * 16 + c4);
#pragma unroll
    for (int m = 0; m < 4; ++m) {
      const int row = m0 + wr * 64 + m * 16 + fr;
#pragma unroll
      for (int n = 0; n < 4; ++n) {
        const int col = n0 + wc * 64 + n * 16 + c4;
        const u32x2 gq = gqa[m][n];
        const float4 bb = *(const float4*)(p.b_glu + l * 256 + col);
        f32x4 o;
        o[0] = __uint_as_float(gq[0] << 16) * sigm(acc[m][n][0] + bb.x);
        o[1] = __uint_as_float(gq[0] & 0xffff0000u) * sigm(acc[m][n][1] + bb.y);
        o[2] = __uint_as_float(gq[1] << 16) * sigm(acc[m][n][2] + bb.z);
        o[3] = __uint_as_float(gq[1] & 0xffff0000u) * sigm(acc[m][n][3] + bb.w);
        *(u32x2*)(Yc + (size_t)row * 1024 + 768 + col) = pack4(o);
      }
    }
  }
  {
    const int t2 = otid(), ln = t2 & 63, wv = t2 >> 6;
    for (int w = blockIdx.x * 8 + wv; w < 512; w += gridDim.x * 8) {
      const int row0 = NL + (w >> 4) * 16, col = (w & 15) * 16 + (ln & 15);
      f32x4 a4 = f32x4{0.f, 0.f, 0.f, 0.f};
      mini_gemm16(a4, G5 + (size_t)row0 * 256, 256, (const bf16_t*)(ws + O_WGLU) + (size_t)(w & 15) * 16 * 256, 256, 256, ln);
      const float bb = p.b_glu[l * 256 + col];
#pragma unroll
      for (int j = 0; j < 4; ++j) {
        const int row = row0 + 4 * (ln >> 4) + j;
        Yc[(size_t)row * 1024 + 768 + col] = f2bf(bf2f(G5[(size_t)row * 256 + col]) * sigm(a4[j] + bb));
      }
    }
  }
}
DI void phase_merge(const Params& p, char* lds) {
  char* ws = p.ws; asm volatile("" : "+s"(ws));
  const int tid = otid(), lane = tid & 63, wid = tid >> 6, wr = wid >> 1, wc = wid & 1, fr = lane & 15, fq = lane >> 4, c4 = fq * 4;
  bf16_t* Mb = (bf16_t*)(ws + O_MBUF);
  const UM um(128, 8);
  auto job = [&](int seq) {
    const int i = (seq >> 1) & 3; int mt_, nt_;
    if (!um.get(seq >> 3, mt_, nt_)) return gj_none();
    const int m0 = mt_ * 256, n0 = nt_ * 128;
    if (seq & 1) return gj_make((const bf16_t*)(ws + O_H1), nullptr, 1024, m0, (const bf16_t*)(ws + O_WG) + (size_t)i * 1024 * 1024, 1024, n0, 1024);
    return gj_make((const bf16_t*)(ws + O_YCAT) + i * 256, nullptr, 1024, m0, (const bf16_t*)(ws + O_WBR) + (size_t)i * 262144, 256, n0, 256);
  };
  GStream<GNST> gs; gs.start(job(0), lds, tid);
  int seq = 0, mt, ntile;
  for (int k = 0; um.get(k, mt, ntile); ++k) {
    const int m0 = mt * 256, n0 = ntile * 128;
    u32x2 mpk[4][4];
    for (int i = 0; i < 4; ++i) {
      u32x2 pk[4][4];
      {
        f32x4 acc[4][4]; zero_acc(acc);
        gs.run<true>(acc, job(seq + 1)); ++seq;
#pragma unroll
        for (int m = 0; m < 4; ++m)
#pragma unroll
          for (int n = 0; n < 4; ++n) pk[m][n] = pack4(acc[m][n]);
      }
      f32x4 acc[4][4]; zero_acc(acc);
      gs.run<true>(acc, job(seq + 1)); ++seq;
#pragma unroll
      for (int m = 0; m < 4; ++m)
#pragma unroll
        for (int n = 0; n < 4; ++n) {
          f32x4 t;
          t[0] = sigm(acc[m][n][0]) * __uint_as_float(pk[m][n][0] << 16);
          t[1] = sigm(acc[m][n][1]) * __uint_as_float(pk[m][n][0] & 0xffff0000u);
          t[2] = sigm(acc[m][n][2]) * __uint_as_float(pk[m][n][1] << 16);
          t[3] = sigm(acc[m][n][3]) * __uint_as_float(pk[m][n][1] & 0xffff0000u);
          if (i > 0) {
            t[0] += __uint_as_float(mpk[m][n][0] << 16); t[1] += __uint_as_float(mpk[m][n][0] & 0xffff0000u);
            t[2] += __uint_as_float(mpk[m][n][1] << 16); t[3] += __uint_as_float(mpk[m][n][1] & 0xffff0000u);
          }
          mpk[m][n] = pack4(t);
        }
    }
#pragma unroll
    for (int m = 0; m < 4; ++m) {
      const int row = m0 + wr * 64 + m * 16 + fr;
#pragma unroll
      for (int n = 0; n < 4; ++n) *(u32x2*)(Mb + (size_t)row * 1024 + n0 + wc * 64 + n * 16 + c4) = mpk[m][n];
    }
  }
  {
    const int t2 = otid(), lane = t2 & 63, wid = t2 >> 6;
    for (int w = blockIdx.x * 8 + wid; w < 2048; w += gridDim.x * 8) {
      const int row0 = NL + (w >> 6) * 16, col0 = (w & 63) * 16;
      f32x4 macc = f32x4{0.f, 0.f, 0.f, 0.f};
      for (int i = 0; i < 4; ++i) {
        f32x4 ab = f32x4{0.f, 0.f, 0.f, 0.f}, ag = f32x4{0.f, 0.f, 0.f, 0.f};
        mini_gemm16(ab, (const bf16_t*)(ws + O_YCAT) + (size_t)row0 * 1024 + i * 256, 1024, (const bf16_t*)(ws + O_WBR) + (size_t)i * 262144 + (size_t)col0 * 256, 256, 256, lane);
        mini_gemm16(ag, (const bf16_t*)(ws + O_H1) + (size_t)row0 * 1024, 1024, (const bf16_t*)(ws + O_WG) + ((size_t)i * 1024 + col0) * 1024, 1024, 1024, lane);
#pragma unroll
        for (int j = 0; j < 4; ++j) macc[j] += sigm(ag[j]) * ab[j];
      }
#pragma unroll
      for (int j = 0; j < 4; ++j) Mb[(size_t)(row0 + 4 * (lane >> 4) + j) * 1024 + col0 + (lane & 15)] = f2bf(macc[j]);
    }
  }
}
DI void phase_outproj(const Params& p, int l, char* lds, float rscale = 1.f) {
  char* ws = p.ws; asm volatile("" : "+s"(ws));
  bf16_t* X = (bf16_t*)(ws + O_X);
  const float* ada = (const float*)(ws + O_ADA);
  const UM um(128, 4);
  int mt, ntile;
  for (int k = 0; um.get(k, mt, ntile); ++k) {
    const int m0 = mt * 256, n0 = ntile * 256;
    f32x4 acc[2][2][4][2]; zero_acc8(acc);
    asm volatile("s_waitcnt vmcnt(0)" ::: "memory");
    gemm8<false>(acc, (const bf16_t*)(ws + O_MBUF), nullptr, m0, (const bf16_t*)(ws + O_WOUT) + (size_t)n0 * 1024, (const bf16_t*)(ws + O_WOUT) + (size_t)(n0 + 128) * 1024, 1024, lds);
    const int tid = otid(), lane = tid & 63, wid = tid >> 6, wr = wid >> 2, wc = wid & 3, fr = lane & 15, fq = lane >> 4;
    const int cv = m0 < NL ? (m0 >> 14) : 2;
    const float* gt = ada + (l * 3 + cv) * 6144 + 2 * 1024 + n0 + wc * 32 + fq * 4;
    float4 g[2][2];
#pragma unroll
    for (int bj = 0; bj < 2; ++bj)
#pragma unroll
      for (int n = 0; n < 2; ++n) g[bj][n] = *(const float4*)(gt + bj * 128 + n * 16);
#pragma unroll
    for (int ai = 0; ai < 2; ++ai) {
      u32x2 xo[4][2][2];
#pragma unroll
      for (int m = 0; m < 4; ++m)
#pragma unroll
        for (int bj = 0; bj < 2; ++bj)
#pragma unroll
          for (int n = 0; n < 2; ++n)
            xo[m][bj][n] = *(const u32x2*)(X + (size_t)(m0 + ai * 128 + wr * 64 + m * 16 + fr) * 1024 + n0 + bj * 128 + wc * 32 + n * 16 + fq * 4);
#pragma unroll
      for (int m = 0; m < 4; ++m)
#pragma unroll
        for (int bj = 0; bj < 2; ++bj)
#pragma unroll
          for (int n = 0; n < 2; ++n) {
            const u32x2 xv = xo[m][bj][n]; const f32x4 av = acc[ai][bj][m][n]; const float4 gg = g[bj][n];
            u32x2 xn;
            xn[0] = pack2(__uint_as_float(xv[0] << 16) + rscale * gg.x * av[0], __uint_as_float(xv[0] & 0xffff0000u) + rscale * gg.y * av[1]);
            xn[1] = pack2(__uint_as_float(xv[1] << 16) + rscale * gg.z * av[2], __uint_as_float(xv[1] & 0xffff0000u) + rscale * gg.w * av[3]);
            *(u32x2*)(X + (size_t)(m0 + ai * 128 + wr * 64 + m * 16 + fr) * 1024 + n0 + bj * 128 + wc * 32 + n * 16 + fq * 4) = xn;
          }
    }
  }
  const int tid = otid(), lane = tid & 63, wid = tid >> 6;
  (void)lane; (void)wid;
  {
    const int t2 = otid(), lane = t2 & 63, wid = t2 >> 6;
    for (int w = blockIdx.x * 8 + wid; w < 2048; w += gridDim.x * 8) {
      const int row0 = NL + (w >> 6) * 16, col0 = (w & 63) * 16;
      f32x4 acc = f32x4{0.f, 0.f, 0.f, 0.f};
      mini_gemm16(acc, (const bf16_t*)(ws + O_MBUF) + (size_t)row0 * 1024, 1024, (const bf16_t*)(ws + O_WOUT) + (size_t)col0 * 1024, 1024, 1024, lane);
      const float g = ada[(l * 3 + 2) * 6144 + 2 * 1024 + col0 + (lane & 15)];
      bf16_t xold[4];
#pragma unroll
      for (int j = 0; j < 4; ++j) xold[j] = X[(size_t)(row0 + 4 * (lane >> 4) + j) * 1024 + col0 + (lane & 15)];
#pragma unroll
      for (int j = 0; j < 4; ++j) X[(size_t)(row0 + 4 * (lane >> 4) + j) * 1024 + col0 + (lane & 15)] = f2bf(bf2f(xold[j]) + rscale * g * acc[j]);
    }
  }
}
DI void phase_norm2(const Params& p, int l, char* lds) {
  char* ws = p.ws; asm volatile("" : "+s"(ws));
  const int tid = otid(), lane = tid & 63, w = tid >> 6, fr = lane & 15, fq = lane >> 4;
  const bf16_t* X = (const bf16_t*)(ws + O_X);
  bf16_t* H2 = (bf16_t*)(ws + O_H2);
  float* LG = (float*)(ws + O_LOGIT);
  const float* ada = (const float*)(ws + O_ADA);
  float* ssq = (float*)lds;
  float* red = (float*)(lds + 1024);
  float* tabG = (float*)(lds + 40960);
  float* tabS = tabG + 3072;
  for (int i = tid; i < 3072; i += NTHR) {
    const int cv_ = i >> 10, k_ = i & 1023;
    const float* a_ = ada + (l * 3 + cv_) * 6144 + 3 * 1024 + k_;
    tabG[i] = p.g_norm2[l * 1024 + k_] * (1.f + a_[1024]); tabS[i] = a_[0];
  }
  __syncthreads();
  const int kb = w * 128 + fq * 8;
  bf16x8 bh[4][4], bl[4][4];
#pragma unroll
  for (int e = 0; e < 4; ++e)
#pragma unroll
    for (int s_ = 0; s_ < 4; ++s_) {
      const size_t off = (size_t)(e * 16 + fr) * 1024 + kb + s_ * 32;
      bh[e][s_] = *(const bf16x8*)((const bf16_t*)(ws + O_WRHI) + off);
      bl[e][s_] = *(const bf16x8*)((const bf16_t*)(ws + O_WRLO) + off);
    }
  const int ng = NTOK / 16;
  u32x4 xn[4];
  if ((int)blockIdx.x < ng) {
#pragma unroll
    for (int s_ = 0; s_ < 4; ++s_) xn[s_] = *(const u32x4*)(X + (size_t)(blockIdx.x * 16 + fr) * 1024 + kb + s_ * 32);
  }
#pragma unroll 1
  for (int gi = blockIdx.x; gi < ng; gi += gridDim.x) {
    const int row0 = gi * 16, row = row0 + fr, cv = row0 < NL ? (row0 >> 14) : 2;
    u32x4 xr[4];
#pragma unroll
    for (int s_ = 0; s_ < 4; ++s_) xr[s_] = xn[s_];
    if (gi + (int)gridDim.x < ng) {
#pragma unroll
      for (int s_ = 0; s_ < 4; ++s_) xn[s_] = *(const u32x4*)(X + (size_t)((gi + gridDim.x) * 16 + fr) * 1024 + kb + s_ * 32);
    }
    float ss = 0.f;
#pragma unroll
    for (int s_ = 0; s_ < 4; ++s_)
#pragma unroll
      for (int j = 0; j < 4; ++j) { const float a0 = __uint_as_float(xr[s_][j] << 16), a1 = __uint_as_float(xr[s_][j] & 0xffff0000u); ss += a0 * a0; ss += a1 * a1; }
    ss = xhalf(ss); ss += bperm(ss, lane ^ 16);
    if (fq == 0) ssq[w * 16 + fr] = ss;
    __syncthreads();
    float tot = 0.f;
#pragma unroll
    for (int w2 = 0; w2 < 8; ++w2) tot += ssq[w2 * 16 + fr];
    const float rstd = rsqrtf(tot * (1.f / 1024.f) + EPS);
    const float* gn = tabG + cv * 1024 + kb;
    const float* sh = tabS + cv * 1024 + kb;
    f32x4 acc[4];
#pragma unroll
    for (int e = 0; e < 4; ++e) acc[e] = f32x4{0.f, 0.f, 0.f, 0.f};
#pragma unroll
    for (int s_ = 0; s_ < 4; ++s_) {
      u32x4 ahi, alo;
#pragma unroll
      for (int q = 0; q < 2; ++q) {
        const float4 g = *(const float4*)(gn + s_ * 32 + q * 4), s1 = *(const float4*)(sh + s_ * 32 + q * 4);
        const unsigned u0 = xr[s_][q * 2], u1 = xr[s_][q * 2 + 1];
        const float h0 = __uint_as_float(u0 << 16) * rstd * g.x + s1.x, h1 = __uint_as_float(u0 & 0xffff0000u) * rstd * g.y + s1.y;
        const float h2 = __uint_as_float(u1 << 16) * rstd * g.z + s1.z, h3 = __uint_as_float(u1 & 0xffff0000u) * rstd * g.w + s1.w;
        const unsigned p0 = pack2(h0, h1), p1 = pack2(h2, h3);
        ahi[q * 2] = p0; ahi[q * 2 + 1] = p1;
        alo[q * 2] = pack2(h0 - __uint_as_float(p0 << 16), h1 - __uint_as_float(p0 & 0xffff0000u));
        alo[q * 2 + 1] = pack2(h2 - __uint_as_float(p1 << 16), h3 - __uint_as_float(p1 & 0xffff0000u));
      }
      *(u32x4*)(H2 + (size_t)row * 1024 + kb + s_ * 32) = ahi;
      const bf16x8 fh = __builtin_bit_cast(bf16x8, ahi), fl = __builtin_bit_cast(bf16x8, alo);
#pragma unroll
      for (int e = 0; e < 4; ++e) { acc[e] = MFMA16(fh, bh[e][s_], acc[e]); acc[e] = MFMA16(fl, bh[e][s_], acc[e]); acc[e] = MFMA16(fh, bl[e][s_], acc[e]); }
    }
#pragma unroll
    for (int e = 0; e < 4; ++e) *(f32x4*)(red + ((w * 4 + e) * 64 + lane) * 4) = acc[e];
    __syncthreads();
    if (tid < 256) {
      const int e = tid >> 6, ln = tid & 63;
      f32x4 sum = *(const f32x4*)(red + (e * 64 + ln) * 4);
#pragma unroll
      for (int w2 = 1; w2 < 8; ++w2) sum += *(const f32x4*)(red + ((w2 * 4 + e) * 64 + ln) * 4);
#pragma unroll
      for (int j = 0; j < 4; ++j) LG[(size_t)(row0 + (ln >> 4) * 4 + j) * 64 + e * 16 + (ln & 15)] = sum[j];
    }
  }
}
DI void phase_topk(const Params& p, int l, char* lds) {
  char* ws = p.ws; asm volatile("" : "+s"(ws));
  const int tid = otid(), lane = tid & 63, wid = tid >> 6;
  int* lcnt = (int*)lds;
  int* lbase = lcnt + 64;
  const float* LG = (const float*)(ws + O_LOGIT);
  int* IDX = (int*)(ws + O_IDX); float* GW = (float*)(ws + O_GW); int* RANK = (int*)(ws + O_SLOT);
  if (tid < 64) lcnt[tid] = 0;
  __syncthreads();
  const int rows_per = (NTOK + gridDim.x - 1) / gridDim.x;
  const int r0 = blockIdx.x * rows_per, r1 = min(NTOK, r0 + rows_per);
  const float eb = p.e_bias[l * 64 + lane];
  float lgv[17];
#pragma unroll
  for (int i = 0; i < 17; ++i) { const int row = r0 + wid + i * 8; lgv[i] = row < r1 ? LG[(size_t)row * 64 + lane] : 0.f; }
#pragma unroll
  for (int i = 0; i < 17; ++i) {
    const int row = r0 + wid + i * 8;
    if (row >= r1) break;
    const float score = sigm(lgv[i]);
    float sel = score + eb;
    float gsum = 0.f; int myk = -1;
    for (int k = 0; k < 6; ++k) {
      const float mx = wave_max(sel, lane);
      const unsigned long long bal = __ballot(sel == mx);
      const int win = __ffsll((long long)bal) - 1;
      const float sc_w = bperm(score, win);
      gsum += sc_w;
      if (lane == win) { sel = -1e30f; myk = k; }
    }
    if (myk >= 0) {
      const int lr = atomicAdd(&lcnt[lane], 1);
      IDX[row * 6 + myk] = lane; GW[row * 6 + myk] = score / gsum; RANK[row * 6 + myk] = lr;
    }
  }
  __syncthreads();
  if (tid < 64) lbase[tid] = atomicAdd((int*)(ws + O_CNT) + tid, lcnt[tid]);
  __syncthreads();
  for (int i = r0 * 6 + tid; i < r1 * 6; i += NTHR) RANK[i] += lbase[IDX[i]];
}

DI void phase_lists(const Params& p, char* lds) {
  char* ws = p.ws; asm volatile("" : "+s"(ws));
  const int tid = otid();
  int* poff = (int*)lds;
  const int* cnt = (const int*)(ws + O_CNT);
  if (tid == 0) { int a = 0; for (int e = 0; e < 64; ++e) { poff[e] = a; a += (cnt[e] + 255) & ~255; } poff[64] = a; }
  __syncthreads();
  int* SLOT = (int*)(ws + O_SLOT); const int* IDX = (const int*)(ws + O_IDX); int* ROWIDX = (int*)(ws + O_ROWIDX);
  for (int i = blockIdx.x * NTHR + tid; i < NTOK * 6; i += gridDim.x * NTHR) {
    const int s = poff[IDX[i]] + SLOT[i];
    SLOT[i] = s; ROWIDX[s] = i / 6;
  }
  for (int e = blockIdx.x; e < 64; e += gridDim.x) {
    const int c = cnt[e], pc = (c + 255) & ~255;
    for (int s = c + tid; s < pc; s += NTHR) ROWIDX[poff[e] + s] = 0;
  }
  for (int t = blockIdx.x * NTHR + tid; t < NTOK; t += gridDim.x * NTHR) ROWIDX[poff[64] + t] = t;
}
DI int find_expert(const int* poff, int slot0) { int e = 0; for (int i = 1; i < 64; ++i) e = (poff[i] <= slot0) ? i : e; return e; }

DI void phase_moe1(const Params& p, char* lds) {
  char* ws = p.ws; asm volatile("" : "+s"(ws));
  int* poff = (int*)(lds + LDS_POFF);
  {
    const int tid = otid();
    const int* cnt = (const int*)(ws + O_CNT);
    if (tid == 0) { int a = 0; for (int e = 0; e < 64; ++e) { poff[e] = a; a += (cnt[e] + 255) & ~255; } poff[64] = a; }
    __syncthreads();
  }
  const int TR = poff[64] >> 8;
  bf16_t* ACT = (bf16_t*)(ws + O_ACT);
  const bf16_t* H2 = (const bf16_t*)(ws + O_H2);
  const UM um(TR + 130, 2);
  int ti, ntile;
  for (int k = 0; um.get(k, ti, ntile); ++k) {
    const int f0 = ntile * 128, slot0 = ti * 256;
    const int e = ti < TR ? find_expert(poff, slot0) : 64;
    f32x4 acc[2][2][4][2]; zero_acc8(acc);
    asm volatile("s_waitcnt vmcnt(0)" ::: "memory");
    gemm8<true>(acc, H2, (const int*)(ws + O_ROWIDX), slot0, (const bf16_t*)(ws + O_WE1) + (size_t)e * 262144 + (size_t)f0 * 1024, (const bf16_t*)(ws + O_WE3) + (size_t)e * 262144 + (size_t)f0 * 1024, 1024, lds);
    const int tid = otid(), lane = tid & 63, wid = tid >> 6, wr = wid >> 2, wc = wid & 3, fr = lane & 15, fq = lane >> 4;
#pragma unroll
    for (int ai = 0; ai < 2; ++ai)
#pragma unroll
      for (int m = 0; m < 4; ++m) {
        const int row = slot0 + ai * 128 + wr * 64 + m * 16 + fr;
#pragma unroll
        for (int n = 0; n < 2; ++n) {
          const f32x4 g = acc[ai][0][m][n], u = acc[ai][1][m][n];
          f32x4 o;
#pragma unroll
          for (int j = 0; j < 4; ++j) o[j] = g[j] * sigm(g[j]) * u[j];
          *(u32x2*)(ACT + (size_t)row * 256 + f0 + wc * 32 + n * 16 + fq * 4) = pack4(o);
        }
      }
  }
}
DI void phase_moe2(const Params& p, char* lds) {
  char* ws = p.ws; asm volatile("" : "+s"(ws));
  const int tid = otid(), lane = tid & 63, wid = tid >> 6, wr = wid >> 1, wc = wid & 1, fr = lane & 15, fq = lane >> 4;
  int* poff = (int*)(lds + LDS_POFF);
  const int* cnt = (const int*)(ws + O_CNT);
  if (tid == 0) { int a = 0; for (int e = 0; e < 64; ++e) { poff[e] = a; a += (cnt[e] + 255) & ~255; } poff[64] = a; }
  __syncthreads();
  const int TR = poff[64] >> 8;
  const bf16_t* ACT = (const bf16_t*)(ws + O_ACT);
  unsigned char* Y = (unsigned char*)(ws + O_R);
  const UM um(TR + 130, 4);
  auto job = [&](int k) {
    int ti, nt_;
    if (!um.get(k, ti, nt_)) return gj_none();
    const int slot0 = ti * 256, e = ti < TR ? find_expert(poff, slot0) : 64;
    return gj_make(ACT, nullptr, 256, slot0, (const bf16_t*)(ws + O_WE2) + (size_t)e * 262144, 256, nt_ * 256, 256);
  };
  GStreamW gs; gs.start(job(0), lds, tid);
  int ti, ntile;
  for (int k = 0; um.get(k, ti, ntile); ++k) {
    const int n0 = ntile * 256, slot0 = ti * 256;
    f32x4 acc[4][8]; zero_accw(acc);
    gs.run(acc, job(k + 1));
    if (ti >= TR) {
      bf16_t* Ysh = (bf16_t*)(ws + O_R + (size_t)YROWS * 1024);
#pragma unroll
      for (int m = 0; m < 4; ++m) {
        const int row = (ti - TR) * 256 + wr * 64 + m * 16 + fr;
#pragma unroll
        for (int n = 0; n < 8; ++n) *(u32x2*)(Ysh + (size_t)row * 1024 + n0 + wc * 128 + n * 16 + fq * 4) = pack4(acc[m][n]);
      }
    } else
#pragma unroll
    for (int m = 0; m < 4; ++m) {
      const int row = slot0 + wr * 64 + m * 16 + fr;
#pragma unroll
      for (int hf = 0; hf < 2; ++hf) {
        unsigned a[4];
#pragma unroll
        for (int n = 0; n < 4; ++n) {
          const f32x4 v = acc[m][hf * 4 + n];
          const float q0 = __builtin_amdgcn_fmed3f(v[0] * 16.f, -448.f, 448.f), q1 = __builtin_amdgcn_fmed3f(v[1] * 16.f, -448.f, 448.f);
          const float q2 = __builtin_amdgcn_fmed3f(v[2] * 16.f, -448.f, 448.f), q3 = __builtin_amdgcn_fmed3f(v[3] * 16.f, -448.f, 448.f);
          int w = __builtin_amdgcn_cvt_pk_fp8_f32(q0, q1, 0, false);
          w = __builtin_amdgcn_cvt_pk_fp8_f32(q2, q3, w, true);
          a[n] = (unsigned)w;
        }
        const auto r01 = __builtin_amdgcn_permlane16_swap(a[0], a[1], false, false);
        const auto r23 = __builtin_amdgcn_permlane16_swap(a[2], a[3], false, false);
        const auto s02 = __builtin_amdgcn_permlane32_swap(r01[0], r23[0], false, false);
        const auto s13 = __builtin_amdgcn_permlane32_swap(r01[1], r23[1], false, false);
        *(u32x4*)(Y + (size_t)row * 1024 + n0 + wc * 128 + hf * 64 + fq * 16) = u32x4{s02[0], s13[0], s02[1], s13[1]};
      }
    }
  }
}

#define XB_TMO      128
#define XB_XCNT(j)  (256  + 64 * (j))
#define XB_XSUB(j)  (1280 + 64 * (j))
#define XB_XGEN(j)  (2304 + 64 * (j))
#define XB_TOP      3328
#define XB_TOPGEN   3392
#define XCD_BAR_WORDS 3456
#define XB_SPIN_CAP (1u << 21)
__device__ __forceinline__ unsigned xb_ld(unsigned* p)              { return __hip_atomic_load(p, __ATOMIC_RELAXED, __HIP_MEMORY_SCOPE_AGENT); }
__device__ __forceinline__ unsigned xb_add(unsigned* p, unsigned v) { return __hip_atomic_fetch_add(p, v, __ATOMIC_RELAXED, __HIP_MEMORY_SCOPE_AGENT); }
__device__ __forceinline__ unsigned xb_xcc_id() { return (unsigned)__builtin_amdgcn_s_getreg((3 << 11) | 20) & 0xFu; }
#define XB_SPIN(cond, bar) do { unsigned _sp = 0; while (cond) { __builtin_amdgcn_s_sleep(1); \
    if ((++_sp & 255u) == 0u) { if (xb_ld(&(bar)[XB_TMO])) break; if (_sp > XB_SPIN_CAP) { atomicAdd(&(bar)[XB_TMO], 1u); break; } } } } while (0)
struct XcdBarrier { unsigned* bar; unsigned x; volatile LAS unsigned* st; };
__device__ __forceinline__ XcdBarrier xcd_barrier_post(unsigned* bar, volatile LAS unsigned* st) {
    XcdBarrier b; b.bar = bar; b.x = xb_xcc_id(); b.st = st;
    if (threadIdx.x == 0) (void)xb_add(&bar[XB_XCNT(b.x)], 1u);
    return b;
}
__device__ __forceinline__ void xcd_barrier_complete(unsigned* bar, unsigned x, unsigned& nloc, unsigned& nx) {
    const unsigned G = gridDim.x * gridDim.y * gridDim.z;
    unsigned sum, cnt, mine, sp = 0u;
    for (;;) {
        sum = 0u; cnt = 0u; mine = 0u;
#pragma unroll
        for (unsigned j = 0; j < 16; ++j) { const unsigned c = xb_ld(&bar[XB_XCNT(j)]); sum += c; cnt += (c > 0u) ? 1u : 0u; mine = (j == x) ? c : mine; }
        if (sum == G) break;
        __builtin_amdgcn_s_sleep(1);
        if ((++sp & 255u) == 0u) { if (xb_ld(&bar[XB_TMO])) break; if (sp > XB_SPIN_CAP) { atomicAdd(&bar[XB_TMO], 1u); break; } }
    }
    nloc = mine > 0u ? mine : 1u; nx = cnt > 0u ? cnt : 1u;
}
__device__ __forceinline__ void xcd_barrier(const XcdBarrier& b) {
    asm volatile("s_waitcnt vmcnt(0)" ::: "memory");
    __syncthreads();
    if (threadIdx.x == 0) {
        unsigned* bar = b.bar;
        __builtin_amdgcn_s_waitcnt(0);
        unsigned nloc = b.st[0], nx = b.st[1];
        if (nloc == 0u) { xcd_barrier_complete(bar, b.x, nloc, nx); b.st[0] = nloc; b.st[1] = nx; }
        const unsigned old = xb_add(&bar[XB_XSUB(b.x)], 1u);
        const unsigned gen = old / nloc;
        if (old + 1u == (gen + 1u) * nloc) {
            __builtin_amdgcn_fence(__ATOMIC_RELEASE, "agent");
            asm volatile("s_waitcnt vmcnt(0)" ::: "memory");
            const unsigned og = xb_add(&bar[XB_TOP], 1u);
            const unsigned tg = og / nx;
            if (og + 1u == (tg + 1u) * nx) xb_add(&bar[XB_TOPGEN], 1u);
            else XB_SPIN(xb_ld(&bar[XB_TOPGEN]) == tg, bar);
            __builtin_amdgcn_fence(__ATOMIC_ACQUIRE, "agent");
            xb_add(&bar[XB_XGEN(b.x)], 1u);
            asm volatile("s_waitcnt vmcnt(0)" ::: "memory");
        } else {
            XB_SPIN(xb_ld(&bar[XB_XGEN(b.x)]) == gen, bar);
            __builtin_amdgcn_fence(__ATOMIC_ACQUIRE, "agent");
            asm volatile("s_waitcnt vmcnt(0)" ::: "memory");
        }
    }
    __syncthreads();
}

__global__ void __launch_bounds__(NTHR, 2) k_mega(Params_ p_unused) {
#define p (*kargs())
  extern __shared__ __attribute__((aligned(16))) char lds[];
  uint4* xbw = (uint4*)(lds + LDS_BYTES);
  if (threadIdx.x == 0) *xbw = make_uint4(0u, 0u, 0u, 0u);
  __syncthreads();
  (void)xcd_barrier_post((unsigned*)(p.ws + O_BAR), (volatile LAS unsigned*)xbw);
#define GRID_BAR() do { XcdBarrier b_; unsigned long long bp_ = (unsigned long long)(p.ws + O_BAR); asm volatile("" : "+s"(bp_)); b_.bar = (unsigned*)bp_; b_.x = xb_xcc_id(); b_.st = (volatile LAS unsigned*)(lds + LDS_BYTES); xcd_barrier(b_); } while (0)
#if PROBE_GROUP
#define REPS(g) int reps_ = 1 + ((g) == PROBE_GROUP ? 1 : 0); asm volatile("" : "+s"(reps_)); _Pragma("unroll 1") for (int r_ = 0; r_ < reps_; ++r_)
#define RSC (r_ == 0 ? 1.f : 0.f)
#else
#define REPS(g)
#define RSC 1.f
#endif
  { REPS(11) { phase_p0(p, lds); GRID_BAR(); phase_p1(p); GRID_BAR(); } }
  for (int l = 0; l < DEPTH; ++l) {
    { REPS(1) { phase_rows(p, l, RSC); } }
    { REPS(10) { phase_prep(p, l, lds); GRID_BAR(); } }
    if (blockIdx.x == 0) { const int t_ = otid(); if (t_ < 64) ((int*)(p.ws + O_CNT))[t_] = 0; if (t_ < 8) ((int*)(p.ws + O_QCTR))[t_ * 64] = 0; }
    phase_proj(p, lds); GRID_BAR(); phase_up(p, lds); GRID_BAR();
    phase_attn(p, l, lds); GRID_BAR();
    { REPS(4) { phase_s5out(p, lds); GRID_BAR(); phase_glu(p, l, lds); GRID_BAR(); } }
    { REPS(5) { phase_merge(p, lds); GRID_BAR(); } }
    { REPS(6) { phase_outproj(p, l, lds, RSC); GRID_BAR(); } }
    { REPS(7) { phase_norm2(p, l, lds); GRID_BAR(); } }
    { REPS(12) {
#if PROBE_GROUP == 12
      if (r_ > 0) { if (blockIdx.x == 0) { const int t_ = otid(); if (t_ < 64) ((int*)(p.ws + O_CNT))[t_] = 0; } GRID_BAR(); }
#endif
      phase_topk(p, l, lds); GRID_BAR();
      phase_lists(p, lds); GRID_BAR(); } }
    { REPS(8) { phase_moe1(p, lds); GRID_BAR(); } }
    { REPS(9) { phase_moe2(p, lds); GRID_BAR(); } }
  }
  phase_rows(p, DEPTH);
#undef p
}

extern "C" void kernel_launch(void* const* d_in, const int* in_sizes, int n_in, void* d_out, int out_size, void* d_ws, size_t ws_size, hipStream_t stream) {
  if (ws_size < WS_NEED) { fprintf(stderr, "workspace too small: %zu < %zu\n", ws_size, (size_t)WS_NEED); return; }
  Params_ p{};
  const float** pp = (const float**)&p;
  for (int i = 0; i < 37; ++i) pp[i] = (const float*)d_in[i];
  p.out = (float*)d_out; p.ws = (char*)d_ws;
  constexpr int kDynLds = LDS_TOTAL;
  static int grid = 0;
  if (!grid) {
    int dev = 0, cus = 0, per_cu = 0;
    hipGetDevice(&dev);
    hipDeviceGetAttribute(&cus, hipDeviceAttributeMultiprocessorCount, dev);
    hipFuncSetAttribute((const void*)k_mega, hipFuncAttributeMaxDynamicSharedMemorySize, kDynLds);
    hipOccupancyMaxActiveBlocksPerMultiprocessor(&per_cu, (const void*)k_mega, NTHR, kDynLds);
    grid = cus * (per_cu < 1 ? per_cu : 1);
    if (grid > 256) grid = 256;
  }
  if (grid <= 0) { fprintf(stderr, "k_mega does not fit\n"); return; }
  hipMemsetAsync((char*)d_ws + O_BAR, 0, 16384, stream);
  hipLaunchKernelGGL(k_mega, dim3(grid), dim3(NTHR), kDynLds, stream, p);
}
```

```cpp
#include <hip/hip_runtime.h>
#include <stdint.h>
#include <stdio.h>
typedef __attribute__((address_space(1))) char* GPTR;
#ifndef PROBE_GROUP
#define PROBE_GROUP 0
#endif

#define DI __device__ __forceinline__
#define LAS __attribute__((address_space(3)))
typedef unsigned short bf16_t;
using bf16x8 = __attribute__((ext_vector_type(8))) short;
using s16x4 = __attribute__((ext_vector_type(4))) short;
using f32x4 = __attribute__((ext_vector_type(4))) float;
using f32x16 = __attribute__((ext_vector_type(16))) float;
using u32x4 = __attribute__((ext_vector_type(4))) unsigned;
using u32x2 = __attribute__((ext_vector_type(2))) unsigned;
typedef __bf16 bf2_t __attribute__((ext_vector_type(2)));
typedef float fl2_t __attribute__((ext_vector_type(2)));
typedef short v4i16_t __attribute__((ext_vector_type(4)));

constexpr int NL = 32768, NC = 512, NTOK = 33280, DM = 1024, SEQ = 16384, CTXL = 256, KLEN = 16640, DEPTH = 4;
constexpr int INW = 6304, NTHR = 512;
constexpr int NCHUNK = 260;
constexpr int YROWS = 216064 + 33280;
constexpr float LOG2E = 1.4426950408889634f;
constexpr float NA_QS = 0.125f * LOG2E;
constexpr float DIFF_QS = 0.17677669529663687f * LOG2E;
constexpr float MLA_QS = 0.10206207261596577f * LOG2E;
constexpr float EPS = 1e-6f;

constexpr size_t O_BAR = 0;
constexpr size_t O_TP = O_BAR + 14336;
constexpr size_t O_CNT = O_BAR + 16384;
constexpr size_t O_QCTR = O_CNT + 1024;
constexpr size_t O_LAMF = O_QCTR + 2048;
constexpr size_t O_ADA = O_LAMF + 256;
constexpr size_t O_ROPER = O_ADA + 294912;
constexpr size_t O_ROPEC = O_ROPER + 16384;
constexpr size_t O_S5PW = O_ROPEC + 4096;
constexpr size_t O_S5BB = O_S5PW + 4259840;
constexpr size_t O_S5K = O_S5BB + 1048576;
constexpr size_t O_X = O_S5K + 8388608;
constexpr size_t O_H1 = O_X + 136314880;
constexpr size_t O_R = O_H1 + 68157440;
constexpr size_t O_H2 = O_R;
constexpr size_t O_YCAT = O_H2 + 68157440;
constexpr size_t O_MBUF = O_YCAT + 68157440;
constexpr size_t O_QN = O_MBUF + 68157440;
constexpr size_t O_KN = O_QN + 17039360;
constexpr size_t O_VN = O_KN + 17039360;
constexpr size_t O_QDL = O_VN + 17039360;
constexpr size_t O_QDR = O_QDL + 16777216;
constexpr size_t O_KD = O_QDR + 17039360;
constexpr size_t O_VD = O_KD + 17039360;
constexpr size_t O_QML = O_VD + 17039360;
constexpr size_t O_QMR = O_QML + 25165824;
constexpr size_t O_KM = O_QMR + 25559040;
constexpr size_t O_VM = O_KM + 25559040;
constexpr size_t O_CQ = O_VM + 17039360;
constexpr size_t O_CKV = O_CQ + 17039360;
constexpr size_t O_UCAT = O_CKV + 8519680;
constexpr size_t O_SLOC = O_UCAT + 21954560;
constexpr size_t O_G5 = O_SLOC + 8519680;
constexpr size_t R_END1 = O_G5 + 17039360;
constexpr size_t R_END2 = O_R + (size_t)YROWS * 2048;
constexpr size_t O_ACT = R_END1 > R_END2 ? R_END1 : R_END2;
constexpr size_t O_IDX = O_ACT + (size_t)YROWS * 512;
constexpr size_t O_GW = O_IDX + 798720;
constexpr size_t O_SLOT = O_GW + 798720;
constexpr size_t O_ROWIDX = O_SLOT + 798720;
constexpr size_t O_WIN = O_ROWIDX + 997376;
constexpr size_t O_WG = O_WIN + 2304 * 1024 * 2;
constexpr size_t O_WUQ = O_WG + 4096 * 1024 * 2;
constexpr size_t O_WUKV = O_WUQ + 384 * 256 * 2;
constexpr size_t O_WGLU = O_WUKV + 512 * 128 * 2;
constexpr size_t O_WBR = O_WGLU + 256 * 256 * 2;
constexpr size_t O_WOUT = O_WBR + 4 * 1024 * 256 * 2;
constexpr size_t O_WE1 = O_WOUT + 1024 * 1024 * 2;
constexpr size_t O_WE3 = O_WE1 + (size_t)65 * 256 * 1024 * 2;
constexpr size_t O_WE2 = O_WE3 + (size_t)65 * 256 * 1024 * 2;
constexpr size_t O_S5B2 = O_WE2 + (size_t)65 * 1024 * 256 * 2;
constexpr size_t O_S5B1 = O_S5B2 + (size_t)16 * 1024 * 1280 * 2;
constexpr size_t O_WRHI = O_S5B1 + (size_t)16 * 256 * 1024 * 2;
constexpr size_t O_WRLO = O_WRHI + 128 * 1024 * 2;
constexpr size_t WS_NEED = O_WRLO + 128 * 1024 * 2;
constexpr size_t O_H2LO = O_MBUF;
constexpr size_t O_LOGIT = O_YCAT;

struct Params_ {
  const float *x, *c, *ctx, *c_ctx, *w_ada, *b_ada, *g_norm1, *g_norm2, *w_in, *na_rpb, *diff_lambda, *g_diff, *g_mla_q, *g_mla_kv,
      *w_mla_uq, *w_mla_ukv, *s5_lam_re, *s5_lam_im, *s5_log_step, *s5_b_re, *s5_b_im, *s5_c_re, *s5_c_im, *s5_d, *w_glu, *b_glu,
      *w_branch, *w_out, *w_router, *e_bias, *w_e1, *w_e3, *w_e2, *w_s1, *w_s3, *w_s2, *g_final;
  float* out;
  char* ws;
};
typedef const __attribute__((address_space(4))) Params_ Params;
DI Params* kargs() { Params* k = (Params*)__builtin_amdgcn_kernarg_segment_ptr(); asm volatile("" : "+s"(k)); return k; }

DI float bf2f(bf16_t b) { return __uint_as_float((unsigned)b << 16); }
DI bf16_t f2bf(float x) { unsigned u = __float_as_uint(x); u += 0x7fffu + ((u >> 16) & 1u); return (bf16_t)(u >> 16); }
DI unsigned pack2(float a, float b) { fl2_t f = {a, b}; bf2_t r = __builtin_convertvector(f, bf2_t); return __builtin_bit_cast(unsigned, r); }
DI float sigm(float x) { return __builtin_amdgcn_rcpf(1.f + __builtin_amdgcn_exp2f(-LOG2E * x)); }
DI float gelu_tanh(float x) { float u = 0.7978845608028654f * (x + 0.044715f * x * x * x); return x * (1.f - __builtin_amdgcn_rcpf(__builtin_amdgcn_exp2f((2.f * LOG2E) * u) + 1.f)); }
DI float bperm(float v, int srclane) { return __int_as_float(__builtin_amdgcn_ds_bpermute(srclane << 2, __float_as_int(v))); }
DI float xhalf(float v) { auto rr = __builtin_amdgcn_permlane32_swap(__float_as_uint(v), __float_as_uint(v), false, false); return __uint_as_float(rr[0]) + __uint_as_float(rr[1]); }
DI float xhalf_max(float v) { auto rr = __builtin_amdgcn_permlane32_swap(__float_as_uint(v), __float_as_uint(v), false, false); return fmaxf(__uint_as_float(rr[0]), __uint_as_float(rr[1])); }
DI float xhalf_get(float v, int hi) { auto rr = __builtin_amdgcn_permlane32_swap(__float_as_uint(v), __float_as_uint(v), false, false); return __uint_as_float(hi ? rr[0] : rr[1]); }
DI float wave_sum(float v, int lane) {
#pragma unroll
  for (int o = 16; o > 0; o >>= 1) v += bperm(v, lane ^ o);
  return xhalf(v);
}
DI float wave_max(float v, int lane) {
#pragma unroll
  for (int o = 16; o > 0; o >>= 1) v = fmaxf(v, bperm(v, lane ^ o));
  return xhalf_max(v);
}
DI void tokinfo(int row, int& b, int& isctx, int& t) {
  if (row < NL) { b = row >> 14; t = row & 16383; isctx = 0; }
  else { int r = row - NL; b = r >> 8; t = r & 255; isctx = 1; }
}
#define MFMA16(a, b, c) __builtin_amdgcn_mfma_f32_16x16x32_bf16((a), (b), (c), 0, 0, 0)
#define MFMA32(a, b, c) __builtin_amdgcn_mfma_f32_32x32x16_bf16((a), (b), (c), 0, 0, 0)
DI int otid() { int t = threadIdx.x; asm volatile("" : "+v"(t)); return t; }
template <int DK> DI size_t kimg(int kidx, int d) { return ((size_t)((kidx >> 6) * (DK / 8) + (d >> 3)) * 64 + (kidx & 63)) * 8 + (d & 7); }
DI size_t vimg(int kidx, int d) { return (size_t)(kidx >> 6) * 4096 + (d >> 5) * 2048 + (kidx & 63) * 32 + (d & 31); }
DI void glds16(const void* g, unsigned lds_base) {
  unsigned sv;
  asm volatile("s_mov_b32 %0, m0\n\ts_mov_b32 m0, %2\n\ts_nop 0\n\tglobal_load_lds_dwordx4 %1, off\n\ts_mov_b32 m0, %0" : "=&s"(sv) : "v"(g), "s"(lds_base) : "memory");
}
DI int crow(int r, int hi) { return (r & 3) + 8 * (r >> 2) + 4 * hi; }

constexpr int GSTAGE = 49152;
constexpr int GNST = 3;
constexpr int GEMM_LDS = GNST * GSTAGE;
constexpr int LDS_BYTES = GEMM_LDS + 2048;
constexpr int LDS_XBW = LDS_BYTES, LDS_POFF = LDS_BYTES + 16, LDS_TOTAL = LDS_BYTES + 16 + 512;
struct GJ { const bf16_t* A; const int* ridx; const bf16_t* Bt; int lda, m0, ldb, n0, nt; bool valid; };
DI GJ gj_none() { GJ j; j.A = nullptr; j.ridx = nullptr; j.Bt = nullptr; j.lda = 0; j.m0 = 0; j.ldb = 0; j.n0 = 0; j.nt = 0; j.valid = false; return j; }
DI GJ gj_make(const bf16_t* A, const int* ridx, int lda, int m0, const bf16_t* Bt, int ldb, int n0, int K) {
  GJ j; j.A = A; j.ridx = ridx; j.Bt = Bt; j.lda = lda; j.m0 = m0; j.ldb = ldb; j.n0 = n0; j.nt = K >> 6; j.valid = true; return j; }
struct GP { const bf16_t* p[6]; };
DI GP g_setup(const GJ& j, int tid) {
  const int r = tid >> 3, c = (((tid & 7) ^ ((r >> 1) & 7))) * 8;
  GP g;
#pragma unroll
  for (int i = 0; i < 4; ++i) { int rr = j.m0 + r + 64 * i; if (j.ridx) rr = j.ridx[rr]; g.p[i] = j.A + (size_t)rr * j.lda + c; }
#pragma unroll
  for (int i = 0; i < 2; ++i) g.p[4 + i] = j.Bt + (size_t)(j.n0 + r + 64 * i) * j.ldb + c;
  return g;
}
DI void g_issue1(const GP& g, int kt, char* base, int tid, int i) {
  __builtin_amdgcn_global_load_lds((const unsigned*)(g.p[i] + kt * 64), (unsigned*)(base + i * 8192 + tid * 16), 16, 0, 0);
}
DI const bf16_t* g_ptr1(const GJ& j, int tid, int i) {
  const int r = tid >> 3, c = (((tid & 7) ^ ((r >> 1) & 7))) * 8;
  if (i < 4) { int rr = j.m0 + r + 64 * i; if (j.ridx) rr = j.ridx[rr]; return j.A + (size_t)rr * j.lda + c; }
  return j.Bt + (size_t)(j.n0 + r + 64 * (i - 4)) * j.ldb + c;
}
DI void g_issue(const GP& g, int kt, char* base, int tid) {
#pragma unroll
  for (int i = 0; i < 6; ++i) g_issue1(g, kt, base, tid, i);
}
template <int NST>
struct GStream {
  GP cur; int cur_nt, ring, tid; char* lds;
  DI void start(const GJ& j, char* lds_, int tid_) {
    lds = lds_; tid = tid_; ring = 0; cur_nt = j.nt;
    if (j.valid) { cur = g_setup(j, tid);
#pragma unroll
      for (int i = 0; i < NST - 1; ++i) g_issue(cur, i, lds + i * GSTAGE, tid); }
  }
  template <bool LAZY = false, bool PF2 = true>
  DI void run(f32x4 (&acc)[4][4], const GJ& next) {
    const int lane = tid & 63, wid = tid >> 6, wr = wid >> 1, wc = wid & 1, fr = lane & 15, fq = lane >> 4;
    const int sw = (fr >> 1) & 7;
    const int aoff = (wr * 64 + fr) * 128, boff = 32768 + (wc * 64 + fr) * 128;
    const int c0 = ((fq ^ sw) * 16), c1 = (((4 + fq) ^ sw) * 16);
    const bool hn = next.valid;
    GP nxt = cur;
    if (!LAZY && hn) nxt = g_setup(next, tid);
    const int nt = cur_nt;
#pragma unroll 1
    for (int t = 0; t < nt; ++t) {
      int infl = nt - 1 - t + (hn ? NST - 1 : 0); infl = infl > NST - 2 ? NST - 2 : infl;
      if (infl >= 2) asm volatile("s_waitcnt vmcnt(12)" ::: "memory");
      else if (infl == 1) asm volatile("s_waitcnt vmcnt(6)" ::: "memory");
      else asm volatile("s_waitcnt vmcnt(0)" ::: "memory");
      __builtin_amdgcn_s_barrier();
      const int j = t + NST - 1;
      char* ib = lds + ((ring + j) % NST) * GSTAGE;
      const bool own = j < nt, doi = own || hn;
      const int ikt = own ? j : j - nt;
      GP src = cur;
      if (!LAZY && !own && hn) src = nxt;
#define G_ISSUE1(i_) do { if (LAZY && !own) __builtin_amdgcn_global_load_lds((const unsigned*)(g_ptr1(next, tid, (i_)) + ikt * 64), (unsigned*)(ib + (i_) * 8192 + tid * 16), 16, 0, 0); else g_issue1(src, ikt, ib, tid, (i_)); } while (0)
      const char* base = lds + ((ring + t) % NST) * GSTAGE;
      bf16x8 af[4], bfr[4], af1[4], bf1[4];
#pragma unroll
      for (int m = 0; m < 4; ++m) af[m] = *(const bf16x8*)(base + aoff + m * 2048 + c0);
#pragma unroll
      for (int n = 0; n < 4; ++n) bfr[n] = *(const bf16x8*)(base + boff + n * 2048 + c0);
      __builtin_amdgcn_sched_barrier(0);
#pragma unroll
      for (int m = 0; m < 4; ++m) {
#pragma unroll
        for (int n = 0; n < 4; ++n) acc[m][n] = MFMA16(bfr[n], af[m], acc[m][n]);
        if (doi) G_ISSUE1(m);
        if (!LAZY && PF2) {
          if (m == 0) {
#pragma unroll
            for (int n = 0; n < 4; ++n) bf1[n] = *(const bf16x8*)(base + boff + n * 2048 + c1);
          }
          if (m == 1) {
#pragma unroll
            for (int q = 0; q < 4; ++q) af1[q] = *(const bf16x8*)(base + aoff + q * 2048 + c1);
          }
        }
        __builtin_amdgcn_sched_barrier(0);
      }
      if (LAZY || !PF2) {
#pragma unroll
        for (int m = 0; m < 4; ++m) af1[m] = *(const bf16x8*)(base + aoff + m * 2048 + c1);
#pragma unroll
        for (int n = 0; n < 4; ++n) bf1[n] = *(const bf16x8*)(base + boff + n * 2048 + c1);
        __builtin_amdgcn_sched_barrier(0);
      }
#pragma unroll
      for (int m = 0; m < 4; ++m) {
#pragma unroll
        for (int n = 0; n < 4; ++n) acc[m][n] = MFMA16(bf1[n], af1[m], acc[m][n]);
        if (m < 2 && doi) G_ISSUE1(4 + m);
        __builtin_amdgcn_sched_barrier(0);
      }
    }
#undef G_ISSUE1
    ring = (ring + nt) % NST;
    if (LAZY) { if (hn) cur = g_setup(next, tid); } else cur = nxt;
    cur_nt = next.nt;
  }
  DI void run2(f32x4 (&acc)[4][4], const GJ& next) { run(acc, next); }
};
DI void mini_gemm16(f32x4& acc, const bf16_t* __restrict__ A, int lda, const bf16_t* __restrict__ Bt, int ldb, int K, int lane) {
  const bf16_t* ap = A + (size_t)(lane & 15) * lda + 8 * (lane >> 4);
  const bf16_t* bp = Bt + (size_t)(lane & 15) * ldb + 8 * (lane >> 4);
  int k0 = 0;
#pragma unroll 1
  for (; k0 + 512 <= K; k0 += 512) {
    bf16x8 a[16], b[16];
#pragma unroll
    for (int i = 0; i < 16; ++i) { a[i] = *(const bf16x8*)(ap + k0 + i * 32); b[i] = *(const bf16x8*)(bp + k0 + i * 32); }
#pragma unroll
    for (int i = 0; i < 16; ++i) acc = MFMA16(a[i], b[i], acc);
  }
#pragma unroll 1
  for (; k0 < K; k0 += 256) {
    bf16x8 a[8], b[8];
#pragma unroll
    for (int i = 0; i < 8; ++i) { a[i] = *(const bf16x8*)(ap + k0 + i * 32); b[i] = *(const bf16x8*)(bp + k0 + i * 32); }
#pragma unroll
    for (int i = 0; i < 8; ++i) acc = MFMA16(a[i], b[i], acc);
  }
}
constexpr int WSTAGE = 32768, WNST = 4;
struct GPW { const bf16_t* p[4]; };
DI GPW gw_setup(const GJ& j, int tid) {
  const int r = tid >> 2, c = (((tid & 3) ^ ((0 - (r >> 2)) & 3))) * 8;
  GPW g;
#pragma unroll
  for (int i = 0; i < 2; ++i) { int rr = j.m0 + r + 128 * i; if (j.ridx) rr = j.ridx[rr]; g.p[i] = j.A + (size_t)rr * j.lda + c; }
#pragma unroll
  for (int i = 0; i < 2; ++i) g.p[2 + i] = j.Bt + (size_t)(j.n0 + r + 128 * i) * j.ldb + c;
  return g;
}
DI void gw_issue1(const GPW& g, int kt, char* base, int tid, int i) {
  __builtin_amdgcn_global_load_lds((const unsigned*)(g.p[i] + kt * 32), (unsigned*)(base + i * 8192 + tid * 16), 16, 0, 0);
}
struct GStreamW {
  GPW cur; int cur_nt, ring, tid; char* lds;
  DI void start(const GJ& j, char* lds_, int tid_) {
    lds = lds_; tid = tid_; ring = 0; cur_nt = j.nt * 2;
    if (j.valid) { cur = gw_setup(j, tid);
#pragma unroll
      for (int s = 0; s < WNST - 1; ++s)
#pragma unroll
        for (int i = 0; i < 4; ++i) gw_issue1(cur, s, lds + s * WSTAGE, tid, i); }
  }
  DI void run(f32x4 (&acc)[4][8], const GJ& next) {
    const int lane = tid & 63, wid = tid >> 6, wr = wid >> 1, wc = wid & 1, fr = lane & 15, fq = lane >> 4;
    const int fo = ((fq ^ ((0 - (fr >> 2)) & 3)) * 16);
    const int aoff = (wr * 64 + fr) * 64 + fo, boff = 16384 + (wc * 128 + fr) * 64 + fo;
    const bool hn = next.valid;
    GPW nxt = cur;
    if (hn) nxt = gw_setup(next, tid);
    const int nt = cur_nt;
#pragma unroll 1
    for (int t = 0; t < nt; ++t) {
      int infl = nt - 1 - t + (hn ? WNST - 1 : 0); infl = infl > WNST - 2 ? WNST - 2 : infl;
      if (infl >= 2) asm volatile("s_waitcnt vmcnt(8)" ::: "memory");
      else if (infl == 1) asm volatile("s_waitcnt vmcnt(4)" ::: "memory");
      else asm volatile("s_waitcnt vmcnt(0)" ::: "memory");
      __builtin_amdgcn_s_barrier();
      const int j = t + WNST - 1;
      char* ib = lds + ((ring + j) % WNST) * WSTAGE;
      const bool own = j < nt, doi = own || hn;
      const int ikt = own ? j : j - nt;
      GPW src = cur;
      if (!own && hn) src = nxt;
      const char* base = lds + ((ring + t) % WNST) * WSTAGE;
      bf16x8 af[4], bfr[8];
#pragma unroll
      for (int m = 0; m < 4; ++m) af[m] = *(const bf16x8*)(base + aoff + m * 1024);
#pragma unroll
      for (int n = 0; n < 8; ++n) bfr[n] = *(const bf16x8*)(base + boff + n * 1024);
      __builtin_amdgcn_sched_barrier(0);
#pragma unroll
      for (int m = 0; m < 4; ++m) {
#pragma unroll
        for (int n = 0; n < 8; ++n) acc[m][n] = MFMA16(bfr[n], af[m], acc[m][n]);
        if (doi) gw_issue1(src, ikt, ib, tid, m);
        __builtin_amdgcn_sched_barrier(0);
      }
    }
    ring = (ring + nt) % WNST;
    cur = nxt; cur_nt = next.nt * 2;
  }
};
DI void zero_accw(f32x4 (&acc)[4][8]) {
#pragma unroll
  for (int m = 0; m < 4; ++m)
#pragma unroll
    for (int n = 0; n < 8; ++n) acc[m][n] = f32x4{0.f, 0.f, 0.f, 0.f};
}
constexpr int G8_HT = 128 * 64;
DI int g8_lds_byte(int r, int c) { const int st = (r >> 4) * 2 + (c >> 5), rr = r & 15, cc = c & 31, ob = rr * 64 + cc * 2; return st * 1024 + (ob ^ (((ob >> 9) & 1) << 5)); }
DI void g8_stage_rc(int b, int& R, int& C) { const int st = b / 1024, sb = b % 1024, swz = sb ^ (((sb >> 9) & 1) << 5); R = (st >> 1) * 16 + swz / 64; C = (st & 1) * 32 + (swz % 64) / 2; }
template <bool GATHER>
DI void gemm8(f32x4 (&acc)[2][2][4][2], const bf16_t* __restrict__ A, const int* __restrict__ ridx, int brow, const bf16_t* __restrict__ B0, const bf16_t* __restrict__ B1, int K, char* shmc) {
  bf16_t* shm = (bf16_t*)shmc;
#define G8_SA(b, h) (shm + ((b) * 2 + (h)) * G8_HT)
#define G8_SB(b, h) (shm + (4 + (b) * 2 + (h)) * G8_HT)
  int tz = otid();
  int wid = tz >> 6, lane = tz & 63, wr = wid >> 2, wc = wid & 3, fr = lane & 15, fq = lane >> 4;
  int ar[2][2];
  if (GATHER) {
#pragma unroll
    for (int h = 0; h < 2; ++h)
#pragma unroll
      for (int i = 0; i < 2; ++i) { int r_, c_; g8_stage_rc(tz * 16 + i * 8192, r_, c_); ar[h][i] = ridx[brow + h * 128 + r_]; }
  }
#define G8_STAGE_A(P, h, kt) do { _Pragma("unroll") for (int i_ = 0; i_ < 2; ++i_) { const int b_ = tz * 16 + i_ * 8192; int r_, c_; g8_stage_rc(b_, r_, c_); \
      const long row_ = GATHER ? (long)ar[h][i_] : (long)(brow + (h) * 128 + r_); \
      __builtin_amdgcn_global_load_lds((const unsigned*)(A + row_ * K + (long)(kt) * 64 + c_), (unsigned*)((char*)(P) + b_), 16, 0, 0); } } while (0)
#define G8_STAGE_B(P, h, kt) do { const bf16_t* bb_ = (h) ? B1 : B0; _Pragma("unroll") for (int i_ = 0; i_ < 2; ++i_) { const int b_ = tz * 16 + i_ * 8192; int r_, c_; g8_stage_rc(b_, r_, c_); \
      __builtin_amdgcn_global_load_lds((const unsigned*)(bb_ + (long)r_ * K + (long)(kt) * 64 + c_), (unsigned*)((char*)(P) + b_), 16, 0, 0); } } while (0)
#define G8_LDA(dst, b, h) _Pragma("unroll") for (int m = 0; m < 4; ++m) _Pragma("unroll") for (int k = 0; k < 2; ++k) \
    dst[m][k] = *reinterpret_cast<const bf16x8*>((char*)G8_SA(b, h) + g8_lds_byte(wr * 64 + m * 16 + fr, k * 32 + fq * 8))
#define G8_LDB(dst, b, h) _Pragma("unroll") for (int n = 0; n < 2; ++n) _Pragma("unroll") for (int k = 0; k < 2; ++k) \
    dst[n][k] = *reinterpret_cast<const bf16x8*>((char*)G8_SB(b, h) + g8_lds_byte(wc * 32 + n * 16 + fr, k * 32 + fq * 8))
#define G8_MMA(ai, bj, At_, Bt_) do { __builtin_amdgcn_s_setprio(1); \
    _Pragma("unroll") for (int m = 0; m < 4; ++m) _Pragma("unroll") for (int n = 0; n < 2; ++n) _Pragma("unroll") for (int k = 0; k < 2; ++k) \
      acc[ai][bj][m][n] = MFMA16(Bt_[n][k], At_[m][k], acc[ai][bj][m][n]); \
    __builtin_amdgcn_s_setprio(0); } while (0)
#define G8_WAIT_V(n) asm volatile("s_waitcnt vmcnt(" #n ")" ::: "memory")
#define G8_WAIT_L(n) asm volatile("s_waitcnt lgkmcnt(" #n ")" ::: "memory")
#define G8_BAR __builtin_amdgcn_s_barrier()
#define G8_SCHED __builtin_amdgcn_sched_barrier(0)
  bf16x8 At[4][2], Bq0[2][2], Bq1[2][2];
  const int nt = K / 64;
  G8_STAGE_B(G8_SB(0, 0), 0, 0); G8_STAGE_A(G8_SA(0, 0), 0, 0);
  G8_STAGE_B(G8_SB(0, 1), 1, 0); G8_STAGE_A(G8_SA(0, 1), 1, 0);
  if (wr == 1) G8_BAR;
  G8_WAIT_V(4); G8_BAR;
  G8_STAGE_B(G8_SB(1, 0), 0, 1); G8_STAGE_A(G8_SA(1, 0), 0, 1); G8_STAGE_B(G8_SB(1, 1), 1, 1);
  G8_WAIT_V(6); G8_BAR;
#pragma unroll 1
  for (int t = 0; t < nt - 2; t += 2) {
    G8_LDB(Bq0, 0, 0); G8_SCHED; G8_LDA(At, 0, 0); G8_STAGE_A(G8_SA(1, 1), 1, t + 1);
    G8_WAIT_L(8); G8_BAR; G8_WAIT_L(0); G8_MMA(0, 0, At, Bq0); G8_BAR; G8_SCHED;
    G8_LDB(Bq1, 0, 1); G8_STAGE_B(G8_SB(0, 0), 0, t + 2);
    G8_BAR; G8_WAIT_L(0); G8_MMA(0, 1, At, Bq1); G8_BAR;
    G8_LDA(At, 0, 1); G8_STAGE_A(G8_SA(0, 0), 0, t + 2);
    G8_BAR; G8_WAIT_L(0); G8_MMA(1, 0, At, Bq0); G8_BAR; G8_SCHED;
    G8_STAGE_B(G8_SB(0, 1), 1, t + 2);
    G8_WAIT_V(6); G8_BAR; G8_MMA(1, 1, At, Bq1); G8_BAR;
    G8_LDB(Bq0, 1, 0); G8_SCHED; G8_LDA(At, 1, 0); G8_STAGE_A(G8_SA(0, 1), 1, t + 2);
    G8_WAIT_L(8); G8_BAR; G8_WAIT_L(0); G8_MMA(0, 0, At, Bq0); G8_BAR; G8_SCHED;
    G8_LDB(Bq1, 1, 1); G8_STAGE_B(G8_SB(1, 0), 0, t + 3);
    G8_BAR; G8_WAIT_L(0); G8_MMA(0, 1, At, Bq1); G8_BAR;
    G8_LDA(At, 1, 1); G8_STAGE_A(G8_SA(1, 0), 0, t + 3);
    G8_BAR; G8_WAIT_L(0); G8_MMA(1, 0, At, Bq0); G8_BAR; G8_SCHED;
    G8_STAGE_B(G8_SB(1, 1), 1, t + 3);
    G8_WAIT_V(6); G8_BAR; G8_MMA(1, 1, At, Bq1); G8_BAR;
  }
  { int t2 = tz; asm volatile("" : "+v"(t2)); tz = t2; wid = tz >> 6; lane = tz & 63; wr = wid >> 2; wc = wid & 3; fr = lane & 15; fq = lane >> 4; }
  { G8_LDB(Bq0, 0, 0); G8_WAIT_V(0); G8_LDA(At, 0, 0); G8_STAGE_A(G8_SA(1, 1), 1, nt - 1);
    G8_BAR; G8_WAIT_L(0); G8_MMA(0, 0, At, Bq0); G8_BAR;
    G8_LDB(Bq1, 0, 1); G8_BAR; G8_WAIT_L(0); G8_MMA(0, 1, At, Bq1); G8_BAR;
    G8_LDA(At, 0, 1); G8_WAIT_V(4); G8_BAR; G8_WAIT_L(0); G8_MMA(1, 0, At, Bq0); G8_MMA(1, 1, At, Bq1); G8_BAR; }
  { G8_LDB(Bq0, 1, 0); G8_LDA(At, 1, 0); G8_WAIT_V(2); G8_BAR; G8_WAIT_L(0); G8_MMA(0, 0, At, Bq0); G8_BAR;
    G8_LDB(Bq1, 1, 1); G8_WAIT_V(0); G8_BAR; G8_WAIT_L(0); G8_MMA(0, 1, At, Bq1); G8_BAR;
    G8_LDA(At, 1, 1); G8_BAR; G8_WAIT_L(0); G8_MMA(1, 0, At, Bq0); G8_MMA(1, 1, At, Bq1); G8_BAR; }
  if (wr == 0) G8_BAR;
#undef G8_SA
#undef G8_SB
#undef G8_STAGE_A
#undef G8_STAGE_B
#undef G8_LDA
#undef G8_LDB
#undef G8_MMA
#undef G8_WAIT_V
#undef G8_WAIT_L
#undef G8_BAR
#undef G8_SCHED
}
DI void zero_acc8(f32x4 (&acc)[2][2][4][2]) {
#pragma unroll
  for (int a = 0; a < 2; ++a)
#pragma unroll
    for (int b = 0; b < 2; ++b)
#pragma unroll
      for (int m = 0; m < 4; ++m)
#pragma unroll
        for (int n = 0; n < 2; ++n) acc[a][b][m][n] = f32x4{0.f, 0.f, 0.f, 0.f};
}
struct UM {
  int x, r, R, NT, nloc;
  DI UM(int NM, int NT_) { x = blockIdx.x & 7; r = blockIdx.x >> 3; R = gridDim.x >> 3; NT = NT_; nloc = ((NM - x + 7) >> 3) * NT_; if (NM <= x) nloc = 0; }
  DI bool get(int k, int& mt, int& nt) const { const int v = r + k * R; if (k < 0 || v >= nloc) return false; mt = x + 8 * (v / NT); nt = v % NT; return true; }
};
DI u32x2 pack4(const f32x4& v) { u32x2 r; r[0] = pack2(v[0], v[1]); r[1] = pack2(v[2], v[3]); return r; }
DI void zero_acc(f32x4 (&acc)[4][4]) {
#pragma unroll
  for (int m = 0; m < 4; ++m)
#pragma unroll
    for (int n = 0; n < 4; ++n) acc[m][n] = f32x4{0.f, 0.f, 0.f, 0.f};
}

DI float rope_apply(float v, float partner, int fr, int half, int t, const float2* roper, const float2* ropec) {
  const int i = fr & 7;
  const float2 cs = half ? ropec[(t & 63) * 8 + i] : roper[(t >> 6) * 8 + i];
  return (fr & 8) ? (partner * cs.y + v * cs.x) : (v * cs.x - partner * cs.y);
}

DI void phase_p0(const Params& p, char* lds) {
  const int tid = otid(), gtid = blockIdx.x * NTHR + tid, gsz = gridDim.x * NTHR;
  float* sl = (float*)lds;
  for (int i = tid; i < 3072; i += NTHR) { float v = i < 2048 ? p.c[i] : p.c_ctx[i - 2048]; sl[i] = v / (1.f + __expf(-v)); }
  __syncthreads();
  float* adap = (float*)(p.ws + O_ACT);
  for (int w = gtid; w < DEPTH * 6144 * 4; w += gsz) {
    const int kp = w / (DEPTH * 6144), o = w % (DEPTH * 6144);
    const int l = o / 6144, col = o % 6144;
    const float* wp = p.w_ada + ((size_t)l * 1024 + kp * 256) * 6144 + col;
    const float* s0 = sl + kp * 256;
    float a0 = 0.f, a1 = 0.f, a2 = 0.f;
#pragma unroll 16
    for (int k = 0; k < 256; ++k) { const float wv = wp[(size_t)k * 6144]; a0 += s0[k] * wv; a1 += s0[1024 + k] * wv; a2 += s0[2048 + k] * wv; }
    float* dst = adap + (size_t)kp * (DEPTH * 3 * 6144);
    dst[(l * 3 + 0) * 6144 + col] = a0; dst[(l * 3 + 1) * 6144 + col] = a1; dst[(l * 3 + 2) * 6144 + col] = a2;
  }
  float2* rr = (float2*)(p.ws + O_ROPER);
  float2* rc = (float2*)(p.ws + O_ROPEC);
  for (int i = gtid; i < 2048 + 512; i += gsz) {
    const int j = i < 2048 ? i : i - 2048;
    const int pos = j >> 3, f = j & 7;
    double freq = 1.0;
    switch (f) { case 1: freq = 0.31622776601683794; break; case 2: freq = 0.1; break; case 3: freq = 0.031622776601683794; break; case 4: freq = 0.01; break;
      case 5: freq = 0.0031622776601683794; break; case 6: freq = 0.001; break; case 7: freq = 0.00031622776601683794; break; default: break; }
    double rev = (double)pos * freq * 0.15915494309189535; rev -= floor(rev);
    const float rf = (float)rev;
    const float2 cs = make_float2(__builtin_amdgcn_cosf(rf), __builtin_amdgcn_sinf(rf));
    if (i < 2048) rr[j] = cs; else rc[j] = cs;
  }
  float2* pw = (float2*)(p.ws + O_S5PW);
  float2* bb = (float2*)(p.ws + O_S5BB);
  for (int i = gtid; i < DEPTH * 2 * 16 * 64; i += gsz) {
    const int ldg = i >> 6, pp = i & 63;
    const float lr = p.s5_lam_re[i], li = p.s5_lam_im[i];
    const float step = expf(p.s5_log_step[ldg]);
    float ar = 1.f, ai = 0.f;
    for (int tau = 0; tau <= 64; ++tau) {
      double rev = (double)li * (double)step * (double)tau * 0.15915494309189535; rev -= floor(rev);
      const float rf = (float)rev;
      const float mag = expf(lr * step * (float)tau);
      const float2 v = make_float2(mag * __builtin_amdgcn_cosf(rf), mag * __builtin_amdgcn_sinf(rf));
      pw[((size_t)ldg * 65 + tau) * 64 + pp] = v;
      if (tau == 1) { ar = v.x; ai = v.y; }
    }
    const float den = lr * lr + li * li;
    const float fr_ = ((ar - 1.f) * lr + ai * li) / den, fi_ = (ai * lr - (ar - 1.f) * li) / den;
    for (int j = 0; j < 16; ++j) {
      const float br = p.s5_b_re[(size_t)i * 16 + j], bi = p.s5_b_im[(size_t)i * 16 + j];
      bb[(size_t)i * 16 + j] = make_float2(fr_ * br - fi_ * bi, fr_ * bi + fi_ * br);
    }
  }
  if (gtid < DEPTH) {
    const float* lf = p.diff_lambda + gtid * 128;
    float s1 = 0.f, s2 = 0.f;
    for (int k = 0; k < 32; ++k) { s1 += lf[k] * lf[32 + k]; s2 += lf[64 + k] * lf[96 + k]; }
    const float lam_init = 0.8f - 0.6f * expf(-0.3f * (float)gtid);
    ((float*)(p.ws + O_LAMF))[gtid] = expf(s1) - expf(s2) + lam_init;
  }
  if (gtid < 64) ((int*)(p.ws + O_CNT))[gtid] = 0;
}

DI void phase_p1(const Params& p) {
  const int gtid = blockIdx.x * NTHR + otid(), gsz = gridDim.x * NTHR;
  {
    const float* adap = (const float*)(p.ws + O_ACT);
    float* ada = (float*)(p.ws + O_ADA);
    for (int i = gtid; i < DEPTH * 3 * 6144; i += gsz) {
      const int l = i / (3 * 6144), col = i % 6144;
      ada[i] = ((adap[i] + adap[i + DEPTH * 3 * 6144]) + (adap[i + 2 * DEPTH * 3 * 6144] + adap[i + 3 * DEPTH * 3 * 6144])) + p.b_ada[l * 6144 + col];
    }
  }
  const float2* pw = (const float2*)(p.ws + O_S5PW);
  const float2* bb = (const float2*)(p.ws + O_S5BB);
  float* km = (float*)(p.ws + O_S5K);
  for (int o = gtid; o < DEPTH * 2 * 16 * 64 * 256; o += gsz) {
    const int j2 = o & 15, j = (o >> 4) & 15, tau = (o >> 8) & 63, ldg = o >> 14;
    const float* cr = p.s5_c_re + ((size_t)ldg * 16 + j) * 64;
    const float* ci = p.s5_c_im + ((size_t)ldg * 16 + j) * 64;
    const float2* pwr = pw + ((size_t)ldg * 65 + tau) * 64;
    const float2* bbr = bb + (size_t)ldg * 64 * 16 + j2;
    float s = 0.f;
    for (int pp = 0; pp < 64; ++pp) {
      const float2 a = pwr[pp], b = bbr[pp * 16];
      const float wr_ = cr[pp] * a.x - ci[pp] * a.y, wi_ = cr[pp] * a.y + ci[pp] * a.x;
      s += wr_ * b.x - wi_ * b.y;
    }
    km[o] = s;
  }
}

template <int LOPART = 0>
DI void conv_tile(const float* __restrict__ in, int ld_in, bf16_t* __restrict__ out, int ld_out, const float* __restrict__ rs, int k0, int n0, float* sm) {
  const int tid = otid();
  {
    const int k = tid >> 3, n4 = (tid & 7) * 4;
    float4 v = *(const float4*)(in + (size_t)(k0 + k) * ld_in + n0 + n4);
    if (rs) { const float s = rs[k0 + k]; v.x *= s; v.y *= s; v.z *= s; v.w *= s; }
    sm[(n4 + 0) * 65 + k] = v.x; sm[(n4 + 1) * 65 + k] = v.y; sm[(n4 + 2) * 65 + k] = v.z; sm[(n4 + 3) * 65 + k] = v.w;
  }
  __syncthreads();
  {
    const int n = tid >> 4, k4 = (tid & 15) * 4;
    const float* s = sm + n * 65 + k4;
    float v0 = s[0], v1 = s[1], v2 = s[2], v3 = s[3];
    if (LOPART) { v0 -= bf2f(f2bf(v0)); v1 -= bf2f(f2bf(v1)); v2 -= bf2f(f2bf(v2)); v3 -= bf2f(f2bf(v3)); }
    u32x2 o; o[0] = pack2(v0, v1); o[1] = pack2(v2, v3);
    *(u32x2*)(out + (size_t)(n0 + n) * ld_out + k0 + k4) = o;
  }
  __syncthreads();
}
DI void conv_job(const float* in, int ld_in, size_t in_ms, bf16_t* out, int ld_out, size_t out_ms, const float* rs, int K, int N, int multi, float* sm) {
  const int tk = K >> 6, tn = N >> 5, per = tk * tn, total = per * multi;
  const int tid = otid();
  const int k = tid >> 3, n4 = (tid & 7) * 4, n = tid >> 4, k4 = (tid & 15) * 4;
  for (int t0 = blockIdx.x * 4; t0 < total; t0 += gridDim.x * 4) {
    float4 v[4];
#pragma unroll
    for (int q = 0; q < 4; ++q) {
      const int t = t0 + q;
      if (t < total) {
        const int mi = t / per, tt = t % per, k0 = (tt / tn) * 64, n0 = (tt % tn) * 32;
        v[q] = *(const float4*)(in + (size_t)mi * in_ms + (size_t)(k0 + k) * ld_in + n0 + n4);
        if (rs) { const float sc = rs[k0 + k]; v[q].x *= sc; v[q].y *= sc; v[q].z *= sc; v[q].w *= sc; }
      } else v[q] = make_float4(0.f, 0.f, 0.f, 0.f);
    }
#pragma unroll
    for (int q = 0; q < 4; ++q) { float* s_ = sm + q * 2080; s_[(n4 + 0) * 65 + k] = v[q].x; s_[(n4 + 1) * 65 + k] = v[q].y; s_[(n4 + 2) * 65 + k] = v[q].z; s_[(n4 + 3) * 65 + k] = v[q].w; }
    __syncthreads();
#pragma unroll
    for (int q = 0; q < 4; ++q) {
      const int t = t0 + q;
      if (t < total) {
        const int mi = t / per, tt = t % per, k0 = (tt / tn) * 64, n0 = (tt % tn) * 32;
        const float* s_ = sm + q * 2080 + n * 65 + k4;
        u32x2 o; o[0] = pack2(s_[0], s_[1]); o[1] = pack2(s_[2], s_[3]);
        *(u32x2*)(out + (size_t)mi * out_ms + (size_t)(n0 + n) * ld_out + k0 + k4) = o;
      }
    }
    __syncthreads();
  }
}
DI void phase_prep(const Params& p, int l, char* lds) {
  float* sm = (float*)lds;
  GPTR wsg_ = (GPTR)p.ws; asm volatile("" : "+s"(wsg_)); char* ws = (char*)wsg_;
  const int tid = otid(), gtid = blockIdx.x * NTHR + tid, gsz = gridDim.x * NTHR;
  unsigned z0_ = 0u; asm volatile("" : "+v"(z0_));
  const u32x4 zero4 = u32x4{z0_, z0_, z0_, z0_};
  conv_job(p.w_in + (size_t)l * 1024 * INW, INW, 0, (bf16_t*)(ws + O_WIN), 1024, 0, nullptr, 1024, 2208, 1, sm);
  for (int i = gtid; i < 96 * 1024 / 8; i += gsz) ((u32x4*)(ws + O_WIN + (size_t)2208 * 1024 * 2))[i] = zero4;
  conv_job(p.w_in + (size_t)l * 1024 * INW + 2208, INW, 0, (bf16_t*)(ws + O_WG), 1024, 0, nullptr, 1024, 4096, 1, sm);
  conv_job(p.w_mla_uq + (size_t)l * 256 * 384, 384, 0, (bf16_t*)(ws + O_WUQ), 256, 0, p.g_mla_q + l * 256, 256, 384, 1, sm);
  conv_job(p.w_mla_ukv + (size_t)l * 128 * 512, 512, 0, (bf16_t*)(ws + O_WUKV), 128, 0, p.g_mla_kv + l * 128, 128, 512, 1, sm);
  conv_job(p.w_glu + (size_t)l * 65536, 256, 0, (bf16_t*)(ws + O_WGLU), 256, 0, nullptr, 256, 256, 1, sm);
  conv_job(p.w_branch + (size_t)l * 4 * 262144, 1024, 262144, (bf16_t*)(ws + O_WBR), 256, 262144, nullptr, 256, 1024, 4, sm);
  conv_job(p.w_out + (size_t)l * 1048576, 1024, 0, (bf16_t*)(ws + O_WOUT), 1024, 0, nullptr, 1024, 1024, 1, sm);
  conv_job(p.w_e1 + (size_t)l * 64 * 262144, 256, 262144, (bf16_t*)(ws + O_WE1), 1024, 262144, nullptr, 1024, 256, 64, sm);
  conv_job(p.w_e3 + (size_t)l * 64 * 262144, 256, 262144, (bf16_t*)(ws + O_WE3), 1024, 262144, nullptr, 1024, 256, 64, sm);
  conv_job(p.w_e2 + (size_t)l * 64 * 262144, 1024, 262144, (bf16_t*)(ws + O_WE2), 256, 262144, nullptr, 256, 1024, 64, sm);
  conv_job(p.w_s1 + (size_t)l * 262144, 256, 0, (bf16_t*)(ws + O_WE1) + (size_t)64 * 262144, 1024, 0, nullptr, 1024, 256, 1, sm);
  conv_job(p.w_s3 + (size_t)l * 262144, 256, 0, (bf16_t*)(ws + O_WE3) + (size_t)64 * 262144, 1024, 0, nullptr, 1024, 256, 1, sm);
  conv_job(p.w_s2 + (size_t)l * 262144, 1024, 0, (bf16_t*)(ws + O_WE2) + (size_t)64 * 262144, 256, 0, nullptr, 256, 1024, 1, sm);
  for (int t = blockIdx.x; t < 32; t += gridDim.x) {
    conv_tile<0>(p.w_router + (size_t)l * 65536, 64, (bf16_t*)(ws + O_WRHI), 1024, nullptr, (t >> 1) * 64, (t & 1) * 32, sm);
    conv_tile<1>(p.w_router + (size_t)l * 65536, 64, (bf16_t*)(ws + O_WRLO), 1024, nullptr, (t >> 1) * 64, (t & 1) * 32, sm);
  }
  for (int i = gtid; i < 64 * 1024 / 8; i += gsz) { ((u32x4*)(ws + O_WRHI + 64 * 1024 * 2))[i] = zero4; ((u32x4*)(ws + O_WRLO + 64 * 1024 * 2))[i] = zero4; }
  const float2* pw = (const float2*)(ws + O_S5PW) + (size_t)l * 2 * 16 * 65 * 64;
  const float2* bbv = (const float2*)(ws + O_S5BB) + (size_t)l * 2 * 16 * 64 * 16;
  const float* km = (const float*)(ws + O_S5K) + (size_t)l * 2 * 16 * 64 * 256;
  const float* cre = p.s5_c_re + (size_t)l * 2 * 16 * 16 * 64;
  const float* cim = p.s5_c_im + (size_t)l * 2 * 16 * 16 * 64;
  bf16_t* b2 = (bf16_t*)(ws + O_S5B2);
#pragma unroll 1
  for (int it0 = gtid; it0 < 16 * 1024 * 128; it0 += gsz * 4) {
    float4 fa[4][2], fb[4][2]; float dd[4];
#pragma unroll
    for (int u = 0; u < 4; ++u) {
      const int it = it0 + u * gsz;
      const float4 z4 = make_float4(0.f, 0.f, 0.f, 0.f);
      fa[u][0] = z4; fa[u][1] = z4; fb[u][0] = z4; fb[u][1] = z4; dd[u] = 0.f;
      if (it < 16 * 1024 * 128) {
        const int kc = it & 127, gn = it >> 7, n = gn & 1023, g = gn >> 10, i = n >> 4, j = n & 15, k0 = kc * 8, i2 = k0 >> 4, jb = k0 & 15;
        if (i2 <= i) { const float4* q_ = (const float4*)(km + ((((size_t)0 * 16 + g) * 64 + (i - i2)) * 16 + j) * 16 + jb); fa[u][0] = q_[0]; fa[u][1] = q_[1]; }
        if (i2 >= i) { const float4* q_ = (const float4*)(km + ((((size_t)1 * 16 + g) * 64 + (i2 - i)) * 16 + j) * 16 + jb); fb[u][0] = q_[0]; fb[u][1] = q_[1]; }
        if (i2 == i && (j >> 3) == (jb >> 3)) dd[u] = p.s5_d[(l * 16 + g) * 16 + j];
      }
    }
#pragma unroll
    for (int u = 0; u < 4; ++u) {
      const int it = it0 + u * gsz;
      if (it < 16 * 1024 * 128) {
        const int kc = it & 127, gn = it >> 7, j = gn & 15, k0 = kc * 8;
        float v[8] = {0.f + fa[u][0].x + fb[u][0].x, 0.f + fa[u][0].y + fb[u][0].y, 0.f + fa[u][0].z + fb[u][0].z, 0.f + fa[u][0].w + fb[u][0].w,
                      0.f + fa[u][1].x + fb[u][1].x, 0.f + fa[u][1].y + fb[u][1].y, 0.f + fa[u][1].z + fb[u][1].z, 0.f + fa[u][1].w + fb[u][1].w};
#pragma unroll
        for (int e = 0; e < 8; ++e) if (e == (j & 7)) v[e] += dd[u];
        u32x4 o; o[0] = pack2(v[0], v[1]); o[1] = pack2(v[2], v[3]); o[2] = pack2(v[4], v[5]); o[3] = pack2(v[6], v[7]);
        *(u32x4*)(b2 + ((size_t)gn * 1280 + k0)) = o;
      }
    }
  }
#pragma unroll 1
  for (int it0 = gtid; it0 < 16 * 1024 * 32; it0 += gsz * 2) {
    float4 cr4[2][2], ci4[2][2], pw4[2][4];
#pragma unroll
    for (int u = 0; u < 2; ++u) {
      const int it = it0 + u * gsz;
      if (it < 16 * 1024 * 32) {
        const int kq = it & 31, gn = it >> 5, n = gn & 1023, g = gn >> 10, i = n >> 4, j = n & 15;
        const int d = kq >> 4, kk = (kq & 15) * 8, p0 = kk & 63, tau = d ? 64 - i : i + 1;
        const float4* c1 = (const float4*)(cre + (((size_t)d * 16 + g) * 16 + j) * 64 + p0);
        const float4* c2 = (const float4*)(cim + (((size_t)d * 16 + g) * 16 + j) * 64 + p0);
        const float4* c3 = (const float4*)(pw + (((size_t)d * 16 + g) * 65 + tau) * 64 + p0);
        cr4[u][0] = c1[0]; cr4[u][1] = c1[1]; ci4[u][0] = c2[0]; ci4[u][1] = c2[1];
        pw4[u][0] = c3[0]; pw4[u][1] = c3[1]; pw4[u][2] = c3[2]; pw4[u][3] = c3[3];
      }
    }
#pragma unroll
    for (int u = 0; u < 2; ++u) {
      const int it = it0 + u * gsz;
      if (it < 16 * 1024 * 32) {
        const int kq = it & 31, gn = it >> 5, kk = (kq & 15) * 8, ri = kk >> 6;
        const float cr[8] = {cr4[u][0].x, cr4[u][0].y, cr4[u][0].z, cr4[u][0].w, cr4[u][1].x, cr4[u][1].y, cr4[u][1].z, cr4[u][1].w};
        const float ci[8] = {ci4[u][0].x, ci4[u][0].y, ci4[u][0].z, ci4[u][0].w, ci4[u][1].x, ci4[u][1].y, ci4[u][1].z, ci4[u][1].w};
        const float ax[8] = {pw4[u][0].x, pw4[u][0].z, pw4[u][1].x, pw4[u][1].z, pw4[u][2].x, pw4[u][2].z, pw4[u][3].x, pw4[u][3].z};
        const float ay[8] = {pw4[u][0].y, pw4[u][0].w, pw4[u][1].y, pw4[u][1].w, pw4[u][2].y, pw4[u][2].w, pw4[u][3].y, pw4[u][3].w};
        float v[8];
#pragma unroll
        for (int e = 0; e < 8; ++e) {
          const float wr_ = cr[e] * ax[e] - ci[e] * ay[e], wi_ = cr[e] * ay[e] + ci[e] * ax[e];
          v[e] = ri == 0 ? wr_ : -wi_;
        }
        u32x4 o; o[0] = pack2(v[0], v[1]); o[1] = pack2(v[2], v[3]); o[2] = pack2(v[4], v[5]); o[3] = pack2(v[6], v[7]);
        *(u32x4*)(b2 + ((size_t)gn * 1280 + 1024 + kq * 8)) = o;
      }
    }
  }
  bf16_t* b1 = (bf16_t*)(ws + O_S5B1);
#pragma unroll 1
  for (int it0 = gtid; it0 < 16 * 256 * 128; it0 += gsz * 2) {
    float2 a2[2]; float4 b4[2][4];
#pragma unroll
    for (int u = 0; u < 2; ++u) {
      const int it = it0 + u * gsz;
      if (it < 16 * 256 * 128) {
        const int kc = it & 127, gn = it >> 7, n = gn & 255, g = gn >> 8;
        const int d = n >> 7, pp = n & 63, k0 = kc * 8, s = k0 >> 4, jb = k0 & 15;
        a2[u] = pw[(((size_t)d * 16 + g) * 65 + (d ? s : 63 - s)) * 64 + pp];
        const float4* q_ = (const float4*)(bbv + (((size_t)d * 16 + g) * 64 + pp) * 16 + jb);
        b4[u][0] = q_[0]; b4[u][1] = q_[1]; b4[u][2] = q_[2]; b4[u][3] = q_[3];
      }
    }
#pragma unroll
    for (int u = 0; u < 2; ++u) {
      const int it = it0 + u * gsz;
      if (it < 16 * 256 * 128) {
        const int kc = it & 127, gn = it >> 7, n = gn & 255, ri = (n >> 6) & 1, k0 = kc * 8;
        const float2 a = a2[u];
        const float bx[8] = {b4[u][0].x, b4[u][0].z, b4[u][1].x, b4[u][1].z, b4[u][2].x, b4[u][2].z, b4[u][3].x, b4[u][3].z};
        const float by[8] = {b4[u][0].y, b4[u][0].w, b4[u][1].y, b4[u][1].w, b4[u][2].y, b4[u][2].w, b4[u][3].y, b4[u][3].w};
        float v[8];
#pragma unroll
        for (int e = 0; e < 8; ++e) v[e] = ri == 0 ? (a.x * bx[e] - a.y * by[e]) : (a.x * by[e] + a.y * bx[e]);
        u32x4 o; o[0] = pack2(v[0], v[1]); o[1] = pack2(v[2], v[3]); o[2] = pack2(v[4], v[5]); o[3] = pack2(v[6], v[7]);
        *(u32x4*)(b1 + ((size_t)gn * 1024 + k0)) = o;
      }
    }
  }
}

DI void phase_rows(const Params& p, int l, float rscale = 1.f) {
  GPTR wsg_ = (GPTR)p.ws; asm volatile("" : "+s"(wsg_)); char* ws = (char*)wsg_;
  const int tid_ = otid(), lane = tid_ & 63, gw = blockIdx.x * 8 + (tid_ >> 6), nw = gridDim.x * 8;
  bf16_t* X = (bf16_t*)(ws + O_X);
  bf16_t* H1 = (bf16_t*)(ws + O_H1);
  const unsigned char* Y = (const unsigned char*)(ws + O_R);
  const int* slot = (const int*)(ws + O_SLOT);
  const float* gwt = (const float*)(ws + O_GW);
  const int* cnt = (const int*)(ws + O_CNT);
  const float* ada = (const float*)(ws + O_ADA);
  int poff64 = 0;
  if (l > 0) { for (int e = 0; e < 64; ++e) poff64 += (cnt[e] + 255) & ~255; }
  for (int row = gw; row < NTOK; row += nw) {
    int b, isctx, t; tokinfo(row, b, isctx, t);
    const int cv = isctx ? 2 : b;
    float xv[16];
    if (l == 0) {
      const float* src = isctx ? p.ctx + (size_t)(b * 256 + t) * 1024 : p.x + (size_t)row * 1024;
#pragma unroll
      for (int i = 0; i < 4; ++i) { const float4 v = *(const float4*)(src + i * 256 + lane * 4); xv[i * 4] = v.x; xv[i * 4 + 1] = v.y; xv[i * 4 + 2] = v.z; xv[i * 4 + 3] = v.w; }
    } else {
      const bf16_t* src = X + (size_t)row * 1024;
#pragma unroll
      for (int i = 0; i < 4; ++i) { const u32x2 v = *(const u32x2*)(src + i * 256 + lane * 4);
        xv[i * 4] = __uint_as_float(v[0] << 16); xv[i * 4 + 1] = __uint_as_float(v[0] & 0xffff0000u); xv[i * 4 + 2] = __uint_as_float(v[1] << 16); xv[i * 4 + 3] = __uint_as_float(v[1] & 0xffff0000u); }
      float f[16];
      typedef float fl2v __attribute__((ext_vector_type(2)));
      {
        const bf16_t* ys = (const bf16_t*)(ws + O_R + (size_t)YROWS * 1024) + (size_t)row * 1024;
#pragma unroll
        for (int i = 0; i < 4; ++i) { const u32x2 v = *(const u32x2*)(ys + i * 256 + lane * 4);
          f[i * 4] = rscale * __uint_as_float(v[0] << 16); f[i * 4 + 1] = rscale * __uint_as_float(v[0] & 0xffff0000u); f[i * 4 + 2] = rscale * __uint_as_float(v[1] << 16); f[i * 4 + 3] = rscale * __uint_as_float(v[1] & 0xffff0000u); }
      }
      int sv = 0; float wv = 0.f;
      if (lane < 6) { sv = slot[row * 6 + lane]; wv = gwt[row * 6 + lane] * rscale * 0.0625f; }
      int yv[6][4];
#pragma unroll
      for (int k = 0; k < 6; ++k) {
        const int s = __builtin_amdgcn_readlane(sv, k);
        const unsigned char* ys = Y + (size_t)s * 1024;
#pragma unroll
        for (int i = 0; i < 4; ++i) yv[k][i] = *(const int*)(ys + i * 256 + lane * 4);
      }
#pragma unroll
      for (int k = 0; k < 6; ++k) {
        const float w = __int_as_float(__builtin_amdgcn_readlane(__float_as_int(wv), k));
#pragma unroll
        for (int i = 0; i < 4; ++i) {
          const fl2v lo = __builtin_amdgcn_cvt_pk_f32_fp8(yv[k][i], false), hi = __builtin_amdgcn_cvt_pk_f32_fp8(yv[k][i], true);
          f[i * 4] += w * lo[0]; f[i * 4 + 1] += w * lo[1]; f[i * 4 + 2] += w * hi[0]; f[i * 4 + 3] += w * hi[1]; }
      }
      const float* gt2 = ada + ((l - 1) * 3 + cv) * 6144 + 5 * 1024;
#pragma unroll
      for (int i = 0; i < 4; ++i) { const float4 g = *(const float4*)(gt2 + i * 256 + lane * 4);
        xv[i * 4] += g.x * f[i * 4]; xv[i * 4 + 1] += g.y * f[i * 4 + 1]; xv[i * 4 + 2] += g.z * f[i * 4 + 2]; xv[i * 4 + 3] += g.w * f[i * 4 + 3]; }
    }
    float ss = 0.f;
#pragma unroll
    for (int i = 0; i < 16; ++i) ss += xv[i] * xv[i];
    ss = wave_sum(ss, lane);
    const float rstd = rsqrtf(ss * (1.f / 1024.f) + EPS);
    if (l < DEPTH) {
      bf16_t* dst = X + (size_t)row * 1024;
#pragma unroll
      for (int i = 0; i < 4; ++i) { u32x2 o2; o2[0] = pack2(xv[i * 4], xv[i * 4 + 1]); o2[1] = pack2(xv[i * 4 + 2], xv[i * 4 + 3]); *(u32x2*)(dst + i * 256 + lane * 4) = o2; }
      const float* gn = p.g_norm1 + l * 1024;
      const float* sh = ada + (l * 3 + cv) * 6144;
      const float* sc = sh + 1024;
      bf16_t* hd = H1 + (size_t)row * 1024;
#pragma unroll
      for (int i = 0; i < 4; ++i) {
        const int o = i * 256 + lane * 4;
        const float4 g = *(const float4*)(gn + o), s1 = *(const float4*)(sh + o), s2 = *(const float4*)(sc + o);
        const float h0 = xv[i * 4] * rstd * g.x * (1.f + s2.x) + s1.x, h1 = xv[i * 4 + 1] * rstd * g.y * (1.f + s2.y) + s1.y;
        const float h2 = xv[i * 4 + 2] * rstd * g.z * (1.f + s2.z) + s1.z, h3 = xv[i * 4 + 3] * rstd * g.w * (1.f + s2.w) + s1.w;
        u32x2 o2; o2[0] = pack2(h0, h1); o2[1] = pack2(h2, h3);
        *(u32x2*)(hd + o) = o2;
      }
    } else if (!isctx) {
      float* dst = p.out + (size_t)row * 1024;
#pragma unroll
      for (int i = 0; i < 4; ++i) {
        const int o = i * 256 + lane * 4;
        const float4 g = *(const float4*)(p.g_final + o);
        *(float4*)(dst + o) = make_float4(xv[i * 4] * rstd * g.x, xv[i * 4 + 1] * rstd * g.y, xv[i * 4 + 2] * rstd * g.z, xv[i * 4 + 3] * rstd * g.w);
      }
    }
  }
}

#define EPI_ROW_BEGIN \
  _Pragma("unroll") for (int m = 0; m < 4; ++m) { \
    int row = m0 + wr * 64 + m * 16 + fr; asm volatile("" : "+v"(row)); \
    int b, isctx, t; tokinfo(row, b, isctx, t); const int kidx = isctx ? SEQ + t : t; (void)kidx;
#define EPI_ROW_END }
DI f32x4 rope4(const f32x4& v, int c4, int half, int t, const float2* roper, const float2* ropec) {
  f32x4 r;
#pragma unroll
  for (int j = 0; j < 4; ++j) { const float partner = xhalf_get(v[j], c4 >> 3); r[j] = rope_apply(v[j], partner, c4 + j, half, t, roper, ropec); }
  return r;
}
DI void phase_proj(const Params& p, char* lds) {
  GPTR wsg_ = (GPTR)p.ws; asm volatile("" : "+s"(wsg_)); char* ws = (char*)wsg_;
  const float2* roper = (const float2*)(ws + O_ROPER);
  const float2* ropec = (const float2*)(ws + O_ROPEC);
  const UM um(130, 9);
  int mt, ntile;
  for (int k = 0; um.get(k, mt, ntile); ++k) {
    const int m0 = mt * 256, n0 = ntile * 256;
    f32x4 acc[2][2][4][2]; zero_acc8(acc);
    asm volatile("s_waitcnt vmcnt(0)" ::: "memory");
    gemm8<false>(acc, (const bf16_t*)(ws + O_H1), nullptr, m0, (const bf16_t*)(ws + O_WIN) + (size_t)n0 * 1024, (const bf16_t*)(ws + O_WIN) + (size_t)(n0 + 128) * 1024, 1024, lds);
    const int tid = otid(), lane = tid & 63, wid = tid >> 6, wr = wid >> 2, wc = wid & 3, fr = lane & 15, fq = lane >> 4, c4 = fq * 4;
#define EPI8_BEGIN \
    _Pragma("unroll") for (int ai = 0; ai < 2; ++ai) _Pragma("unroll") for (int m = 0; m < 4; ++m) { \
      int row = m0 + ai * 128 + wr * 64 + m * 16 + fr; asm volatile("" : "+v"(row)); \
      int b, isctx, t; tokinfo(row, b, isctx, t); const int kidx = isctx ? SEQ + t : t; (void)kidx; \
      _Pragma("unroll") for (int n = 0; n < 2; ++n) { const int c16 = cb + wc * 32 + n * 16; const f32x4 v = acc[ai][bj][m][n];
#define EPI8_END } }
#pragma unroll
    for (int bj = 0; bj < 2; ++bj) {
      const int cb = n0 + bj * 128, ont = cb >> 7;
      if (ont < 6) {
        const int which = cb >> 8;
        bf16_t* dst = (bf16_t*)(ws + (which == 0 ? O_QN : (which == 1 ? O_KN : O_VN)));
        const float sc = which == 0 ? NA_QS : 1.f;
        EPI8_BEGIN
          const int head = (c16 >> 6) & 3, d = (c16 & 63) + c4;
          bf16_t* hb = dst + (size_t)(b * 4 + head) * KLEN * 64;
          const size_t off = which == 0 ? (size_t)kidx * 64 + d : (which == 1 ? kimg<64>(kidx, d) : vimg(kidx, d));
          *(u32x2*)(hb + off) = pack4(v * sc);
        EPI8_END
      } else if (ont < 10) {
        const int isk = ont >= 8;
        bf16_t *QdL = (bf16_t*)(ws + O_QDL), *QdR = (bf16_t*)(ws + O_QDR), *Kd = (bf16_t*)(ws + O_KD);
        EPI8_BEGIN
          const int cc = c16 - (isk ? 1024 : 768), head8 = cc >> 5, half = (cc >> 4) & 1, d = half * 16 + c4;
          const f32x4 rv = rope4(v, c4, half, t, roper, ropec);
          if (!isk) {
            *(u32x2*)(QdR + ((size_t)(b * 8 + head8) * KLEN + kidx) * 32 + d) = pack4(v * DIFF_QS);
            if (!isctx) *(u32x2*)(QdL + ((size_t)(b * 8 + head8) * SEQ + t) * 32 + d) = pack4(rv * DIFF_QS);
          } else {
            *(u32x2*)(Kd + (size_t)(b * 8 + head8) * KLEN * 32 + kimg<32>(kidx, d)) = pack4(isctx ? v : rv);
          }
        EPI8_END
      } else if (ont < 12) {
        bf16_t* Vd = (bf16_t*)(ws + O_VD);
        EPI8_BEGIN
          const int cc = c16 - 1280, head = cc >> 6, d = (cc & 63) + c4;
          *(u32x2*)(Vd + (size_t)(b * 4 + head) * KLEN * 64 + vimg(kidx, d)) = pack4(v);
        EPI8_END
      } else if (ont < 15) {
        bf16_t* dst = ont < 14 ? (bf16_t*)(ws + O_CQ) : (bf16_t*)(ws + O_CKV);
        const int ldd = ont < 14 ? 256 : 128, base = ont < 14 ? 1536 : 1792;
        EPI8_BEGIN
          *(u32x2*)(dst + (size_t)row * ldd + (c16 - base) + c4) = pack4(v);
        EPI8_END
      } else {
        bf16_t *Km = (bf16_t*)(ws + O_KM), *Uc = (bf16_t*)(ws + O_UCAT);
        EPI8_BEGIN
          if (c16 < 1952) {
            const int half = ((c16 - 1920) >> 4) & 1, d = half * 16 + c4;
            const f32x4 rv = rope4(v, c4, half, t, roper, ropec);
            const u32x2 o = pack4(isctx ? v : rv);
#pragma unroll
            for (int h = 0; h < 4; ++h) *(u32x2*)(Km + (size_t)(b * 4 + h) * KLEN * 96 + kimg<96>(kidx, 64 + d)) = o;
          } else if (c16 < 2208) {
            const int g = (c16 - 1952) >> 4;
            const int sp = isctx ? t : 256 + t;
            *(u32x2*)(Uc + ((size_t)(g * 520 + b * NCHUNK + (sp >> 6)) * 1280) + (sp & 63) * 16 + c4) = pack4(v);
          }
        EPI8_END
      }
    }
#undef EPI8_BEGIN
#undef EPI8_END
  }
}

template <int NI>
DI void row_scales(const bf16_t* A, int row0, int kd, float* rs, int lane) {
  const int r_ = lane >> 2, q_ = lane & 3;
  u32x4 v[2][NI];
#pragma unroll
  for (int ps = 0; ps < 2; ++ps)
#pragma unroll
    for (int i = 0; i < NI; ++i) v[ps][i] = *(const u32x4*)(A + (size_t)(row0 + ps * 16 + r_) * kd + (i * 4 + q_) * 8);
#pragma unroll
  for (int ps = 0; ps < 2; ++ps) {
    float s = 0.f;
#pragma unroll
    for (int i = 0; i < NI; ++i)
#pragma unroll
      for (int e = 0; e < 4; ++e) { const float a = __uint_as_float(v[ps][i][e] << 16), b_ = __uint_as_float(v[ps][i][e] & 0xffff0000u); s += a * a; s += b_ * b_; }
    s += bperm(s, lane ^ 1); s += bperm(s, lane ^ 2);
    if (q_ == 0) rs[ps * 16 + r_] = rsqrtf(s / (float)kd + EPS);
  }
}
DI void phase_up(const Params& p, char* lds) {
  GPTR wsg_ = (GPTR)p.ws; asm volatile("" : "+s"(wsg_)); char* ws = (char*)wsg_;
  const int tid = otid(), lane = tid & 63, wid = tid >> 6, wr = wid >> 1, wc = wid & 1, fr = lane & 15, fq = lane >> 4, c4 = fq * 4;
  const float2* roper = (const float2*)(ws + O_ROPER);
  const float2* ropec = (const float2*)(ws + O_ROPEC);
  const bf16_t *CQ = (const bf16_t*)(ws + O_CQ), *CKV = (const bf16_t*)(ws + O_CKV);
  bf16_t *QmL = (bf16_t*)(ws + O_QML), *QmR = (bf16_t*)(ws + O_QMR), *Km = (bf16_t*)(ws + O_KM), *Vm = (bf16_t*)(ws + O_VM);
  float* rs = (float*)(lds + GEMM_LDS);
  auto job = [&](int u) {
    if (u < 390) return gj_make(CQ, nullptr, 256, (u / 3) * 256, (const bf16_t*)(ws + O_WUQ), 256, (u % 3) * 128, 256);
    if (u < 910) { const int uu = u - 390; return gj_make(CKV, nullptr, 128, (uu / 4) * 256, (const bf16_t*)(ws + O_WUKV), 128, (uu % 4) * 128, 128); }
    if (u < 1006) { const int uu = u - 910, g = uu / 6; return gj_make((const bf16_t*)(ws + O_UCAT) + (size_t)g * 520 * 1280, nullptr, 1280, ((uu % 6) >> 1) * 256, (const bf16_t*)(ws + O_S5B1) + (size_t)g * 256 * 1024, 1024, (uu & 1) * 128, 1024); }
    return gj_none();
  };
  GStream<GNST> gs; gs.start(job(blockIdx.x), lds, tid);
  for (int u = blockIdx.x; u < 1006; u += gridDim.x) {
    f32x4 acc[4][4]; zero_acc(acc);
    if (u < 910) {
      const bool isq = u < 390;
      const int uu = isq ? u : u - 390;
      const int mt = isq ? uu / 3 : uu / 4, ntile = isq ? uu % 3 : uu % 4, m0 = mt * 256, n0 = ntile * 128;
      const int kd = isq ? 256 : 128;
      const bf16_t* A = isq ? CQ : CKV;
      if (isq) row_scales<8>(A, m0 + wid * 32, 256, rs + wid * 32, lane); else row_scales<4>(A, m0 + wid * 32, 128, rs + wid * 32, lane);
      gs.run2(acc, job(u + gridDim.x));
#pragma unroll
      for (int m = 0; m < 4; ++m) {
        int lr = wr * 64 + m * 16 + fr;
        asm volatile("" : "+v"(lr));
        const int row = m0 + lr;
        int b, isctx, t; tokinfo(row, b, isctx, t);
        const int kidx = isctx ? SEQ + t : t;
        const float rsc = rs[lr];
#pragma unroll
        for (int n = 0; n < 4; ++n) {
          const int c16 = n0 + wc * 64 + n * 16;
          if (isq) {
            const int head = c16 / 96, dd = c16 % 96, d = dd + c4;
            const f32x4 v = acc[m][n] * (rsc * MLA_QS);
            bf16_t* qr_ = QmR + ((size_t)(b * 4 + head) * KLEN + kidx) * 96 + d;
            bf16_t* ql_ = QmL + ((size_t)(b * 4 + head) * SEQ + t) * 96 + d;
            if (dd < 64) {
              const u32x2 o = pack4(v);
              *(u32x2*)qr_ = o;
              if (!isctx) *(u32x2*)ql_ = o;
            } else {
              const f32x4 rv = rope4(v, c4, (dd >> 4) & 1, t, roper, ropec);
              *(u32x2*)qr_ = pack4(v);
              if (!isctx) *(u32x2*)ql_ = pack4(rv);
            }
          } else {
            const int head = c16 >> 7, dd = c16 & 127, d = dd + c4;
            const f32x4 v = acc[m][n] * rsc;
            if (dd < 64) *(u32x2*)(Km + (size_t)(b * 4 + head) * KLEN * 96 + kimg<96>(kidx, d)) = pack4(v);
            else *(u32x2*)(Vm + (size_t)(b * 4 + head) * KLEN * 64 + vimg(kidx, d - 64)) = pack4(v);
          }
        }
      }
      asm volatile("s_waitcnt lgkmcnt(0)" ::: "memory"); __builtin_amdgcn_s_barrier();
    } else {
      const int uu = u - 910, g = uu / 6, mt = (uu % 6) >> 1, ntile = uu & 1, m0 = mt * 256, n0 = ntile * 128;
      gs.run2(acc, job(u + gridDim.x));
      float* sloc = (float*)(ws + O_SLOC) + (size_t)g * 520 * 256;
#pragma unroll
      for (int m = 0; m < 4; ++m) {
        const int row = m0 + wr * 64 + m * 16 + fr;
        if (row < 520) {
#pragma unroll
          for (int n = 0; n < 4; ++n) *(f32x4*)(sloc + (size_t)row * 256 + n0 + wc * 64 + n * 16 + c4) = acc[m][n];
        }
      }
    }
  }
}

constexpr int ATT_NST = 4, ATT_STG = 20480, ATT_RPB = ATT_NST * ATT_STG, ATT_LDS = ATT_RPB + 2048;
template <int DK, int NMAP, int MODE, bool FAST>
DI void attn_unit(const bf16_t* const (&Qlat)[NMAP], const bf16_t* const (&Qraw)[NMAP], const bf16_t* const (&Kp)[NMAP], const bf16_t* Vp,
                  int qb, char* lds, float (&lout)[NMAP], f32x16 (&o)[NMAP][2], const float* rpbL) {
  constexpr int KS = DK / 16, KMAP = DK * 128, KBYTES = NMAP * KMAP;
  constexpr int NPOS = KBYTES / 16, KR = (NPOS + NTHR - 1) / NTHR, LPS = KR + 1;
  const int tid = otid(), lane = tid & 63, wid = tid >> 6, r32 = lane & 31, hi = lane >> 5;
  const int qrow = (MODE == 2 ? SEQ : qb * 256) + wid * 32 + r32;
  bf16x8 qf[NMAP][KS];
#pragma unroll
  for (int m = 0; m < NMAP; ++m)
#pragma unroll
    for (int s = 0; s < KS; ++s) qf[m][s] = *(const bf16x8*)((MODE == 0 ? Qlat[m] : Qraw[m]) + (size_t)qrow * DK + s * 16 + hi * 8);
  float mrun[NMAP], lrun[NMAP];
#pragma unroll
  for (int m = 0; m < NMAP; ++m) { mrun[m] = -1e30f; lrun[m] = 0.f; o[m][0] = f32x16{}; o[m][1] = f32x16{}; }
  int kt_lo = 0, kt_hi = 260;
  const int rq = qb * 4 + (wid >> 1), cq = (wid & 1) * 32 + r32;
  if (MODE == 1) { int lo = qb * 4 - 4; lo = lo < 0 ? 0 : (lo > 248 ? 248 : lo); int hi_ = qb * 4 + 3 - 4; hi_ = hi_ < 0 ? 0 : (hi_ > 248 ? 248 : hi_); kt_lo = lo; kt_hi = hi_ + 8; }
  if (MODE == 2) { kt_lo = 256; kt_hi = 260; }
  const int ntile = (MODE == 1) ? (kt_hi - kt_lo + 4) : (kt_hi - kt_lo);
  auto tile_of = [&](int i) { return (MODE == 1 && i >= kt_hi - kt_lo) ? 256 + (i - (kt_hi - kt_lo)) : kt_lo + i; };
  const bf16_t* ksrc[KR];
  int kdst[KR];
#pragma unroll
  for (int i = 0; i < KR; ++i) {
    int q = tid + i * NTHR; if (q >= NPOS) q -= NTHR;
    const int m = q / (KMAP / 16), w = q % (KMAP / 16);
    ksrc[i] = ((NMAP == 2 && m == 1) ? Kp[NMAP - 1] : Kp[0]) + w * 8;
    kdst[i] = q * 16;
  }
  const bf16_t* vsrc = Vp + tid * 8;
  auto issue = [&](int i) {
    const int kt = tile_of(i);
    char* sb = lds + (i % ATT_NST) * ATT_STG;
#pragma unroll
    for (int r = 0; r < KR; ++r) glds16(ksrc[r] + (size_t)kt * 64 * DK, (unsigned)__builtin_amdgcn_readfirstlane((int)(unsigned)(uintptr_t)(sb + kdst[r])));
    glds16(vsrc + (size_t)kt * 4096, (unsigned)__builtin_amdgcn_readfirstlane((int)(unsigned)(uintptr_t)(sb + KBYTES + tid * 16)));
  };
  const int voff = KBYTES + ((lane >> 4) & 1) * 32 + (lane & 3) * 8 + (4 * hi + ((lane & 15) >> 2)) * 64;
#pragma unroll
  for (int m = 0; m < NMAP; ++m)
#pragma unroll
    for (int s = 0; s < KS; ++s) asm volatile("" :: "v"(qf[m][s]));
  asm volatile("s_waitcnt vmcnt(0)" ::: "memory");
#pragma unroll
  for (int i = 0; i < ATT_NST - 1; ++i) if (i < ntile) issue(i);
  auto step = [&](int it) {
    const int kt = tile_of(it);
    {
      const int infl = (ntile - 1 - it) < (ATT_NST - 2) ? (ntile - 1 - it) : (ATT_NST - 2);
      if (infl >= 2) { if (LPS == 2) asm volatile("s_waitcnt vmcnt(4)" ::: "memory"); else asm volatile("s_waitcnt vmcnt(6)" ::: "memory"); }
      else if (infl == 1) { if (LPS == 2) asm volatile("s_waitcnt vmcnt(2)" ::: "memory"); else asm volatile("s_waitcnt vmcnt(3)" ::: "memory"); }
      else asm volatile("s_waitcnt vmcnt(0)" ::: "memory");
    }
    __builtin_amdgcn_s_barrier();
    char* buf = lds + (it % ATT_NST) * ATT_STG;
    bool active = true;
    int dr = 0;
    if (MODE == 1 && kt < 256) { int rs_ = rq - 4; rs_ = rs_ < 0 ? 0 : (rs_ > 248 ? 248 : rs_); active = (kt >= rs_) && (kt < rs_ + 8); dr = kt - rq + 7; }
    if (!active) { if (it + ATT_NST - 1 < ntile) issue(it + ATT_NST - 1); }
    if (active) {
      const char* vp0 = buf + voff;
      bf16x8 pf[NMAP][4];
#pragma unroll
      for (int m = 0; m < NMAP; ++m) {
        f32x16 s0 = f32x16{}, s1 = f32x16{};
        const char* kb = buf + m * KMAP + hi * 1024 + r32 * 16;
#pragma unroll
        for (int s = 0; s < KS; ++s) {
          const bf16x8 k0 = *(const bf16x8*)(kb + s * 2048);
          const bf16x8 k1 = *(const bf16x8*)(kb + s * 2048 + 512);
          s0 = MFMA32(k0, qf[m][s], s0);
          s1 = MFMA32(k1, qf[m][s], s1);
        }
        if (MODE == 1 && kt < 256) {
          int cs = cq - 8; cs = cs < 0 ? 0 : (cs > 48 ? 48 : cs);
#pragma unroll
          for (int r = 0; r < 16; ++r) {
            const int ck0 = crow(r, hi), ck1 = 32 + ck0;
            s0[r] = (ck0 >= cs && ck0 < cs + 16) ? s0[r] + rpbL[dr * 31 + (ck0 - cq + 15)] : -1e30f;
            s1[r] = (ck1 >= cs && ck1 < cs + 16) ? s1[r] + rpbL[dr * 31 + (ck1 - cq + 15)] : -1e30f;
          }
        }
        float ps = 0.f;
        if (FAST) {
#pragma unroll
          for (int r = 0; r < 16; ++r) { s0[r] = __builtin_amdgcn_exp2f(s0[r]); s1[r] = __builtin_amdgcn_exp2f(s1[r]); ps += s0[r] + s1[r]; }
          lrun[m] += ps;
        } else {
          float mx = fmaxf(s0[0], s1[0]);
#pragma unroll
          for (int r = 1; r < 16; ++r) mx = fmaxf(mx, fmaxf(s0[r], s1[r]));
          mx = xhalf_max(mx);
          const float mnew = fmaxf(mrun[m], mx);
          const float alpha = __builtin_amdgcn_exp2f(mrun[m] - mnew);
          mrun[m] = mnew;
#pragma unroll
          for (int r = 0; r < 16; ++r) { s0[r] = __builtin_amdgcn_exp2f(s0[r] - mnew); s1[r] = __builtin_amdgcn_exp2f(s1[r] - mnew); ps += s0[r] + s1[r]; }
          lrun[m] = lrun[m] * alpha + ps;
#pragma unroll
          for (int r = 0; r < 16; ++r) { o[m][0][r] *= alpha; o[m][1][r] *= alpha; }
        }
#pragma unroll
        for (int ks = 0; ks < 4; ++ks) {
          u32x4 pk;
#pragma unroll
          for (int e = 0; e < 4; ++e) {
            const int r = (ks & 1) * 8 + e * 2;
            pk[e] = (ks < 2) ? pack2(s0[r], s0[r + 1]) : pack2(s1[r], s1[r + 1]);
          }
          pf[m][ks] = __builtin_bit_cast(bf16x8, pk);
        }
      }
      if (it + ATT_NST - 1 < ntile) issue(it + ATT_NST - 1);
#pragma unroll
      for (int d0 = 0; d0 < 2; ++d0) {
        bf16x8 vf[4];
#pragma unroll
        for (int ks = 0; ks < 4; ++ks) {
          const s16x4 lo = __builtin_bit_cast(s16x4, __builtin_amdgcn_ds_read_tr16_b64_v4i16((__attribute__((address_space(3))) v4i16_t*)(vp0 + d0 * 4096 + ks * 1024)));
          const s16x4 hh = __builtin_bit_cast(s16x4, __builtin_amdgcn_ds_read_tr16_b64_v4i16((__attribute__((address_space(3))) v4i16_t*)(vp0 + d0 * 4096 + ks * 1024 + 512)));
          vf[ks] = bf16x8{lo[0], lo[1], lo[2], lo[3], hh[0], hh[1], hh[2], hh[3]};
        }
#pragma unroll
        for (int m = 0; m < NMAP; ++m)
#pragma unroll
          for (int ks = 0; ks < 4; ++ks) o[m][d0] = MFMA32(vf[ks], pf[m][ks], o[m][d0]);
      }
    }
  };
  const int n1 = MODE == 0 ? 256 : ntile;
#pragma unroll 1
  for (int it = 0; it < n1; ++it) step(it);
  if (MODE == 0) {
#pragma unroll
    for (int m = 0; m < NMAP; ++m)
#pragma unroll
      for (int s = 0; s < KS; ++s) qf[m][s] = *(const bf16x8*)(Qraw[m] + (size_t)qrow * DK + s * 16 + hi * 8);
#pragma unroll
    for (int m = 0; m < NMAP; ++m)
#pragma unroll
      for (int s = 0; s < KS; ++s) asm volatile("" :: "v"(qf[m][s]));
#pragma unroll 1
    for (int it = 256; it < ntile; ++it) step(it);
  }
#pragma unroll
  for (int m = 0; m < NMAP; ++m) lout[m] = xhalf(lrun[m]);
  __syncthreads();
}
DI bool lsum_bad(float l) { return !(l > 1e-18f && l < 1e18f); }
DI bool block_any(bool v, char* lds) {
  volatile LAS int* flg = (volatile LAS int*)(lds + ATT_RPB + 2032);
  if (otid() == 0) *flg = 0;
  __syncthreads();
  if (v) *flg = 1;
  __syncthreads();
  const int r = *flg;
  __syncthreads();
  return r != 0;
}

DI void attn_store(const float (&val)[2][16], bf16_t* ycat, int token, int colbase, int hi) {
#pragma unroll
  for (int d0 = 0; d0 < 2; ++d0)
#pragma unroll
    for (int g = 0; g < 4; ++g) {
      u32x2 v; v[0] = pack2(val[d0][4 * g], val[d0][4 * g + 1]); v[1] = pack2(val[d0][4 * g + 2], val[d0][4 * g + 3]);
      *(u32x2*)(ycat + (size_t)token * 1024 + colbase + d0 * 32 + 8 * g + 4 * hi) = v;
    }
}

template <int MODE>
DI void attn_diff(const Params& p, int l, int b, int h, int qb, char* lds) {
  GPTR wsg_ = (GPTR)p.ws; asm volatile("" : "+s"(wsg_)); char* ws = (char*)wsg_;
  const bf16_t* const ql[2] = {(const bf16_t*)(ws + O_QDL) + (size_t)(b * 8 + 2 * h) * SEQ * 32, (const bf16_t*)(ws + O_QDL) + (size_t)(b * 8 + 2 * h + 1) * SEQ * 32};
  const bf16_t* const qr[2] = {(const bf16_t*)(ws + O_QDR) + (size_t)(b * 8 + 2 * h) * KLEN * 32, (const bf16_t*)(ws + O_QDR) + (size_t)(b * 8 + 2 * h + 1) * KLEN * 32};
  const bf16_t* const kp[2] = {(const bf16_t*)(ws + O_KD) + (size_t)(b * 8 + 2 * h) * KLEN * 32, (const bf16_t*)(ws + O_KD) + (size_t)(b * 8 + 2 * h + 1) * KLEN * 32};
  const bf16_t* vp = (const bf16_t*)(ws + O_VD) + (size_t)(b * 4 + h) * KLEN * 64;
  float lo[2]; f32x16 o[2][2];
  attn_unit<32, 2, MODE, true>(ql, qr, kp, vp, qb, lds, lo, o, nullptr);
  if (block_any(lsum_bad(lo[0]) || lsum_bad(lo[1]), lds)) attn_unit<32, 2, MODE, false>(ql, qr, kp, vp, qb, lds, lo, o, nullptr);
  const int tid_ = otid(), lane = tid_ & 63, wid = tid_ >> 6, r32 = lane & 31, hi = lane >> 5;
  int lq = l; asm volatile("" : "+s"(lq));
  const float lam = ((const float*)(ws + O_LAMF))[lq];
  const float lam_init = 0.8f - 0.6f * expf(-0.3f * (float)lq);
  const float i0 = 1.f / lo[0], i1 = lam / lo[1];
  float d[2][16]; float ss = 0.f;
#pragma unroll
  for (int d0 = 0; d0 < 2; ++d0)
#pragma unroll
    for (int r = 0; r < 16; ++r) { d[d0][r] = o[0][d0][r] * i0 - o[1][d0][r] * i1; ss += d[d0][r] * d[d0][r]; }
  ss = xhalf(ss);
  const float rstd = rsqrtf(ss * (1.f / 64.f) + EPS) * (1.f - lam_init);
  const float* gs = p.g_diff + lq * 64;
#pragma unroll
  for (int d0 = 0; d0 < 2; ++d0)
#pragma unroll
    for (int r = 0; r < 16; ++r) d[d0][r] *= rstd * gs[d0 * 32 + crow(r, hi)];
  const int token = MODE == 2 ? NL + b * 256 + wid * 32 + r32 : b * SEQ + qb * 256 + wid * 32 + r32;
  attn_store(d, (bf16_t*)(ws + O_YCAT), token, 256 + h * 64, hi);
}
template <int MODE>
DI void attn_mla(const Params& p, int b, int h, int qb, char* lds) {
  GPTR wsg_ = (GPTR)p.ws; asm volatile("" : "+s"(wsg_)); char* ws = (char*)wsg_;
  const bf16_t* const ql[1] = {(const bf16_t*)(ws + O_QML) + (size_t)(b * 4 + h) * SEQ * 96};
  const bf16_t* const qr[1] = {(const bf16_t*)(ws + O_QMR) + (size_t)(b * 4 + h) * KLEN * 96};
  const bf16_t* const kp[1] = {(const bf16_t*)(ws + O_KM) + (size_t)(b * 4 + h) * KLEN * 96};
  const bf16_t* vp = (const bf16_t*)(ws + O_VM) + (size_t)(b * 4 + h) * KLEN * 64;
  float lo[1]; f32x16 o[1][2];
  attn_unit<96, 1, MODE, true>(ql, qr, kp, vp, qb, lds, lo, o, nullptr);
  if (block_any(lsum_bad(lo[0]), lds)) attn_unit<96, 1, MODE, false>(ql, qr, kp, vp, qb, lds, lo, o, nullptr);
  const int tid_ = otid(), lane = tid_ & 63, wid = tid_ >> 6, r32 = lane & 31, hi = lane >> 5;
  const float inv = 1.f / lo[0];
  float d[2][16];
#pragma unroll
  for (int d0 = 0; d0 < 2; ++d0)
#pragma unroll
    for (int r = 0; r < 16; ++r) d[d0][r] = o[0][d0][r] * inv;
  const int token = MODE == 2 ? NL + b * 256 + wid * 32 + r32 : b * SEQ + qb * 256 + wid * 32 + r32;
  attn_store(d, (bf16_t*)(ws + O_YCAT), token, 512 + h * 64, hi);
}
template <int MODE>
DI void attn_na(const Params& p, int l, int b, int h, int qb, char* lds) {
  GPTR wsg_ = (GPTR)p.ws; asm volatile("" : "+s"(wsg_)); char* ws = (char*)wsg_;
  float* rpbL = (float*)(lds + ATT_RPB);
  if (MODE == 1) {
    __syncthreads();
    for (int i = otid(); i < 465; i += NTHR) rpbL[i] = p.na_rpb[(size_t)(l * 4 + h) * 465 + i] * LOG2E;
    __syncthreads();
  }
  const bf16_t* const qr[1] = {(const bf16_t*)(ws + O_QN) + (size_t)(b * 4 + h) * KLEN * 64};
  const bf16_t* const kp[1] = {(const bf16_t*)(ws + O_KN) + (size_t)(b * 4 + h) * KLEN * 64};
  const bf16_t* vp = (const bf16_t*)(ws + O_VN) + (size_t)(b * 4 + h) * KLEN * 64;
  float lo[1]; f32x16 o[1][2];
  attn_unit<64, 1, MODE, true>(qr, qr, kp, vp, qb, lds, lo, o, rpbL);
  if (block_any(lsum_bad(lo[0]), lds)) attn_unit<64, 1, MODE, false>(qr, qr, kp, vp, qb, lds, lo, o, rpbL);
  const int tid_ = otid(), lane = tid_ & 63, wid = tid_ >> 6, r32 = lane & 31, hi = lane >> 5;
  const float inv = 1.f / lo[0];
  float d[2][16];
#pragma unroll
  for (int d0 = 0; d0 < 2; ++d0)
#pragma unroll
    for (int r = 0; r < 16; ++r) d[d0][r] = o[0][d0][r] * inv;
  const int token = MODE == 2 ? NL + b * 256 + wid * 32 + r32 : b * SEQ + qb * 256 + wid * 32 + r32;
  attn_store(d, (bf16_t*)(ws + O_YCAT), token, h * 64, hi);
}

DI void phase_attn(const Params& p, int l, char* lds) {
  GPTR wsg_ = (GPTR)p.ws; asm volatile("" : "+s"(wsg_)); char* ws = (char*)wsg_;
  if (blockIdx.x < 8) {
    const int id = blockIdx.x * NTHR + otid();
    const int pp = id & 63, d = (id >> 6) & 1, g = (id >> 7) & 15, b = id >> 11;
    const float2 a64 = ((const float2*)(ws + O_S5PW))[((((size_t)l * 2 + d) * 16 + g) * 65 + 64) * 64 + pp];
    const float* sloc = (const float*)(ws + O_SLOC) + ((size_t)g * 520 + b * NCHUNK) * 256 + d * 128 + pp;
    bf16_t* uc = (bf16_t*)(ws + O_UCAT) + ((size_t)g * 520 + b * NCHUNK) * 1280 + 1024 + d * 128 + pp;
    float hr = 0.f, hi_ = 0.f;
#pragma unroll 1
    for (int s0 = 0; s0 < NCHUNK; s0 += 26) {
      float sr[26], si[26];
#pragma unroll
      for (int j = 0; j < 26; ++j) { const int s = s0 + j, c = d == 0 ? s : (s < 4 ? 3 - s : 263 - s); sr[j] = sloc[(size_t)c * 256]; si[j] = sloc[(size_t)c * 256 + 64]; }
#pragma unroll
      for (int j = 0; j < 26; ++j) {
        const int s = s0 + j, c = d == 0 ? s : (s < 4 ? 3 - s : 263 - s);
        uc[(size_t)c * 1280] = f2bf(hr); uc[(size_t)c * 1280 + 64] = f2bf(hi_);
        const float nr = a64.x * hr - a64.y * hi_ + sr[j], ni = a64.x * hi_ + a64.y * hr + si[j];
        hr = nr; hi_ = ni;
      }
    }
  }
  int x = blockIdx.x & 7; asm volatile("" : "+s"(x));
  const int b = x >> 2, h = x & 3;
  int* qctr = (int*)(ws + O_QCTR) + x * 64;
  volatile LAS int* qw = (volatile LAS int*)(lds + ATT_RPB + 2040);
#pragma unroll 1
  for (;;) {
    if (otid() == 0) *qw = atomicAdd(qctr, 1);
    __syncthreads();
    const int item = *qw;
    __syncthreads();
    if (item >= 195) break;
    if (item < 64) attn_diff<0>(p, l, b, h, item, lds);
    else if (item < 128) attn_mla<0>(p, b, h, item - 64, lds);
    else if (item < 192) attn_na<1>(p, l, b, h, item - 128, lds);
    else if (item == 192) attn_diff<2>(p, l, b, h, 0, lds);
    else if (item == 193) attn_mla<2>(p, b, h, 0, lds);
    else attn_na<2>(p, l, b, h, 0, lds);
  }
}

DI void phase_s5out(const Params& p, char* lds) {
  GPTR wsg_ = (GPTR)p.ws; asm volatile("" : "+s"(wsg_)); char* ws = (char*)wsg_;
  bf16_t* G5 = (bf16_t*)(ws + O_G5);
  const UM um(48, 4);
  int gm, ntile;
  for (int k = 0; um.get(k, gm, ntile); ++k) {
    const int g = gm / 3, m0 = (gm % 3) * 256, n0 = ntile * 256;
    f32x4 acc[2][2][4][2]; zero_acc8(acc);
    asm volatile("s_waitcnt vmcnt(0)" ::: "memory");
    const bf16_t* bw = (const bf16_t*)(ws + O_S5B2) + ((size_t)g * 1024 + n0) * 1280;
    gemm8<false>(acc, (const bf16_t*)(ws + O_UCAT) + (size_t)g * 520 * 1280, nullptr, m0, bw, bw + (size_t)128 * 1280, 1280, lds);
    const int tid = otid(), lane = tid & 63, wid = tid >> 6, wr = wid >> 2, wc = wid & 3, fr = lane & 15, fq = lane >> 4, c4 = fq * 4;
#pragma unroll
    for (int ai = 0; ai < 2; ++ai)
#pragma unroll
      for (int m = 0; m < 4; ++m) {
        int row = m0 + ai * 128 + wr * 64 + m * 16 + fr; asm volatile("" : "+v"(row));
        if (row < 520) {
          const int b = row >= NCHUNK ? 1 : 0, chunk = row - b * NCHUNK;
#pragma unroll
          for (int bj = 0; bj < 2; ++bj)
#pragma unroll
            for (int n = 0; n < 2; ++n) {
              const int sp = chunk * 64 + ((n0 + bj * 128 + wc * 32) >> 4) + n;
              const int token = sp < 256 ? NL + b * 256 + sp : b * SEQ + sp - 256;
              f32x4 v = acc[ai][bj][m][n];
#pragma unroll
              for (int j = 0; j < 4; ++j) v[j] = gelu_tanh(v[j]);
              *(u32x2*)(G5 + (size_t)token * 256 + g * 16 + c4) = pack4(v);
            }
        }
      }
  }
}
DI void phase_glu(const Params& p, int l, char* lds) {
  GPTR wsg_ = (GPTR)p.ws; asm volatile("" : "+s"(wsg_)); char* ws = (char*)wsg_;
  const int tid = otid(), lane = tid & 63, wid = tid >> 6, wr = wid >> 1, wc = wid & 1, fr = lane & 15, fq = lane >> 4, c4 = fq * 4;
  const bf16_t* G5 = (const bf16_t*)(ws + O_G5);
  bf16_t* Yc = (bf16_t*)(ws + O_YCAT);
  const UM um(128, 2);
  auto job = [&](int k) { int mt, nt; return um.get(k, mt, nt) ? gj_make(G5, nullptr, 256, mt * 256, (const bf16_t*)(ws + O_WGLU), 256, nt * 128, 256) : gj_none(); };
  GStream<GNST> gs; gs.start(job(0), lds, tid);
  int mt, ntile;
  for (int k = 0; um.get(k, mt, ntile); ++k) {
    const int m0 = mt * 256, n0 = ntile * 128;
    f32x4 acc[4][4]; zero_acc(acc);
    gs.run2(acc, job(k + 1));
    u32x2 gqa[4][4];
#pragma unroll
    for (int m = 0; m < 4; ++m)
#pragma unroll
      for (int n = 0; n < 4; ++n) gqa[m][n] = *(const u32x2*)(G5 + (size_t)(m0 + wr * 64 + m * 16 + fr) * 256 + n0 + wc * 64 + n * 16 + c4);
#pragma unroll
    for (int m = 0; m < 4; ++m) {
      const int row = m0 + wr * 64 + m * 16 + fr;
#pragma unroll
      for (int n = 0; n < 4; ++n) {
        const int col = n0 + wc * 64 + n * 16 + c4;
        const u32x2 gq = gqa[m][n];
        const float4 bb = *(const float4*)(p.b_glu + l * 256 + col);
        f32x4 o;
        o[0] = __uint_as_float(gq[0] << 16) * sigm(acc[m][n][0] + bb.x);
        o[1] = __uint_as_float(gq[0] & 0xffff0000u) * sigm(acc[m][n][1] + bb.y);
        o[2] = __uint_as_float(gq[1] << 16) * sigm(acc[m][n][2] + bb.z);
        o[3] = __uint_as_float(gq[1] & 0xffff0000u) * sigm(acc[m][n][3] + bb.w);
        *(u32x2*)(Yc + (size_t)row * 1024 + 768 + col) = pack4(o);
      }
    }
  }
  {
    const int t2 = otid(), ln = t2 & 63, wv = t2 >> 6;
    for (int w = blockIdx.x * 8 + wv; w < 512; w += gridDim.x * 8) {
      const int row0 = NL + (w >> 4) * 16, col = (w & 15) * 16 + (ln & 15);
      f32x4 a4 = f32x4{0.f, 0.f, 0.f, 0.f};
      mini_gemm16(a4, G5 + (size_t)row0 * 256, 256, (const bf16_t*)(ws + O_WGLU) + (size_t)(w & 15) * 16 * 256, 256, 256, ln);
      const float bb = p.b_glu[l * 256 + col];
#pragma unroll
      for (int j = 0; j < 4; ++j) {
        const int row = row0 + 4 * (ln >> 4) + j;
        Yc[(size_t)row * 1024 + 768 + col] = f2bf(bf2f(G5[(size_t)row * 256 + col]) * sigm(a4[j] + bb));
      }
    }
  }
}
DI void phase_merge(const Params& p, char* lds) {
  GPTR wsg_ = (GPTR)p.ws; asm volatile("" : "+s"(wsg_)); char* ws = (char*)wsg_;
  const int tid = otid(), lane = tid & 63, wid = tid >> 6, wr = wid >> 1, wc = wid & 1, fr = lane & 15, fq = lane >> 4, c4 = fq * 4;
  bf16_t* Mb = (bf16_t*)(ws + O_MBUF);
  const UM um(128, 8);
  auto job = [&](int seq) {
    const int i = (seq >> 1) & 3; int mt_, nt_;
    if (!um.get(seq >> 3, mt_, nt_)) return gj_none();
    const int m0 = mt_ * 256, n0 = nt_ * 128;
    if (seq & 1) return gj_make((const bf16_t*)(ws + O_H1), nullptr, 1024, m0, (const bf16_t*)(ws + O_WG) + (size_t)i * 1024 * 1024, 1024, n0, 1024);
    return gj_make((const bf16_t*)(ws + O_YCAT) + i * 256, nullptr, 1024, m0, (const bf16_t*)(ws + O_WBR) + (size_t)i * 262144, 256, n0, 256);
  };
  GStream<GNST> gs; gs.start(job(0), lds, tid);
  int seq = 0, mt, ntile;
  for (int k = 0; um.get(k, mt, ntile); ++k) {
    const int m0 = mt * 256, n0 = ntile * 128;
    u32x2 mpk[4][4];
    for (int i = 0; i < 4; ++i) {
      u32x2 pk[4][4];
      {
        f32x4 acc[4][4]; zero_acc(acc);
        gs.run<true>(acc, job(seq + 1)); ++seq;
#pragma unroll
        for (int m = 0; m < 4; ++m)
#pragma unroll
          for (int n = 0; n < 4; ++n) pk[m][n] = pack4(acc[m][n]);
      }
      f32x4 acc[4][4]; zero_acc(acc);
      gs.run<true>(acc, job(seq + 1)); ++seq;
#pragma unroll
      for (int m = 0; m < 4; ++m)
#pragma unroll
        for (int n = 0; n < 4; ++n) {
          f32x4 t;
          t[0] = sigm(acc[m][n][0]) * __uint_as_float(pk[m][n][0] << 16);
          t[1] = sigm(acc[m][n][1]) * __uint_as_float(pk[m][n][0] & 0xffff0000u);
          t[2] = sigm(acc[m][n][2]) * __uint_as_float(pk[m][n][1] << 16);
          t[3] = sigm(acc[m][n][3]) * __uint_as_float(pk[m][n][1] & 0xffff0000u);
          if (i > 0) {
            t[0] += __uint_as_float(mpk[m][n][0] << 16); t[1] += __uint_as_float(mpk[m][n][0] & 0xffff0000u);
            t[2] += __uint_as_float(mpk[m][n][1] << 16); t[3] += __uint_as_float(mpk[m][n][1] & 0xffff0000u);
          }
          mpk[m][n] = pack4(t);
        }
    }
#pragma unroll
    for (int m = 0; m < 4; ++m) {
      const int row = m0 + wr * 64 + m * 16 + fr;
#pragma unroll
      for (int n = 0; n < 4; ++n) *(u32x2*)(Mb + (size_t)row * 1024 + n0 + wc * 64 + n * 16 + c4) = mpk[m][n];
    }
  }
  {
    const int t2 = otid(), lane = t2 & 63, wid = t2 >> 6;
    for (int bq = blockIdx.x; bq < 256; bq += gridDim.x) {
      const int row0 = NL + ((bq >> 4) * 2 + (wid >> 2)) * 16, col0 = ((bq & 15) * 4 + (wid & 3)) * 16;
      f32x4 macc = f32x4{0.f, 0.f, 0.f, 0.f};
      for (int i = 0; i < 4; ++i) {
        f32x4 ab = f32x4{0.f, 0.f, 0.f, 0.f}, ag = f32x4{0.f, 0.f, 0.f, 0.f};
        mini_gemm16(ab, (const bf16_t*)(ws + O_YCAT) + (size_t)row0 * 1024 + i * 256, 1024, (const bf16_t*)(ws + O_WBR) + (size_t)i * 262144 + (size_t)col0 * 256, 256, 256, lane);
        mini_gemm16(ag, (const bf16_t*)(ws + O_H1) + (size_t)row0 * 1024, 1024, (const bf16_t*)(ws + O_WG) + ((size_t)i * 1024 + col0) * 1024, 1024, 1024, lane);
#pragma unroll
        for (int j = 0; j < 4; ++j) macc[j] += sigm(ag[j]) * ab[j];
      }
#pragma unroll
      for (int j = 0; j < 4; ++j) Mb[(size_t)(row0 + 4 * (lane >> 4) + j) * 1024 + col0 + (lane & 15)] = f2bf(macc[j]);
    }
  }
}
DI void phase_outproj(const Params& p, int l, char* lds, float rscale = 1.f) {
  GPTR wsg_ = (GPTR)p.ws; asm volatile("" : "+s"(wsg_)); char* ws = (char*)wsg_;
  bf16_t* X = (bf16_t*)(ws + O_X);
  const float* ada = (const float*)(ws + O_ADA);
  const UM um(128, 4);
  int mt, ntile;
  for (int k = 0; um.get(k, mt, ntile); ++k) {
    const int m0 = mt * 256, n0 = ntile * 256;
    f32x4 acc[2][2][4][2]; zero_acc8(acc);
    asm volatile("s_waitcnt vmcnt(0)" ::: "memory");
    gemm8<false>(acc, (const bf16_t*)(ws + O_MBUF), nullptr, m0, (const bf16_t*)(ws + O_WOUT) + (size_t)n0 * 1024, (const bf16_t*)(ws + O_WOUT) + (size_t)(n0 + 128) * 1024, 1024, lds);
    const int tid = otid(), lane = tid & 63, wid = tid >> 6, wr = wid >> 2, wc = wid & 3, fr = lane & 15, fq = lane >> 4;
    const int cv = m0 < NL ? (m0 >> 14) : 2;
    const float* gt = ada + (l * 3 + cv) * 6144 + 2 * 1024 + n0 + wc * 32 + fq * 4;
    float4 g[2][2];
#pragma unroll
    for (int bj = 0; bj < 2; ++bj)
#pragma unroll
      for (int n = 0; n < 2; ++n) g[bj][n] = *(const float4*)(gt + bj * 128 + n * 16);
#pragma unroll
    for (int ai = 0; ai < 2; ++ai) {
      u32x2 xo[4][2][2];
#pragma unroll
      for (int m = 0; m < 4; ++m)
#pragma unroll
        for (int bj = 0; bj < 2; ++bj)
#pragma unroll
          for (int n = 0; n < 2; ++n)
            xo[m][bj][n] = *(const u32x2*)(X + (size_t)(m0 + ai * 128 + wr * 64 + m * 16 + fr) * 1024 + n0 + bj * 128 + wc * 32 + n * 16 + fq * 4);
#pragma unroll
      for (int m = 0; m < 4; ++m)
#pragma unroll
        for (int bj = 0; bj < 2; ++bj)
#pragma unroll
          for (int n = 0; n < 2; ++n) {
            const u32x2 xv = xo[m][bj][n]; const f32x4 av = acc[ai][bj][m][n]; const float4 gg = g[bj][n];
            u32x2 xn;
            xn[0] = pack2(__uint_as_float(xv[0] << 16) + rscale * gg.x * av[0], __uint_as_float(xv[0] & 0xffff0000u) + rscale * gg.y * av[1]);
            xn[1] = pack2(__uint_as_float(xv[1] << 16) + rscale * gg.z * av[2], __uint_as_float(xv[1] & 0xffff0000u) + rscale * gg.w * av[3]);
            *(u32x2*)(X + (size_t)(m0 + ai * 128 + wr * 64 + m * 16 + fr) * 1024 + n0 + bj * 128 + wc * 32 + n * 16 + fq * 4) = xn;
          }
    }
  }
  const int tid = otid(), lane = tid & 63, wid = tid >> 6;
  (void)lane; (void)wid;
  {
    const int t2 = otid(), lane = t2 & 63, wid = t2 >> 6;
    for (int bq = blockIdx.x; bq < 256; bq += gridDim.x) {
      const int row0 = NL + ((bq >> 4) * 2 + (wid >> 2)) * 16, col0 = ((bq & 15) * 4 + (wid & 3)) * 16;
      f32x4 acc = f32x4{0.f, 0.f, 0.f, 0.f};
      mini_gemm16(acc, (const bf16_t*)(ws + O_MBUF) + (size_t)row0 * 1024, 1024, (const bf16_t*)(ws + O_WOUT) + (size_t)col0 * 1024, 1024, 1024, lane);
      const float g = ada[(l * 3 + 2) * 6144 + 2 * 1024 + col0 + (lane & 15)];
      bf16_t xold[4];
#pragma unroll
      for (int j = 0; j < 4; ++j) xold[j] = X[(size_t)(row0 + 4 * (lane >> 4) + j) * 1024 + col0 + (lane & 15)];
#pragma unroll
      for (int j = 0; j < 4; ++j) X[(size_t)(row0 + 4 * (lane >> 4) + j) * 1024 + col0 + (lane & 15)] = f2bf(bf2f(xold[j]) + rscale * g * acc[j]);
    }
  }
}
DI void phase_norm2(const Params& p, int l, char* lds) {
  GPTR wsg_ = (GPTR)p.ws; asm volatile("" : "+s"(wsg_)); char* ws = (char*)wsg_;
  const int tid = otid(), lane = tid & 63, w = tid >> 6, fr = lane & 15, fq = lane >> 4;
  const bf16_t* X = (const bf16_t*)(ws + O_X);
  bf16_t* H2 = (bf16_t*)(ws + O_H2);
  float* LG = (float*)(ws + O_LOGIT);
  const float* ada = (const float*)(ws + O_ADA);
  float* ssq = (float*)lds;
  float* red = (float*)(lds + 1024);
  float* tabG = (float*)(lds + 40960);
  float* tabS = tabG + 3072;
  for (int i = tid; i < 3072; i += NTHR) {
    const int cv_ = i >> 10, k_ = i & 1023;
    const float* a_ = ada + (l * 3 + cv_) * 6144 + 3 * 1024 + k_;
    tabG[i] = p.g_norm2[l * 1024 + k_] * (1.f + a_[1024]); tabS[i] = a_[0];
  }
  __syncthreads();
  const int kb = w * 128 + fq * 8;
  bf16x8 bh[4][4], bl[4][4];
#pragma unroll
  for (int e = 0; e < 4; ++e)
#pragma unroll
    for (int s_ = 0; s_ < 4; ++s_) {
      const size_t off = (size_t)(e * 16 + fr) * 1024 + kb + s_ * 32;
      bh[e][s_] = *(const bf16x8*)((const bf16_t*)(ws + O_WRHI) + off);
      bl[e][s_] = *(const bf16x8*)((const bf16_t*)(ws + O_WRLO) + off);
    }
  const int ng = NTOK / 16;
  u32x4 xn[4];
  if ((int)blockIdx.x < ng) {
#pragma unroll
    for (int s_ = 0; s_ < 4; ++s_) xn[s_] = *(const u32x4*)(X + (size_t)(blockIdx.x * 16 + fr) * 1024 + kb + s_ * 32);
  }
#pragma unroll 1
  for (int gi = blockIdx.x; gi < ng; gi += gridDim.x) {
    const int row0 = gi * 16, row = row0 + fr, cv = row0 < NL ? (row0 >> 14) : 2;
    u32x4 xr[4];
#pragma unroll
    for (int s_ = 0; s_ < 4; ++s_) xr[s_] = xn[s_];
    if (gi + (int)gridDim.x < ng) {
#pragma unroll
      for (int s_ = 0; s_ < 4; ++s_) xn[s_] = *(const u32x4*)(X + (size_t)((gi + gridDim.x) * 16 + fr) * 1024 + kb + s_ * 32);
    }
    float ss = 0.f;
#pragma unroll
    for (int s_ = 0; s_ < 4; ++s_)
#pragma unroll
      for (int j = 0; j < 4; ++j) { const float a0 = __uint_as_float(xr[s_][j] << 16), a1 = __uint_as_float(xr[s_][j] & 0xffff0000u); ss += a0 * a0; ss += a1 * a1; }
    ss = xhalf(ss); ss += bperm(ss, lane ^ 16);
    if (fq == 0) ssq[w * 16 + fr] = ss;
    __syncthreads();
    float tot = 0.f;
#pragma unroll
    for (int w2 = 0; w2 < 8; ++w2) tot += ssq[w2 * 16 + fr];
    const float rstd = rsqrtf(tot * (1.f / 1024.f) + EPS);
    const float* gn = tabG + cv * 1024 + kb;
    const float* sh = tabS + cv * 1024 + kb;
    f32x4 acc[4];
#pragma unroll
    for (int e = 0; e < 4; ++e) acc[e] = f32x4{0.f, 0.f, 0.f, 0.f};
#pragma unroll
    for (int s_ = 0; s_ < 4; ++s_) {
      u32x4 ahi, alo;
#pragma unroll
      for (int q = 0; q < 2; ++q) {
        const float4 g = *(const float4*)(gn + s_ * 32 + q * 4), s1 = *(const float4*)(sh + s_ * 32 + q * 4);
        const unsigned u0 = xr[s_][q * 2], u1 = xr[s_][q * 2 + 1];
        const float h0 = __uint_as_float(u0 << 16) * rstd * g.x + s1.x, h1 = __uint_as_float(u0 & 0xffff0000u) * rstd * g.y + s1.y;
        const float h2 = __uint_as_float(u1 << 16) * rstd * g.z + s1.z, h3 = __uint_as_float(u1 & 0xffff0000u) * rstd * g.w + s1.w;
        const unsigned p0 = pack2(h0, h1), p1 = pack2(h2, h3);
        ahi[q * 2] = p0; ahi[q * 2 + 1] = p1;
        alo[q * 2] = pack2(h0 - __uint_as_float(p0 << 16), h1 - __uint_as_float(p0 & 0xffff0000u));
        alo[q * 2 + 1] = pack2(h2 - __uint_as_float(p1 << 16), h3 - __uint_as_float(p1 & 0xffff0000u));
      }
      *(u32x4*)(H2 + (size_t)row * 1024 + kb + s_ * 32) = ahi;
      const bf16x8 fh = __builtin_bit_cast(bf16x8, ahi), fl = __builtin_bit_cast(bf16x8, alo);
#pragma unroll
      for (int e = 0; e < 4; ++e) { acc[e] = MFMA16(fh, bh[e][s_], acc[e]); acc[e] = MFMA16(fl, bh[e][s_], acc[e]); acc[e] = MFMA16(fh, bl[e][s_], acc[e]); }
    }
#pragma unroll
    for (int e = 0; e < 4; ++e) *(f32x4*)(red + ((w * 4 + e) * 64 + lane) * 4) = acc[e];
    __syncthreads();
    if (tid < 256) {
      const int e = tid >> 6, ln = tid & 63;
      f32x4 sum = *(const f32x4*)(red + (e * 64 + ln) * 4);
#pragma unroll
      for (int w2 = 1; w2 < 8; ++w2) sum += *(const f32x4*)(red + ((w2 * 4 + e) * 64 + ln) * 4);
#pragma unroll
      for (int j = 0; j < 4; ++j) LG[(size_t)(row0 + (ln >> 4) * 4 + j) * 64 + e * 16 + (ln & 15)] = sum[j];
    }
  }
}
DI void phase_topk(const Params& p, int l, char* lds) {
  GPTR wsg_ = (GPTR)p.ws; asm volatile("" : "+s"(wsg_)); char* ws = (char*)wsg_;
  const int tid = otid(), lane = tid & 63, wid = tid >> 6;
  int* lcnt = (int*)lds;
  int* lbase = lcnt + 64;
  const float* LG = (const float*)(ws + O_LOGIT);
  int* IDX = (int*)(ws + O_IDX); float* GW = (float*)(ws + O_GW); int* RANK = (int*)(ws + O_SLOT);
  if (tid < 64) lcnt[tid] = 0;
  __syncthreads();
  const int rows_per = (NTOK + gridDim.x - 1) / gridDim.x;
  const int r0 = blockIdx.x * rows_per, r1 = min(NTOK, r0 + rows_per);
  const float eb = p.e_bias[l * 64 + lane];
  float lgv[17];
#pragma unroll
  for (int i = 0; i < 17; ++i) { const int row = r0 + wid + i * 8; lgv[i] = row < r1 ? LG[(size_t)row * 64 + lane] : 0.f; }
#pragma unroll
  for (int i = 0; i < 17; ++i) {
    const int row = r0 + wid + i * 8;
    if (row >= r1) break;
    const float score = sigm(lgv[i]);
    float sel = score + eb;
    float gsum = 0.f; int myk = -1;
    for (int k = 0; k < 6; ++k) {
      const float mx = wave_max(sel, lane);
      const unsigned long long bal = __ballot(sel == mx);
      const int win = __ffsll((long long)bal) - 1;
      const float sc_w = bperm(score, win);
      gsum += sc_w;
      if (lane == win) { sel = -1e30f; myk = k; }
    }
    if (myk >= 0) {
      const int lr = atomicAdd(&lcnt[lane], 1);
      IDX[row * 6 + myk] = lane; GW[row * 6 + myk] = score / gsum; RANK[row * 6 + myk] = lr;
    }
  }
  __syncthreads();
  if (tid < 64) lbase[tid] = atomicAdd((int*)(ws + O_CNT) + tid, lcnt[tid]);
  __syncthreads();
  for (int i = r0 * 6 + tid; i < r1 * 6; i += NTHR) RANK[i] += lbase[IDX[i]];
}

DI void phase_lists(const Params& p, char* lds) {
  GPTR wsg_ = (GPTR)p.ws; asm volatile("" : "+s"(wsg_)); char* ws = (char*)wsg_;
  const int tid = otid();
  int* poff = (int*)lds;
  const int* cnt = (const int*)(ws + O_CNT);
  if (tid == 0) { int a = 0; for (int e = 0; e < 64; ++e) { poff[e] = a; a += (cnt[e] + 255) & ~255; } poff[64] = a; }
  __syncthreads();
  int* SLOT = (int*)(ws + O_SLOT); const int* IDX = (const int*)(ws + O_IDX); int* ROWIDX = (int*)(ws + O_ROWIDX);
  for (int i = blockIdx.x * NTHR + tid; i < NTOK * 6; i += gridDim.x * NTHR) {
    const int s = poff[IDX[i]] + SLOT[i];
    SLOT[i] = s; ROWIDX[s] = i / 6;
  }
  for (int e = blockIdx.x; e < 64; e += gridDim.x) {
    const int c = cnt[e], pc = (c + 255) & ~255;
    for (int s = c + tid; s < pc; s += NTHR) ROWIDX[poff[e] + s] = 0;
  }
  for (int t = blockIdx.x * NTHR + tid; t < NTOK; t += gridDim.x * NTHR) ROWIDX[poff[64] + t] = t;
}
DI int find_expert(const int* poff, int slot0) { int e = 0; for (int i = 1; i < 64; ++i) e = (poff[i] <= slot0) ? i : e; return e; }

DI void phase_moe1(const Params& p, char* lds) {
  GPTR wsg_ = (GPTR)p.ws; asm volatile("" : "+s"(wsg_)); char* ws = (char*)wsg_;
  int* poff = (int*)(lds + LDS_POFF);
  {
    const int tid = otid();
    const int* cnt = (const int*)(ws + O_CNT);
    if (tid == 0) { int a = 0; for (int e = 0; e < 64; ++e) { poff[e] = a; a += (cnt[e] + 255) & ~255; } poff[64] = a; }
    __syncthreads();
  }
  const int TR = poff[64] >> 8;
  bf16_t* ACT = (bf16_t*)(ws + O_ACT);
  const bf16_t* H2 = (const bf16_t*)(ws + O_H2);
  const UM um(TR + 130, 2);
  int ti, ntile;
  for (int k = 0; um.get(k, ti, ntile); ++k) {
    const int f0 = ntile * 128, slot0 = ti * 256;
    const int e = ti < TR ? find_expert(poff, slot0) : 64;
    f32x4 acc[2][2][4][2]; zero_acc8(acc);
    asm volatile("s_waitcnt vmcnt(0)" ::: "memory");
    gemm8<true>(acc, H2, (const int*)(ws + O_ROWIDX), slot0, (const bf16_t*)(ws + O_WE1) + (size_t)e * 262144 + (size_t)f0 * 1024, (const bf16_t*)(ws + O_WE3) + (size_t)e * 262144 + (size_t)f0 * 1024, 1024, lds);
    const int tid = otid(), lane = tid & 63, wid = tid >> 6, wr = wid >> 2, wc = wid & 3, fr = lane & 15, fq = lane >> 4;
#pragma unroll
    for (int ai = 0; ai < 2; ++ai)
#pragma unroll
      for (int m = 0; m < 4; ++m) {
        const int row = slot0 + ai * 128 + wr * 64 + m * 16 + fr;
#pragma unroll
        for (int n = 0; n < 2; ++n) {
          const f32x4 g = acc[ai][0][m][n], u = acc[ai][1][m][n];
          f32x4 o;
#pragma unroll
          for (int j = 0; j < 4; ++j) o[j] = g[j] * sigm(g[j]) * u[j];
          *(u32x2*)(ACT + (size_t)row * 256 + f0 + wc * 32 + n * 16 + fq * 4) = pack4(o);
        }
      }
  }
}
DI void phase_moe2(const Params& p, char* lds) {
  GPTR wsg_ = (GPTR)p.ws; asm volatile("" : "+s"(wsg_)); char* ws = (char*)wsg_;
  const int tid = otid(), lane = tid & 63, wid = tid >> 6, wr = wid >> 1, wc = wid & 1, fr = lane & 15, fq = lane >> 4;
  int* poff = (int*)(lds + LDS_POFF);
  const int* cnt = (const int*)(ws + O_CNT);
  if (tid == 0) { int a = 0; for (int e = 0; e < 64; ++e) { poff[e] = a; a += (cnt[e] + 255) & ~255; } poff[64] = a; }
  __syncthreads();
  const int TR = poff[64] >> 8;
  const bf16_t* ACT = (const bf16_t*)(ws + O_ACT);
  unsigned char* Y = (unsigned char*)(ws + O_R);
  const UM um(TR + 130, 4);
  auto job = [&](int k) {
    int ti, nt_;
    if (!um.get(k, ti, nt_)) return gj_none();
    const int slot0 = ti * 256, e = ti < TR ? find_expert(poff, slot0) : 64;
    return gj_make(ACT, nullptr, 256, slot0, (const bf16_t*)(ws + O_WE2) + (size_t)e * 262144, 256, nt_ * 256, 256);
  };
  GStreamW gs; gs.start(job(0), lds, tid);
  int ti, ntile;
  for (int k = 0; um.get(k, ti, ntile); ++k) {
    const int n0 = ntile * 256, slot0 = ti * 256;
    f32x4 acc[4][8]; zero_accw(acc);
    gs.run(acc, job(k + 1));
    if (ti >= TR) {
      bf16_t* Ysh = (bf16_t*)(ws + O_R + (size_t)YROWS * 1024);
#pragma unroll
      for (int m = 0; m < 4; ++m) {
        const int row = (ti - TR) * 256 + wr * 64 + m * 16 + fr;
#pragma unroll
        for (int n = 0; n < 8; ++n) *(u32x2*)(Ysh + (size_t)row * 1024 + n0 + wc * 128 + n * 16 + fq * 4) = pack4(acc[m][n]);
      }
    } else
#pragma unroll
    for (int m = 0; m < 4; ++m) {
      const int row = slot0 + wr * 64 + m * 16 + fr;
#pragma unroll
      for (int hf = 0; hf < 2; ++hf) {
        unsigned a[4];
#pragma unroll
        for (int n = 0; n < 4; ++n) {
          const f32x4 v = acc[m][hf * 4 + n];
          const float q0 = __builtin_amdgcn_fmed3f(v[0] * 16.f, -448.f, 448.f), q1 = __builtin_amdgcn_fmed3f(v[1] * 16.f, -448.f, 448.f);
          const float q2 = __builtin_amdgcn_fmed3f(v[2] * 16.f, -448.f, 448.f), q3 = __builtin_amdgcn_fmed3f(v[3] * 16.f, -448.f, 448.f);
          int w = __builtin_amdgcn_cvt_pk_fp8_f32(q0, q1, 0, false);
          w = __builtin_amdgcn_cvt_pk_fp8_f32(q2, q3, w, true);
          a[n] = (unsigned)w;
        }
        const auto r01 = __builtin_amdgcn_permlane16_swap(a[0], a[1], false, false);
        const auto r23 = __builtin_amdgcn_permlane16_swap(a[2], a[3], false, false);
        const auto s02 = __builtin_amdgcn_permlane32_swap(r01[0], r23[0], false, false);
        const auto s13 = __builtin_amdgcn_permlane32_swap(r01[1], r23[1], false, false);
        *(u32x4*)(Y + (size_t)row * 1024 + n0 + wc * 128 + hf * 64 + fq * 16) = u32x4{s02[0], s13[0], s02[1], s13[1]};
      }
    }
  }
}

#define XB_TMO      128
#define XB_XCNT(j)  (256  + 64 * (j))
#define XB_XSUB(j)  (1280 + 64 * (j))
#define XB_XGEN(j)  (2304 + 64 * (j))
#define XB_TOP      3328
#define XB_TOPGEN   3392
#define XCD_BAR_WORDS 3456
#define XB_SPIN_CAP (1u << 21)
__device__ __forceinline__ unsigned xb_ld(unsigned* p)              { return __hip_atomic_load(p, __ATOMIC_RELAXED, __HIP_MEMORY_SCOPE_AGENT); }
__device__ __forceinline__ unsigned xb_add(unsigned* p, unsigned v) { return __hip_atomic_fetch_add(p, v, __ATOMIC_RELAXED, __HIP_MEMORY_SCOPE_AGENT); }
__device__ __forceinline__ unsigned xb_xcc_id() { return (unsigned)__builtin_amdgcn_s_getreg((3 << 11) | 20) & 0xFu; }
#define XB_SPIN(cond, bar) do { unsigned _sp = 0; while (cond) { __builtin_amdgcn_s_sleep(1); \
    if ((++_sp & 255u) == 0u) { if (xb_ld(&(bar)[XB_TMO])) break; if (_sp > XB_SPIN_CAP) { atomicAdd(&(bar)[XB_TMO], 1u); break; } } } } while (0)
struct XcdBarrier { unsigned* bar; unsigned x; volatile LAS unsigned* st; };
__device__ __forceinline__ XcdBarrier xcd_barrier_post(unsigned* bar, volatile LAS unsigned* st) {
    XcdBarrier b; b.bar = bar; b.x = xb_xcc_id(); b.st = st;
    if (threadIdx.x == 0) (void)xb_add(&bar[XB_XCNT(b.x)], 1u);
    return b;
}
__device__ __forceinline__ void xcd_barrier_complete(unsigned* bar, unsigned x, unsigned& nloc, unsigned& nx) {
    const unsigned G = gridDim.x * gridDim.y * gridDim.z;
    unsigned sum, cnt, mine, sp = 0u;
    for (;;) {
        sum = 0u; cnt = 0u; mine = 0u;
#pragma unroll
        for (unsigned j = 0; j < 16; ++j) { const unsigned c = xb_ld(&bar[XB_XCNT(j)]); sum += c; cnt += (c > 0u) ? 1u : 0u; mine = (j == x) ? c : mine; }
        if (sum == G) break;
        __builtin_amdgcn_s_sleep(1);
        if ((++sp & 255u) == 0u) { if (xb_ld(&bar[XB_TMO])) break; if (sp > XB_SPIN_CAP) { atomicAdd(&bar[XB_TMO], 1u); break; } }
    }
    nloc = mine > 0u ? mine : 1u; nx = cnt > 0u ? cnt : 1u;
}
__device__ __forceinline__ void xcd_barrier(const XcdBarrier& b) {
    asm volatile("s_waitcnt vmcnt(0)" ::: "memory");
    __syncthreads();
    if (threadIdx.x == 0) {
        unsigned* bar = b.bar;
        __builtin_amdgcn_s_waitcnt(0);
        unsigned nloc = b.st[0], nx = b.st[1];
        if (nloc == 0u) { xcd_barrier_complete(bar, b.x, nloc, nx); b.st[0] = nloc; b.st[1] = nx; }
        const unsigned old = xb_add(&bar[XB_XSUB(b.x)], 1u);
        const unsigned gen = old / nloc;
        if (old + 1u == (gen + 1u) * nloc) {
            __builtin_amdgcn_fence(__ATOMIC_RELEASE, "agent");
            asm volatile("s_waitcnt vmcnt(0)" ::: "memory");
            const unsigned og = xb_add(&bar[XB_TOP], 1u);
            const unsigned tg = og / nx;
            if (og + 1u == (tg + 1u) * nx) xb_add(&bar[XB_TOPGEN], 1u);
            else XB_SPIN(xb_ld(&bar[XB_TOPGEN]) == tg, bar);
            __builtin_amdgcn_fence(__ATOMIC_ACQUIRE, "agent");
            xb_add(&bar[XB_XGEN(b.x)], 1u);
            asm volatile("s_waitcnt vmcnt(0)" ::: "memory");
        } else {
            XB_SPIN(xb_ld(&bar[XB_XGEN(b.x)]) == gen, bar);
            __builtin_amdgcn_fence(__ATOMIC_ACQUIRE, "agent");
            asm volatile("s_waitcnt vmcnt(0)" ::: "memory");
        }
    }
    __syncthreads();
}

__global__ void __launch_bounds__(NTHR, 2) k_mega(Params_ p_unused) {
#define p (*kargs())
  extern __shared__ __attribute__((aligned(16))) char lds[];
  uint4* xbw = (uint4*)(lds + LDS_BYTES);
  if (threadIdx.x == 0) *xbw = make_uint4(0u, 0u, 0u, 0u);
  __syncthreads();
  (void)xcd_barrier_post((unsigned*)(p.ws + O_BAR), (volatile LAS unsigned*)xbw);
#define GRID_BAR() do { XcdBarrier b_; unsigned long long bp_ = (unsigned long long)(p.ws + O_BAR); asm volatile("" : "+s"(bp_)); b_.bar = (unsigned*)bp_; b_.x = xb_xcc_id(); b_.st = (volatile LAS unsigned*)(lds + LDS_BYTES); xcd_barrier(b_); } while (0)
#if PROBE_GROUP
#define REPS(g) int reps_ = 1 + ((g) == PROBE_GROUP ? 1 : 0); asm volatile("" : "+s"(reps_)); _Pragma("unroll 1") for (int r_ = 0; r_ < reps_; ++r_)
#define RSC (r_ == 0 ? 1.f : 0.f)
#else
#define REPS(g)
#define RSC 1.f
#endif
  { REPS(11) { phase_p0(p, lds); GRID_BAR(); phase_p1(p); GRID_BAR(); } }
  for (int l = 0; l < DEPTH; ++l) {
    { REPS(1) { phase_rows(p, l, RSC); } }
    { REPS(10) { phase_prep(p, l, lds); GRID_BAR(); } }
    if (blockIdx.x == 0) { const int t_ = otid(); if (t_ < 64) ((int*)(p.ws + O_CNT))[t_] = 0; if (t_ < 8) ((int*)(p.ws + O_QCTR))[t_ * 64] = 0; }
    phase_proj(p, lds); GRID_BAR(); phase_up(p, lds); GRID_BAR();
    phase_attn(p, l, lds); GRID_BAR();
    { REPS(4) { phase_s5out(p, lds); GRID_BAR(); phase_glu(p, l, lds); GRID_BAR(); } }
    { REPS(5) { phase_merge(p, lds); GRID_BAR(); } }
    { REPS(6) { phase_outproj(p, l, lds, RSC); GRID_BAR(); } }
    { REPS(7) { phase_norm2(p, l, lds); GRID_BAR(); } }
    { REPS(12) {
#if PROBE_GROUP == 12
      if (r_ > 0) { if (blockIdx.x == 0) { const int t_ = otid(); if (t_ < 64) ((int*)(p.ws + O_CNT))[t_] = 0; } GRID_BAR(); }
#endif
      phase_topk(p, l, lds); GRID_BAR();
      phase_lists(p, lds); GRID_BAR(); } }
    { REPS(8) { phase_moe1(p, lds); GRID_BAR(); } }
    { REPS(9) { phase_moe2(p, lds); GRID_BAR(); } }
  }
  phase_rows(p, DEPTH);
#undef p
}

extern "C" void kernel_launch(void* const* d_in, const int* in_sizes, int n_in, void* d_out, int out_size, void* d_ws, size_t ws_size, hipStream_t stream) {
  if (ws_size < WS_NEED) { fprintf(stderr, "workspace too small: %zu < %zu\n", ws_size, (size_t)WS_NEED); return; }
  Params_ p{};
  const float** pp = (const float**)&p;
  for (int i = 0; i < 37; ++i) pp[i] = (const float*)d_in[i];
  p.out = (float*)d_out; p.ws = (char*)d_ws;
  constexpr int kDynLds = LDS_TOTAL;
  static int grid = 0;
  if (!grid) {
    int dev = 0, cus = 0, per_cu = 0;
    hipGetDevice(&dev);
    hipDeviceGetAttribute(&cus, hipDeviceAttributeMultiprocessorCount, dev);
    hipFuncSetAttribute((const void*)k_mega, hipFuncAttributeMaxDynamicSharedMemorySize, kDynLds);
    hipOccupancyMaxActiveBlocksPerMultiprocessor(&per_cu, (const void*)k_mega, NTHR, kDynLds);
    grid = cus * (per_cu < 1 ? per_cu : 1);
    if (grid > 256) grid = 256;
  }
  if (grid <= 0) { fprintf(stderr, "k_mega does not fit\n"); return; }
  hipMemsetAsync((char*)d_ws + O_BAR, 0, 16384, stream);
  hipLaunchKernelGGL(k_mega, dim3(grid), dim3(NTHR), kDynLds, stream, p);
}
```

```cpp
#include <hip/hip_runtime.h>
#include <stdint.h>
#include <stdio.h>
typedef __attribute__((address_space(1))) char* GPTR;
#ifndef PROBE_GROUP
#define PROBE_GROUP 0
#endif

#define DI __device__ __forceinline__
#define LAS __attribute__((address_space(3)))
typedef unsigned short bf16_t;
using bf16x8 = __attribute__((ext_vector_type(8))) short;
using s16x4 = __attribute__((ext_vector_type(4))) short;
using f32x4 = __attribute__((ext_vector_type(4))) float;
using f32x16 = __attribute__((ext_vector_type(16))) float;
using u32x4 = __attribute__((ext_vector_type(4))) unsigned;
using u32x2 = __attribute__((ext_vector_type(2))) unsigned;
typedef __bf16 bf2_t __attribute__((ext_vector_type(2)));
typedef float fl2_t __attribute__((ext_vector_type(2)));
typedef short v4i16_t __attribute__((ext_vector_type(4)));

constexpr int NL = 32768, NC = 512, NTOK = 33280, DM = 1024, SEQ = 16384, CTXL = 256, KLEN = 16640, DEPTH = 4;
constexpr int INW = 6304, NTHR = 512;
constexpr int NCHUNK = 260;
constexpr int YROWS = 216064 + 33280;
constexpr float LOG2E = 1.4426950408889634f;
constexpr float NA_QS = 0.125f * LOG2E;
constexpr float DIFF_QS = 0.17677669529663687f * LOG2E;
constexpr float MLA_QS = 0.10206207261596577f * LOG2E;
constexpr float EPS = 1e-6f;

constexpr size_t O_BAR = 0;
constexpr size_t O_TP = O_BAR + 14336;
constexpr size_t O_CNT = O_BAR + 16384;
constexpr size_t O_QCTR = O_CNT + 1024;
constexpr size_t O_LAMF = O_QCTR + 2048;
constexpr size_t O_ADA = O_LAMF + 256;
constexpr size_t O_ROPER = O_ADA + 294912;
constexpr size_t O_ROPEC = O_ROPER + 16384;
constexpr size_t O_S5PW = O_ROPEC + 4096;
constexpr size_t O_S5BB = O_S5PW + 4259840;
constexpr size_t O_S5K = O_S5BB + 1048576;
constexpr size_t O_X = O_S5K + 8388608;
constexpr size_t O_H1 = O_X + 136314880;
constexpr size_t O_R = O_H1 + 68157440;
constexpr size_t O_H2 = O_R;
constexpr size_t O_YCAT = O_H2 + 68157440;
constexpr size_t O_MBUF = O_YCAT + 68157440;
constexpr size_t O_QN = O_MBUF + 68157440;
constexpr size_t O_KN = O_QN + 17039360;
constexpr size_t O_VN = O_KN + 17039360;
constexpr size_t O_QDL = O_VN + 17039360;
constexpr size_t O_QDR = O_QDL + 16777216;
constexpr size_t O_KD = O_QDR + 17039360;
constexpr size_t O_VD = O_KD + 17039360;
constexpr size_t O_QML = O_VD + 17039360;
constexpr size_t O_QMR = O_QML + 25165824;
constexpr size_t O_KM = O_QMR + 25559040;
constexpr size_t O_VM = O_KM + 25559040;
constexpr size_t O_CQ = O_VM + 17039360;
constexpr size_t O_CKV = O_CQ + 17039360;
constexpr size_t O_UCAT = O_CKV + 8519680;
constexpr size_t O_SLOC = O_UCAT + 21954560;
constexpr size_t O_G5 = O_SLOC + 8519680;
constexpr size_t R_END1 = O_G5 + 17039360;
constexpr size_t R_END2 = O_R + (size_t)YROWS * 2048;
constexpr size_t O_ACT = R_END1 > R_END2 ? R_END1 : R_END2;
constexpr size_t O_IDX = O_ACT + (size_t)YROWS * 512;
constexpr size_t O_GW = O_IDX + 798720;
constexpr size_t O_SLOT = O_GW + 798720;
constexpr size_t O_ROWIDX = O_SLOT + 798720;
constexpr size_t O_WIN = O_ROWIDX + 997376;
constexpr size_t O_WG = O_WIN + 2304 * 1024 * 2;
constexpr size_t O_WUQ = O_WG + 4096 * 1024 * 2;
constexpr size_t O_WUKV = O_WUQ + 384 * 256 * 2;
constexpr size_t O_WGLU = O_WUKV + 512 * 128 * 2;
constexpr size_t O_WBR = O_WGLU + 256 * 256 * 2;
constexpr size_t O_WOUT = O_WBR + 4 * 1024 * 256 * 2;
constexpr size_t O_WE1 = O_WOUT + 1024 * 1024 * 2;
constexpr size_t O_WE3 = O_WE1 + (size_t)65 * 256 * 1024 * 2;
constexpr size_t O_WE2 = O_WE3 + (size_t)65 * 256 * 1024 * 2;
constexpr size_t O_S5B2 = O_WE2 + (size_t)65 * 1024 * 256 * 2;
constexpr size_t O_S5B1 = O_S5B2 + (size_t)16 * 1024 * 1280 * 2;
constexpr size_t O_WRHI = O_S5B1 + (size_t)16 * 256 * 1024 * 2;
constexpr size_t O_WRLO = O_WRHI + 128 * 1024 * 2;
constexpr size_t WS_NEED = O_WRLO + 128 * 1024 * 2;
constexpr size_t O_H2LO = O_MBUF;
constexpr size_t O_LOGIT = O_YCAT;

struct Params_ {
  const float *x, *c, *ctx, *c_ctx, *w_ada, *b_ada, *g_norm1, *g_norm2, *w_in, *na_rpb, *diff_lambda, *g_diff, *g_mla_q, *g_mla_kv,
      *w_mla_uq, *w_mla_ukv, *s5_lam_re, *s5_lam_im, *s5_log_step, *s5_b_re, *s5_b_im, *s5_c_re, *s5_c_im, *s5_d, *w_glu, *b_glu,
      *w_branch, *w_out, *w_router, *e_bias, *w_e1, *w_e3, *w_e2, *w_s1, *w_s3, *w_s2, *g_final;
  float* out;
  char* ws;
};
typedef const __attribute__((address_space(4))) Params_ Params;
DI Params* kargs() { Params* k = (Params*)__builtin_amdgcn_kernarg_segment_ptr(); asm volatile("" : "+s"(k)); return k; }

DI float bf2f(bf16_t b) { return __uint_as_float((unsigned)b << 16); }
DI bf16_t f2bf(float x) { unsigned u = __float_as_uint(x); u += 0x7fffu + ((u >> 16) & 1u); return (bf16_t)(u >> 16); }
DI unsigned pack2(float a, float b) { fl2_t f = {a, b}; bf2_t r = __builtin_convertvector(f, bf2_t); return __builtin_bit_cast(unsigned, r); }
DI float sigm(float x) { return __builtin_amdgcn_rcpf(1.f + __builtin_amdgcn_exp2f(-LOG2E * x)); }
DI float gelu_tanh(float x) { float u = 0.7978845608028654f * (x + 0.044715f * x * x * x); return x * (1.f - __builtin_amdgcn_rcpf(__builtin_amdgcn_exp2f((2.f * LOG2E) * u) + 1.f)); }
DI float bperm(float v, int srclane) { return __int_as_float(__builtin_amdgcn_ds_bpermute(srclane << 2, __float_as_int(v))); }
DI float xhalf(float v) { auto rr = __builtin_amdgcn_permlane32_swap(__float_as_uint(v), __float_as_uint(v), false, false); return __uint_as_float(rr[0]) + __uint_as_float(rr[1]); }
DI float xhalf_max(float v) { auto rr = __builtin_amdgcn_permlane32_swap(__float_as_uint(v), __float_as_uint(v), false, false); return fmaxf(__uint_as_float(rr[0]), __uint_as_float(rr[1])); }
DI float xhalf_get(float v, int hi) { auto rr = __builtin_amdgcn_permlane32_swap(__float_as_uint(v), __float_as_uint(v), false, false); return __uint_as_float(hi ? rr[0] : rr[1]); }
DI float wave_sum(float v, int lane) {
#pragma unroll
  for (int o = 16; o > 0; o >>= 1) v += bperm(v, lane ^ o);
  return xhalf(v);
}
DI float wave_max(float v, int lane) {
#pragma unroll
  for (int o = 16; o > 0; o >>= 1) v = fmaxf(v, bperm(v, lane ^ o));
  return xhalf_max(v);
}
DI void tokinfo(int row, int& b, int& isctx, int& t) {
  if (row < NL) { b = row >> 14; t = row & 16383; isctx = 0; }
  else { int r = row - NL; b = r >> 8; t = r & 255; isctx = 1; }
}
#define MFMA16(a, b, c) __builtin_amdgcn_mfma_f32_16x16x32_bf16((a), (b), (c), 0, 0, 0)
#define MFMA32(a, b, c) __builtin_amdgcn_mfma_f32_32x32x16_bf16((a), (b), (c), 0, 0, 0)
DI int otid() { int t = threadIdx.x; asm volatile("" : "+v"(t)); return t; }
template <int DK> DI size_t kimg(int kidx, int d) { return ((size_t)((kidx >> 6) * (DK / 8) + (d >> 3)) * 64 + (kidx & 63)) * 8 + (d & 7); }
DI size_t vimg(int kidx, int d) { return (size_t)(kidx >> 6) * 4096 + (d >> 5) * 2048 + (kidx & 63) * 32 + (d & 31); }
DI void glds16(const void* g, unsigned lds_base) {
  unsigned sv;
  asm volatile("s_mov_b32 %0, m0\n\ts_mov_b32 m0, %2\n\ts_nop 0\n\tglobal_load_lds_dwordx4 %1, off\n\ts_mov_b32 m0, %0" : "=&s"(sv) : "v"(g), "s"(lds_base) : "memory");
}
DI int crow(int r, int hi) { return (r & 3) + 8 * (r >> 2) + 4 * hi; }

constexpr int GSTAGE = 49152;
constexpr int GNST = 3;
constexpr int GEMM_LDS = GNST * GSTAGE;
constexpr int LDS_BYTES = GEMM_LDS + 2048;
constexpr int LDS_XBW = LDS_BYTES, LDS_POFF = LDS_BYTES + 16, LDS_TOTAL = LDS_BYTES + 16 + 512;
struct GJ { const bf16_t* A; const int* ridx; const bf16_t* Bt; int lda, m0, ldb, n0, nt; bool valid; };
DI GJ gj_none() { GJ j; j.A = nullptr; j.ridx = nullptr; j.Bt = nullptr; j.lda = 0; j.m0 = 0; j.ldb = 0; j.n0 = 0; j.nt = 0; j.valid = false; return j; }
DI GJ gj_make(const bf16_t* A, const int* ridx, int lda, int m0, const bf16_t* Bt, int ldb, int n0, int K) {
  GJ j; j.A = A; j.ridx = ridx; j.Bt = Bt; j.lda = lda; j.m0 = m0; j.ldb = ldb; j.n0 = n0; j.nt = K >> 6; j.valid = true; return j; }
struct GP { const bf16_t* p[6]; };
DI GP g_setup(const GJ& j, int tid) {
  const int r = tid >> 3, c = (((tid & 7) ^ ((r >> 1) & 7))) * 8;
  GP g;
#pragma unroll
  for (int i = 0; i < 4; ++i) { int rr = j.m0 + r + 64 * i; if (j.ridx) rr = j.ridx[rr]; g.p[i] = j.A + (size_t)rr * j.lda + c; }
#pragma unroll
  for (int i = 0; i < 2; ++i) g.p[4 + i] = j.Bt + (size_t)(j.n0 + r + 64 * i) * j.ldb + c;
  return g;
}
DI void g_issue1(const GP& g, int kt, char* base, int tid, int i) {
  __builtin_amdgcn_global_load_lds((const unsigned*)(g.p[i] + kt * 64), (unsigned*)(base + i * 8192 + tid * 16), 16, 0, 0);
}
DI const bf16_t* g_ptr1(const GJ& j, int tid, int i) {
  const int r = tid >> 3, c = (((tid & 7) ^ ((r >> 1) & 7))) * 8;
  if (i < 4) { int rr = j.m0 + r + 64 * i; if (j.ridx) rr = j.ridx[rr]; return j.A + (size_t)rr * j.lda + c; }
  return j.Bt + (size_t)(j.n0 + r + 64 * (i - 4)) * j.ldb + c;
}
DI void g_issue(const GP& g, int kt, char* base, int tid) {
#pragma unroll
  for (int i = 0; i < 6; ++i) g_issue1(g, kt, base, tid, i);
}
template <int NST>
struct GStream {
  GP cur; int cur_nt, ring, tid; char* lds;
  DI void start(const GJ& j, char* lds_, int tid_) {
    lds = lds_; tid = tid_; ring = 0; cur_nt = j.nt;
    if (j.valid) { cur = g_setup(j, tid);
#pragma unroll
      for (int i = 0; i < NST - 1; ++i) g_issue(cur, i, lds + i * GSTAGE, tid); }
  }
  template <bool LAZY = false, bool PF2 = true>
  DI void run(f32x4 (&acc)[4][4], const GJ& next) {
    const int lane = tid & 63, wid = tid >> 6, wr = wid >> 1, wc = wid & 1, fr = lane & 15, fq = lane >> 4;
    const int sw = (fr >> 1) & 7;
    const int aoff = (wr * 64 + fr) * 128, boff = 32768 + (wc * 64 + fr) * 128;
    const int c0 = ((fq ^ sw) * 16), c1 = (((4 + fq) ^ sw) * 16);
    const bool hn = next.valid;
    GP nxt = cur;
    if (!LAZY && hn) nxt = g_setup(next, tid);
    const int nt = cur_nt;
#pragma unroll 1
    for (int t = 0; t < nt; ++t) {
      int infl = nt - 1 - t + (hn ? NST - 1 : 0); infl = infl > NST - 2 ? NST - 2 : infl;
      if (infl >= 2) asm volatile("s_waitcnt vmcnt(12)" ::: "memory");
      else if (infl == 1) asm volatile("s_waitcnt vmcnt(6)" ::: "memory");
      else asm volatile("s_waitcnt vmcnt(0)" ::: "memory");
      __builtin_amdgcn_s_barrier();
      const int j = t + NST - 1;
      char* ib = lds + ((ring + j) % NST) * GSTAGE;
      const bool own = j < nt, doi = own || hn;
      const int ikt = own ? j : j - nt;
      GP src = cur;
      if (!LAZY && !own && hn) src = nxt;
#define G_ISSUE1(i_) do { if (LAZY && !own) __builtin_amdgcn_global_load_lds((const unsigned*)(g_ptr1(next, tid, (i_)) + ikt * 64), (unsigned*)(ib + (i_) * 8192 + tid * 16), 16, 0, 0); else g_issue1(src, ikt, ib, tid, (i_)); } while (0)
      const char* base = lds + ((ring + t) % NST) * GSTAGE;
      bf16x8 af[4], bfr[4], af1[4], bf1[4];
#pragma unroll
      for (int m = 0; m < 4; ++m) af[m] = *(const bf16x8*)(base + aoff + m * 2048 + c0);
#pragma unroll
      for (int n = 0; n < 4; ++n) bfr[n] = *(const bf16x8*)(base + boff + n * 2048 + c0);
      __builtin_amdgcn_sched_barrier(0);
#pragma unroll
      for (int m = 0; m < 4; ++m) {
#pragma unroll
        for (int n = 0; n < 4; ++n) acc[m][n] = MFMA16(bfr[n], af[m], acc[m][n]);
        if (doi) G_ISSUE1(m);
        if (!LAZY && PF2) {
          if (m == 0) {
#pragma unroll
            for (int n = 0; n < 4; ++n) bf1[n] = *(const bf16x8*)(base + boff + n * 2048 + c1);
          }
          if (m == 1) {
#pragma unroll
            for (int q = 0; q < 4; ++q) af1[q] = *(const bf16x8*)(base + aoff + q * 2048 + c1);
          }
        }
        __builtin_amdgcn_sched_barrier(0);
      }
      if (LAZY || !PF2) {
#pragma unroll
        for (int m = 0; m < 4; ++m) af1[m] = *(const bf16x8*)(base + aoff + m * 2048 + c1);
#pragma unroll
        for (int n = 0; n < 4; ++n) bf1[n] = *(const bf16x8*)(base + boff + n * 2048 + c1);
        __builtin_amdgcn_sched_barrier(0);
      }
#pragma unroll
      for (int m = 0; m < 4; ++m) {
#pragma unroll
        for (int n = 0; n < 4; ++n) acc[m][n] = MFMA16(bf1[n], af1[m], acc[m][n]);
        if (m < 2 && doi) G_ISSUE1(4 + m);
        __builtin_amdgcn_sched_barrier(0);
      }
    }
#undef G_ISSUE1
    ring = (ring + nt) % NST;
    if (LAZY) { if (hn) cur = g_setup(next, tid); } else cur = nxt;
    cur_nt = next.nt;
  }
  DI void run2(f32x4 (&acc)[4][4], const GJ& next) { run(acc, next); }
};
DI void mini_gemm16(f32x4& acc, const bf16_t* __restrict__ A, int lda, const bf16_t* __restrict__ Bt, int ldb, int K, int lane) {
  const bf16_t* ap = A + (size_t)(lane & 15) * lda + 8 * (lane >> 4);
  const bf16_t* bp = Bt + (size_t)(lane & 15) * ldb + 8 * (lane >> 4);
  int k0 = 0;
#pragma unroll 1
  for (; k0 + 512 <= K; k0 += 512) {
    bf16x8 a[16], b[16];
#pragma unroll
    for (int i = 0; i < 16; ++i) { a[i] = *(const bf16x8*)(ap + k0 + i * 32); b[i] = *(const bf16x8*)(bp + k0 + i * 32); }
#pragma unroll
    for (int i = 0; i < 16; ++i) acc = MFMA16(a[i], b[i], acc);
  }
#pragma unroll 1
  for (; k0 < K; k0 += 256) {
    bf16x8 a[8], b[8];
#pragma unroll
    for (int i = 0; i < 8; ++i) { a[i] = *(const bf16x8*)(ap + k0 + i * 32); b[i] = *(const bf16x8*)(bp + k0 + i * 32); }
#pragma unroll
    for (int i = 0; i < 8; ++i) acc = MFMA16(a[i], b[i], acc);
  }
}
DI void mini_gemm32(f32x4 (&acc)[2][2], const bf16_t* __restrict__ A, int lda, const bf16_t* __restrict__ Bt, int ldb, int K, int lane) {
  const bf16_t* ap = A + (size_t)(lane & 15) * lda + 8 * (lane >> 4);
  const bf16_t* bp = Bt + (size_t)(lane & 15) * ldb + 8 * (lane >> 4);
#pragma unroll 1
  for (int k0 = 0; k0 < K; k0 += 256) {
    bf16x8 a0[8], a1[8], b0[8], b1[8];
#pragma unroll
    for (int i = 0; i < 8; ++i) {
      a0[i] = *(const bf16x8*)(ap + k0 + i * 32); a1[i] = *(const bf16x8*)(ap + (size_t)16 * lda + k0 + i * 32);
      b0[i] = *(const bf16x8*)(bp + k0 + i * 32); b1[i] = *(const bf16x8*)(bp + (size_t)16 * ldb + k0 + i * 32);
    }
#pragma unroll
    for (int i = 0; i < 8; ++i) {
      acc[0][0] = MFMA16(a0[i], b0[i], acc[0][0]); acc[0][1] = MFMA16(a0[i], b1[i], acc[0][1]);
      acc[1][0] = MFMA16(a1[i], b0[i], acc[1][0]); acc[1][1] = MFMA16(a1[i], b1[i], acc[1][1]);
    }
  }
}
constexpr int WSTAGE = 32768, WNST = 4;
struct GPW { const bf16_t* p[4]; };
DI GPW gw_setup(const GJ& j, int tid) {
  const int r = tid >> 2, c = (((tid & 3) ^ ((0 - (r >> 2)) & 3))) * 8;
  GPW g;
#pragma unroll
  for (int i = 0; i < 2; ++i) { int rr = j.m0 + r + 128 * i; if (j.ridx) rr = j.ridx[rr]; g.p[i] = j.A + (size_t)rr * j.lda + c; }
#pragma unroll
  for (int i = 0; i < 2; ++i) g.p[2 + i] = j.Bt + (size_t)(j.n0 + r + 128 * i) * j.ldb + c;
  return g;
}
DI void gw_issue1(const GPW& g, int kt, char* base, int tid, int i) {
  __builtin_amdgcn_global_load_lds((const unsigned*)(g.p[i] + kt * 32), (unsigned*)(base + i * 8192 + tid * 16), 16, 0, 0);
}
struct GStreamW {
  GPW cur; int cur_nt, ring, tid; char* lds;
  DI void start(const GJ& j, char* lds_, int tid_) {
    lds = lds_; tid = tid_; ring = 0; cur_nt = j.nt * 2;
    if (j.valid) { cur = gw_setup(j, tid);
#pragma unroll
      for (int s = 0; s < WNST - 1; ++s)
#pragma unroll
        for (int i = 0; i < 4; ++i) gw_issue1(cur, s, lds + s * WSTAGE, tid, i); }
  }
  DI void run(f32x4 (&acc)[4][8], const GJ& next) {
    const int lane = tid & 63, wid = tid >> 6, wr = wid >> 1, wc = wid & 1, fr = lane & 15, fq = lane >> 4;
    const int fo = ((fq ^ ((0 - (fr >> 2)) & 3)) * 16);
    const int aoff = (wr * 64 + fr) * 64 + fo, boff = 16384 + (wc * 128 + fr) * 64 + fo;
    const bool hn = next.valid;
    GPW nxt = cur;
    if (hn) nxt = gw_setup(next, tid);
    const int nt = cur_nt;
#pragma unroll 1
    for (int t = 0; t < nt; ++t) {
      int infl = nt - 1 - t + (hn ? WNST - 1 : 0); infl = infl > WNST - 2 ? WNST - 2 : infl;
      if (infl >= 2) asm volatile("s_waitcnt vmcnt(8)" ::: "memory");
      else if (infl == 1) asm volatile("s_waitcnt vmcnt(4)" ::: "memory");
      else asm volatile("s_waitcnt vmcnt(0)" ::: "memory");
      __builtin_amdgcn_s_barrier();
      const int j = t + WNST - 1;
      char* ib = lds + ((ring + j) % WNST) * WSTAGE;
      const bool own = j < nt, doi = own || hn;
      const int ikt = own ? j : j - nt;
      GPW src = cur;
      if (!own && hn) src = nxt;
      const char* base = lds + ((ring + t) % WNST) * WSTAGE;
      bf16x8 af[4], bfr[8];
#pragma unroll
      for (int m = 0; m < 4; ++m) af[m] = *(const bf16x8*)(base + aoff + m * 1024);
#pragma unroll
      for (int n = 0; n < 8; ++n) bfr[n] = *(const bf16x8*)(base + boff + n * 1024);
      __builtin_amdgcn_sched_barrier(0);
#pragma unroll
      for (int m = 0; m < 4; ++m) {
#pragma unroll
        for (int n = 0; n < 8; ++n) acc[m][n] = MFMA16(bfr[n], af[m], acc[m][n]);
        if (doi) gw_issue1(src, ikt, ib, tid, m);
        __builtin_amdgcn_sched_barrier(0);
      }
    }
    ring = (ring + nt) % WNST;
    cur = nxt; cur_nt = next.nt * 2;
  }
};
DI void zero_accw(f32x4 (&acc)[4][8]) {
#pragma unroll
  for (int m = 0; m < 4; ++m)
#pragma unroll
    for (int n = 0; n < 8; ++n) acc[m][n] = f32x4{0.f, 0.f, 0.f, 0.f};
}
constexpr int G8_HT = 128 * 64;
DI int g8_lds_byte(int r, int c) { const int st = (r >> 4) * 2 + (c >> 5), rr = r & 15, cc = c & 31, ob = rr * 64 + cc * 2; return st * 1024 + (ob ^ (((ob >> 9) & 1) << 5)); }
DI void g8_stage_rc(int b, int& R, int& C) { const int st = b / 1024, sb = b % 1024, swz = sb ^ (((sb >> 9) & 1) << 5); R = (st >> 1) * 16 + swz / 64; C = (st & 1) * 32 + (swz % 64) / 2; }
template <bool GATHER>
DI void gemm8(f32x4 (&acc)[2][2][4][2], const bf16_t* __restrict__ A, const int* __restrict__ ridx, int brow, const bf16_t* __restrict__ B0, const bf16_t* __restrict__ B1, int K, char* shmc) {
  bf16_t* shm = (bf16_t*)shmc;
#define G8_SA(b, h) (shm + ((b) * 2 + (h)) * G8_HT)
#define G8_SB(b, h) (shm + (4 + (b) * 2 + (h)) * G8_HT)
  int tz = otid();
  int wid = tz >> 6, lane = tz & 63, wr = wid >> 2, wc = wid & 3, fr = lane & 15, fq = lane >> 4;
  int ar[2][2];
  if (GATHER) {
#pragma unroll
    for (int h = 0; h < 2; ++h)
#pragma unroll
      for (int i = 0; i < 2; ++i) { int r_, c_; g8_stage_rc(tz * 16 + i * 8192, r_, c_); ar[h][i] = ridx[brow + h * 128 + r_]; }
  }
#define G8_STAGE_A(P, h, kt) do { _Pragma("unroll") for (int i_ = 0; i_ < 2; ++i_) { const int b_ = tz * 16 + i_ * 8192; int r_, c_; g8_stage_rc(b_, r_, c_); \
      const long row_ = GATHER ? (long)ar[h][i_] : (long)(brow + (h) * 128 + r_); \
      __builtin_amdgcn_global_load_lds((const unsigned*)(A + row_ * K + (long)(kt) * 64 + c_), (unsigned*)((char*)(P) + b_), 16, 0, 0); } } while (0)
#define G8_STAGE_B(P, h, kt) do { const bf16_t* bb_ = (h) ? B1 : B0; _Pragma("unroll") for (int i_ = 0; i_ < 2; ++i_) { const int b_ = tz * 16 + i_ * 8192; int r_, c_; g8_stage_rc(b_, r_, c_); \
      __builtin_amdgcn_global_load_lds((const unsigned*)(bb_ + (long)r_ * K + (long)(kt) * 64 + c_), (unsigned*)((char*)(P) + b_), 16, 0, 0); } } while (0)
#define G8_LDA(dst, b, h) _Pragma("unroll") for (int m = 0; m < 4; ++m) _Pragma("unroll") for (int k = 0; k < 2; ++k) \
    dst[m][k] = *reinterpret_cast<const bf16x8*>((char*)G8_SA(b, h) + g8_lds_byte(wr * 64 + m * 16 + fr, k * 32 + fq * 8))
#define G8_LDB(dst, b, h) _Pragma("unroll") for (int n = 0; n < 2; ++n) _Pragma("unroll") for (int k = 0; k < 2; ++k) \
    dst[n][k] = *reinterpret_cast<const bf16x8*>((char*)G8_SB(b, h) + g8_lds_byte(wc * 32 + n * 16 + fr, k * 32 + fq * 8))
#define G8_MMA(ai, bj, At_, Bt_) do { __builtin_amdgcn_s_setprio(1); \
    _Pragma("unroll") for (int m = 0; m < 4; ++m) _Pragma("unroll") for (int n = 0; n < 2; ++n) _Pragma("unroll") for (int k = 0; k < 2; ++k) \
      acc[ai][bj][m][n] = MFMA16(Bt_[n][k], At_[m][k], acc[ai][bj][m][n]); \
    __builtin_amdgcn_s_setprio(0); } while (0)
#define G8_WAIT_V(n) asm volatile("s_waitcnt vmcnt(" #n ")" ::: "memory")
#define G8_WAIT_L(n) asm volatile("s_waitcnt lgkmcnt(" #n ")" ::: "memory")
#define G8_BAR __builtin_amdgcn_s_barrier()
#define G8_SCHED __builtin_amdgcn_sched_barrier(0)
  bf16x8 At[4][2], Bq0[2][2], Bq1[2][2];
  const int nt = K / 64;
  G8_STAGE_B(G8_SB(0, 0), 0, 0); G8_STAGE_A(G8_SA(0, 0), 0, 0);
  G8_STAGE_B(G8_SB(0, 1), 1, 0); G8_STAGE_A(G8_SA(0, 1), 1, 0);
  if (wr == 1) G8_BAR;
  G8_WAIT_V(4); G8_BAR;
  G8_STAGE_B(G8_SB(1, 0), 0, 1); G8_STAGE_A(G8_SA(1, 0), 0, 1); G8_STAGE_B(G8_SB(1, 1), 1, 1);
  G8_WAIT_V(6); G8_BAR;
#pragma unroll 1
  for (int t = 0; t < nt - 2; t += 2) {
    G8_LDB(Bq0, 0, 0); G8_SCHED; G8_LDA(At, 0, 0); G8_STAGE_A(G8_SA(1, 1), 1, t + 1);
    G8_WAIT_L(8); G8_BAR; G8_WAIT_L(0); G8_MMA(0, 0, At, Bq0); G8_BAR; G8_SCHED;
    G8_LDB(Bq1, 0, 1); G8_STAGE_B(G8_SB(0, 0), 0, t + 2);
    G8_BAR; G8_WAIT_L(0); G8_MMA(0, 1, At, Bq1); G8_BAR;
    G8_LDA(At, 0, 1); G8_STAGE_A(G8_SA(0, 0), 0, t + 2);
    G8_BAR; G8_WAIT_L(0); G8_MMA(1, 0, At, Bq0); G8_BAR; G8_SCHED;
    G8_STAGE_B(G8_SB(0, 1), 1, t + 2);
    G8_WAIT_V(6); G8_BAR; G8_MMA(1, 1, At, Bq1); G8_BAR;
    G8_LDB(Bq0, 1, 0); G8_SCHED; G8_LDA(At, 1, 0); G8_STAGE_A(G8_SA(0, 1), 1, t + 2);
    G8_WAIT_L(8); G8_BAR; G8_WAIT_L(0); G8_MMA(0, 0, At, Bq0); G8_BAR; G8_SCHED;
    G8_LDB(Bq1, 1, 1); G8_STAGE_B(G8_SB(1, 0), 0, t + 3);
    G8_BAR; G8_WAIT_L(0); G8_MMA(0, 1, At, Bq1); G8_BAR;
    G8_LDA(At, 1, 1); G8_STAGE_A(G8_SA(1, 0), 0, t + 3);
    G8_BAR; G8_WAIT_L(0); G8_MMA(1, 0, At, Bq0); G8_BAR; G8_SCHED;
    G8_STAGE_B(G8_SB(1, 1), 1, t + 3);
    G8_WAIT_V(6); G8_BAR; G8_MMA(1, 1, At, Bq1); G8_BAR;
  }
  { int t2 = tz; asm volatile("" : "+v"(t2)); tz = t2; wid = tz >> 6; lane = tz & 63; wr = wid >> 2; wc = wid & 3; fr = lane & 15; fq = lane >> 4; }
  { G8_LDB(Bq0, 0, 0); G8_WAIT_V(0); G8_LDA(At, 0, 0); G8_STAGE_A(G8_SA(1, 1), 1, nt - 1);
    G8_BAR; G8_WAIT_L(0); G8_MMA(0, 0, At, Bq0); G8_BAR;
    G8_LDB(Bq1, 0, 1); G8_BAR; G8_WAIT_L(0); G8_MMA(0, 1, At, Bq1); G8_BAR;
    G8_LDA(At, 0, 1); G8_WAIT_V(4); G8_BAR; G8_WAIT_L(0); G8_MMA(1, 0, At, Bq0); G8_MMA(1, 1, At, Bq1); G8_BAR; }
  { G8_LDB(Bq0, 1, 0); G8_LDA(At, 1, 0); G8_WAIT_V(2); G8_BAR; G8_WAIT_L(0); G8_MMA(0, 0, At, Bq0); G8_BAR;
    G8_LDB(Bq1, 1, 1); G8_WAIT_V(0); G8_BAR; G8_WAIT_L(0); G8_MMA(0, 1, At, Bq1); G8_BAR;
    G8_LDA(At, 1, 1); G8_BAR; G8_WAIT_L(0); G8_MMA(1, 0, At, Bq0); G8_MMA(1, 1, At, Bq1); G8_BAR; }
  if (wr == 0) G8_BAR;
#undef G8_SA
#undef G8_SB
#undef G8_STAGE_A
#undef G8_STAGE_B
#undef G8_LDA
#undef G8_LDB
#undef G8_MMA
#undef G8_WAIT_V
#undef G8_WAIT_L
#undef G8_BAR
#undef G8_SCHED
}
DI void zero_acc8(f32x4 (&acc)[2][2][4][2]) {
#pragma unroll
  for (int a = 0; a < 2; ++a)
#pragma unroll
    for (int b = 0; b < 2; ++b)
#pragma unroll
      for (int m = 0; m < 4; ++m)
#pragma unroll
        for (int n = 0; n < 2; ++n) acc[a][b][m][n] = f32x4{0.f, 0.f, 0.f, 0.f};
}
struct UM {
  int x, r, R, NT, nloc;
  DI UM(int NM, int NT_) { x = blockIdx.x & 7; r = blockIdx.x >> 3; R = gridDim.x >> 3; NT = NT_; nloc = ((NM - x + 7) >> 3) * NT_; if (NM <= x) nloc = 0; }
  DI bool get(int k, int& mt, int& nt) const { const int v = r + k * R; if (k < 0 || v >= nloc) return false; mt = x + 8 * (v / NT); nt = v % NT; return true; }
};
DI u32x2 pack4(const f32x4& v) { u32x2 r; r[0] = pack2(v[0], v[1]); r[1] = pack2(v[2], v[3]); return r; }
DI void zero_acc(f32x4 (&acc)[4][4]) {
#pragma unroll
  for (int m = 0; m < 4; ++m)
#pragma unroll
    for (int n = 0; n < 4; ++n) acc[m][n] = f32x4{0.f, 0.f, 0.f, 0.f};
}

DI float rope_apply(float v, float partner, int fr, int half, int t, const float2* roper, const float2* ropec) {
  const int i = fr & 7;
  const float2 cs = half ? ropec[(t & 63) * 8 + i] : roper[(t >> 6) * 8 + i];
  return (fr & 8) ? (partner * cs.y + v * cs.x) : (v * cs.x - partner * cs.y);
}

DI void phase_p0(const Params& p, char* lds) {
  const int tid = otid(), gtid = blockIdx.x * NTHR + tid, gsz = gridDim.x * NTHR;
  float* sl = (float*)lds;
  for (int i = tid; i < 3072; i += NTHR) { float v = i < 2048 ? p.c[i] : p.c_ctx[i - 2048]; sl[i] = v / (1.f + __expf(-v)); }
  __syncthreads();
  float* adap = (float*)(p.ws + O_ACT);
  for (int w = gtid; w < DEPTH * 6144 * 4; w += gsz) {
    const int kp = w / (DEPTH * 6144), o = w % (DEPTH * 6144);
    const int l = o / 6144, col = o % 6144;
    const float* wp = p.w_ada + ((size_t)l * 1024 + kp * 256) * 6144 + col;
    const float* s0 = sl + kp * 256;
    float a0 = 0.f, a1 = 0.f, a2 = 0.f;
#pragma unroll 16
    for (int k = 0; k < 256; ++k) { const float wv = wp[(size_t)k * 6144]; a0 += s0[k] * wv; a1 += s0[1024 + k] * wv; a2 += s0[2048 + k] * wv; }
    float* dst = adap + (size_t)kp * (DEPTH * 3 * 6144);
    dst[(l * 3 + 0) * 6144 + col] = a0; dst[(l * 3 + 1) * 6144 + col] = a1; dst[(l * 3 + 2) * 6144 + col] = a2;
  }
  float2* rr = (float2*)(p.ws + O_ROPER);
  float2* rc = (float2*)(p.ws + O_ROPEC);
  for (int i = gtid; i < 2048 + 512; i += gsz) {
    const int j = i < 2048 ? i : i - 2048;
    const int pos = j >> 3, f = j & 7;
    double freq = 1.0;
    switch (f) { case 1: freq = 0.31622776601683794; break; case 2: freq = 0.1; break; case 3: freq = 0.031622776601683794; break; case 4: freq = 0.01; break;
      case 5: freq = 0.0031622776601683794; break; case 6: freq = 0.001; break; case 7: freq = 0.00031622776601683794; break; default: break; }
    double rev = (double)pos * freq * 0.15915494309189535; rev -= floor(rev);
    const float rf = (float)rev;
    const float2 cs = make_float2(__builtin_amdgcn_cosf(rf), __builtin_amdgcn_sinf(rf));
    if (i < 2048) rr[j] = cs; else rc[j] = cs;
  }
  float2* pw = (float2*)(p.ws + O_S5PW);
  float2* bb = (float2*)(p.ws + O_S5BB);
  for (int i = gtid; i < DEPTH * 2 * 16 * 64; i += gsz) {
    const int ldg = i >> 6, pp = i & 63;
    const float lr = p.s5_lam_re[i], li = p.s5_lam_im[i];
    const float step = expf(p.s5_log_step[ldg]);
    float ar = 1.f, ai = 0.f;
    for (int tau = 0; tau <= 64; ++tau) {
      double rev = (double)li * (double)step * (double)tau * 0.15915494309189535; rev -= floor(rev);
      const float rf = (float)rev;
      const float mag = expf(lr * step * (float)tau);
      const float2 v = make_float2(mag * __builtin_amdgcn_cosf(rf), mag * __builtin_amdgcn_sinf(rf));
      pw[((size_t)ldg * 65 + tau) * 64 + pp] = v;
      if (tau == 1) { ar = v.x; ai = v.y; }
    }
    const float den = lr * lr + li * li;
    const float fr_ = ((ar - 1.f) * lr + ai * li) / den, fi_ = (ai * lr - (ar - 1.f) * li) / den;
    for (int j = 0; j < 16; ++j) {
      const float br = p.s5_b_re[(size_t)i * 16 + j], bi = p.s5_b_im[(size_t)i * 16 + j];
      bb[(size_t)i * 16 + j] = make_float2(fr_ * br - fi_ * bi, fr_ * bi + fi_ * br);
    }
  }
  if (gtid < DEPTH) {
    const float* lf = p.diff_lambda + gtid * 128;
    float s1 = 0.f, s2 = 0.f;
    for (int k = 0; k < 32; ++k) { s1 += lf[k] * lf[32 + k]; s2 += lf[64 + k] * lf[96 + k]; }
    const float lam_init = 0.8f - 0.6f * expf(-0.3f * (float)gtid);
    ((float*)(p.ws + O_LAMF))[gtid] = expf(s1) - expf(s2) + lam_init;
  }
  if (gtid < 64) ((int*)(p.ws + O_CNT))[gtid] = 0;
}

DI void phase_p1(const Params& p) {
  const int gtid = blockIdx.x * NTHR + otid(), gsz = gridDim.x * NTHR;
  {
    const float* adap = (const float*)(p.ws + O_ACT);
    float* ada = (float*)(p.ws + O_ADA);
    for (int i = gtid; i < DEPTH * 3 * 6144; i += gsz) {
      const int l = i / (3 * 6144), col = i % 6144;
      ada[i] = ((adap[i] + adap[i + DEPTH * 3 * 6144]) + (adap[i + 2 * DEPTH * 3 * 6144] + adap[i + 3 * DEPTH * 3 * 6144])) + p.b_ada[l * 6144 + col];
    }
  }
  const float2* pw = (const float2*)(p.ws + O_S5PW);
  const float2* bb = (const float2*)(p.ws + O_S5BB);
  float* km = (float*)(p.ws + O_S5K);
  for (int o = gtid; o < DEPTH * 2 * 16 * 64 * 256; o += gsz) {
    const int j2 = o & 15, j = (o >> 4) & 15, tau = (o >> 8) & 63, ldg = o >> 14;
    const float* cr = p.s5_c_re + ((size_t)ldg * 16 + j) * 64;
    const float* ci = p.s5_c_im + ((size_t)ldg * 16 + j) * 64;
    const float2* pwr = pw + ((size_t)ldg * 65 + tau) * 64;
    const float2* bbr = bb + (size_t)ldg * 64 * 16 + j2;
    float s = 0.f;
    for (int pp = 0; pp < 64; ++pp) {
      const float2 a = pwr[pp], b = bbr[pp * 16];
      const float wr_ = cr[pp] * a.x - ci[pp] * a.y, wi_ = cr[pp] * a.y + ci[pp] * a.x;
      s += wr_ * b.x - wi_ * b.y;
    }
    km[o] = s;
  }
}

template <int LOPART = 0>
DI void conv_tile(const float* __restrict__ in, int ld_in, bf16_t* __restrict__ out, int ld_out, const float* __restrict__ rs, int k0, int n0, float* sm) {
  const int tid = otid();
  {
    const int k = tid >> 3, n4 = (tid & 7) * 4;
    float4 v = *(const float4*)(in + (size_t)(k0 + k) * ld_in + n0 + n4);
    if (rs) { const float s = rs[k0 + k]; v.x *= s; v.y *= s; v.z *= s; v.w *= s; }
    sm[(n4 + 0) * 65 + k] = v.x; sm[(n4 + 1) * 65 + k] = v.y; sm[(n4 + 2) * 65 + k] = v.z; sm[(n4 + 3) * 65 + k] = v.w;
  }
  __syncthreads();
  {
    const int n = tid >> 4, k4 = (tid & 15) * 4;
    const float* s = sm + n * 65 + k4;
    float v0 = s[0], v1 = s[1], v2 = s[2], v3 = s[3];
    if (LOPART) { v0 -= bf2f(f2bf(v0)); v1 -= bf2f(f2bf(v1)); v2 -= bf2f(f2bf(v2)); v3 -= bf2f(f2bf(v3)); }
    u32x2 o; o[0] = pack2(v0, v1); o[1] = pack2(v2, v3);
    *(u32x2*)(out + (size_t)(n0 + n) * ld_out + k0 + k4) = o;
  }
  __syncthreads();
}
DI void conv_job(const float* in, int ld_in, size_t in_ms, bf16_t* out, int ld_out, size_t out_ms, const float* rs, int K, int N, int multi, float* sm) {
  const int tk = K >> 6, tn = N >> 5, per = tk * tn, total = per * multi;
  const int tid = otid();
  const int k = tid >> 3, n4 = (tid & 7) * 4, n = tid >> 4, k4 = (tid & 15) * 4;
  for (int t0 = blockIdx.x * 4; t0 < total; t0 += gridDim.x * 4) {
    float4 v[4];
#pragma unroll
    for (int q = 0; q < 4; ++q) {
      const int t = t0 + q;
      if (t < total) {
        const int mi = t / per, tt = t % per, k0 = (tt / tn) * 64, n0 = (tt % tn) * 32;
        v[q] = *(const float4*)(in + (size_t)mi * in_ms + (size_t)(k0 + k) * ld_in + n0 + n4);
        if (rs) { const float sc = rs[k0 + k]; v[q].x *= sc; v[q].y *= sc; v[q].z *= sc; v[q].w *= sc; }
      } else v[q] = make_float4(0.f, 0.f, 0.f, 0.f);
    }
#pragma unroll
    for (int q = 0; q < 4; ++q) { float* s_ = sm + q * 2080; s_[(n4 + 0) * 65 + k] = v[q].x; s_[(n4 + 1) * 65 + k] = v[q].y; s_[(n4 + 2) * 65 + k] = v[q].z; s_[(n4 + 3) * 65 + k] = v[q].w; }
    __syncthreads();
#pragma unroll
    for (int q = 0; q < 4; ++q) {
      const int t = t0 + q;
      if (t < total) {
        const int mi = t / per, tt = t % per, k0 = (tt / tn) * 64, n0 = (tt % tn) * 32;
        const float* s_ = sm + q * 2080 + n * 65 + k4;
        u32x2 o; o[0] = pack2(s_[0], s_[1]); o[1] = pack2(s_[2], s_[3]);
        *(u32x2*)(out + (size_t)mi * out_ms + (size_t)(n0 + n) * ld_out + k0 + k4) = o;
      }
    }
    __syncthreads();
  }
}
DI void phase_prep(const Params& p, int l, char* lds) {
  float* sm = (float*)lds;
  GPTR wsg_ = (GPTR)p.ws; asm volatile("" : "+s"(wsg_)); char* ws = (char*)wsg_;
  const int tid = otid(), gtid = blockIdx.x * NTHR + tid, gsz = gridDim.x * NTHR;
  unsigned z0_ = 0u; asm volatile("" : "+v"(z0_));
  const u32x4 zero4 = u32x4{z0_, z0_, z0_, z0_};
  conv_job(p.w_in + (size_t)l * 1024 * INW, INW, 0, (bf16_t*)(ws + O_WIN), 1024, 0, nullptr, 1024, 2208, 1, sm);
  for (int i = gtid; i < 96 * 1024 / 8; i += gsz) ((u32x4*)(ws + O_WIN + (size_t)2208 * 1024 * 2))[i] = zero4;
  conv_job(p.w_in + (size_t)l * 1024 * INW + 2208, INW, 0, (bf16_t*)(ws + O_WG), 1024, 0, nullptr, 1024, 4096, 1, sm);
  conv_job(p.w_mla_uq + (size_t)l * 256 * 384, 384, 0, (bf16_t*)(ws + O_WUQ), 256, 0, p.g_mla_q + l * 256, 256, 384, 1, sm);
  conv_job(p.w_mla_ukv + (size_t)l * 128 * 512, 512, 0, (bf16_t*)(ws + O_WUKV), 128, 0, p.g_mla_kv + l * 128, 128, 512, 1, sm);
  conv_job(p.w_glu + (size_t)l * 65536, 256, 0, (bf16_t*)(ws + O_WGLU), 256, 0, nullptr, 256, 256, 1, sm);
  conv_job(p.w_branch + (size_t)l * 4 * 262144, 1024, 262144, (bf16_t*)(ws + O_WBR), 256, 262144, nullptr, 256, 1024, 4, sm);
  conv_job(p.w_out + (size_t)l * 1048576, 1024, 0, (bf16_t*)(ws + O_WOUT), 1024, 0, nullptr, 1024, 1024, 1, sm);
  conv_job(p.w_e1 + (size_t)l * 64 * 262144, 256, 262144, (bf16_t*)(ws + O_WE1), 1024, 262144, nullptr, 1024, 256, 64, sm);
  conv_job(p.w_e3 + (size_t)l * 64 * 262144, 256, 262144, (bf16_t*)(ws + O_WE3), 1024, 262144, nullptr, 1024, 256, 64, sm);
  conv_job(p.w_e2 + (size_t)l * 64 * 262144, 1024, 262144, (bf16_t*)(ws + O_WE2), 256, 262144, nullptr, 256, 1024, 64, sm);
  conv_job(p.w_s1 + (size_t)l * 262144, 256, 0, (bf16_t*)(ws + O_WE1) + (size_t)64 * 262144, 1024, 0, nullptr, 1024, 256, 1, sm);
  conv_job(p.w_s3 + (size_t)l * 262144, 256, 0, (bf16_t*)(ws + O_WE3) + (size_t)64 * 262144, 1024, 0, nullptr, 1024, 256, 1, sm);
  conv_job(p.w_s2 + (size_t)l * 262144, 1024, 0, (bf16_t*)(ws + O_WE2) + (size_t)64 * 262144, 256, 0, nullptr, 256, 1024, 1, sm);
  for (int t = blockIdx.x; t < 32; t += gridDim.x) {
    conv_tile<0>(p.w_router + (size_t)l * 65536, 64, (bf16_t*)(ws + O_WRHI), 1024, nullptr, (t >> 1) * 64, (t & 1) * 32, sm);
    conv_tile<1>(p.w_router + (size_t)l * 65536, 64, (bf16_t*)(ws + O_WRLO), 1024, nullptr, (t >> 1) * 64, (t & 1) * 32, sm);
  }
  for (int i = gtid; i < 64 * 1024 / 8; i += gsz) { ((u32x4*)(ws + O_WRHI + 64 * 1024 * 2))[i] = zero4; ((u32x4*)(ws + O_WRLO + 64 * 1024 * 2))[i] = zero4; }
  const float2* pw = (const float2*)(ws + O_S5PW) + (size_t)l * 2 * 16 * 65 * 64;
  const float2* bbv = (const float2*)(ws + O_S5BB) + (size_t)l * 2 * 16 * 64 * 16;
  const float* km = (const float*)(ws + O_S5K) + (size_t)l * 2 * 16 * 64 * 256;
  const float* cre = p.s5_c_re + (size_t)l * 2 * 16 * 16 * 64;
  const float* cim = p.s5_c_im + (size_t)l * 2 * 16 * 16 * 64;
  bf16_t* b2 = (bf16_t*)(ws + O_S5B2);
#pragma unroll 1
  for (int it0 = gtid; it0 < 16 * 1024 * 128; it0 += gsz * 4) {
    float4 fa[4][2], fb[4][2]; float dd[4];
#pragma unroll
    for (int u = 0; u < 4; ++u) {
      const int it = it0 + u * gsz;
      const float4 z4 = make_float4(0.f, 0.f, 0.f, 0.f);
      fa[u][0] = z4; fa[u][1] = z4; fb[u][0] = z4; fb[u][1] = z4; dd[u] = 0.f;
      if (it < 16 * 1024 * 128) {
        const int kc = it & 127, gn = it >> 7, n = gn & 1023, g = gn >> 10, i = n >> 4, j = n & 15, k0 = kc * 8, i2 = k0 >> 4, jb = k0 & 15;
        if (i2 <= i) { const float4* q_ = (const float4*)(km + ((((size_t)0 * 16 + g) * 64 + (i - i2)) * 16 + j) * 16 + jb); fa[u][0] = q_[0]; fa[u][1] = q_[1]; }
        if (i2 >= i) { const float4* q_ = (const float4*)(km + ((((size_t)1 * 16 + g) * 64 + (i2 - i)) * 16 + j) * 16 + jb); fb[u][0] = q_[0]; fb[u][1] = q_[1]; }
        if (i2 == i && (j >> 3) == (jb >> 3)) dd[u] = p.s5_d[(l * 16 + g) * 16 + j];
      }
    }
#pragma unroll
    for (int u = 0; u < 4; ++u) {
      const int it = it0 + u * gsz;
      if (it < 16 * 1024 * 128) {
        const int kc = it & 127, gn = it >> 7, j = gn & 15, k0 = kc * 8;
        float v[8] = {0.f + fa[u][0].x + fb[u][0].x, 0.f + fa[u][0].y + fb[u][0].y, 0.f + fa[u][0].z + fb[u][0].z, 0.f + fa[u][0].w + fb[u][0].w,
                      0.f + fa[u][1].x + fb[u][1].x, 0.f + fa[u][1].y + fb[u][1].y, 0.f + fa[u][1].z + fb[u][1].z, 0.f + fa[u][1].w + fb[u][1].w};
#pragma unroll
        for (int e = 0; e < 8; ++e) if (e == (j & 7)) v[e] += dd[u];
        u32x4 o; o[0] = pack2(v[0], v[1]); o[1] = pack2(v[2], v[3]); o[2] = pack2(v[4], v[5]); o[3] = pack2(v[6], v[7]);
        *(u32x4*)(b2 + ((size_t)gn * 1280 + k0)) = o;
      }
    }
  }
#pragma unroll 1
  for (int it0 = gtid; it0 < 16 * 1024 * 32; it0 += gsz * 2) {
    float4 cr4[2][2], ci4[2][2], pw4[2][4];
#pragma unroll
    for (int u = 0; u < 2; ++u) {
      const int it = it0 + u * gsz;
      if (it < 16 * 1024 * 32) {
        const int kq = it & 31, gn = it >> 5, n = gn & 1023, g = gn >> 10, i = n >> 4, j = n & 15;
        const int d = kq >> 4, kk = (kq & 15) * 8, p0 = kk & 63, tau = d ? 64 - i : i + 1;
        const float4* c1 = (const float4*)(cre + (((size_t)d * 16 + g) * 16 + j) * 64 + p0);
        const float4* c2 = (const float4*)(cim + (((size_t)d * 16 + g) * 16 + j) * 64 + p0);
        const float4* c3 = (const float4*)(pw + (((size_t)d * 16 + g) * 65 + tau) * 64 + p0);
        cr4[u][0] = c1[0]; cr4[u][1] = c1[1]; ci4[u][0] = c2[0]; ci4[u][1] = c2[1];
        pw4[u][0] = c3[0]; pw4[u][1] = c3[1]; pw4[u][2] = c3[2]; pw4[u][3] = c3[3];
      }
    }
#pragma unroll
    for (int u = 0; u < 2; ++u) {
      const int it = it0 + u * gsz;
      if (it < 16 * 1024 * 32) {
        const int kq = it & 31, gn = it >> 5, kk = (kq & 15) * 8, ri = kk >> 6;
        const float cr[8] = {cr4[u][0].x, cr4[u][0].y, cr4[u][0].z, cr4[u][0].w, cr4[u][1].x, cr4[u][1].y, cr4[u][1].z, cr4[u][1].w};
        const float ci[8] = {ci4[u][0].x, ci4[u][0].y, ci4[u][0].z, ci4[u][0].w, ci4[u][1].x, ci4[u][1].y, ci4[u][1].z, ci4[u][1].w};
        const float ax[8] = {pw4[u][0].x, pw4[u][0].z, pw4[u][1].x, pw4[u][1].z, pw4[u][2].x, pw4[u][2].z, pw4[u][3].x, pw4[u][3].z};
        const float ay[8] = {pw4[u][0].y, pw4[u][0].w, pw4[u][1].y, pw4[u][1].w, pw4[u][2].y, pw4[u][2].w, pw4[u][3].y, pw4[u][3].w};
        float v[8];
#pragma unroll
        for (int e = 0; e < 8; ++e) {
          const float wr_ = cr[e] * ax[e] - ci[e] * ay[e], wi_ = cr[e] * ay[e] + ci[e] * ax[e];
          v[e] = ri == 0 ? wr_ : -wi_;
        }
        u32x4 o; o[0] = pack2(v[0], v[1]); o[1] = pack2(v[2], v[3]); o[2] = pack2(v[4], v[5]); o[3] = pack2(v[6], v[7]);
        *(u32x4*)(b2 + ((size_t)gn * 1280 + 1024 + kq * 8)) = o;
      }
    }
  }
  bf16_t* b1 = (bf16_t*)(ws + O_S5B1);
#pragma unroll 1
  for (int it0 = gtid; it0 < 16 * 256 * 128; it0 += gsz * 2) {
    float2 a2[2]; float4 b4[2][4];
#pragma unroll
    for (int u = 0; u < 2; ++u) {
      const int it = it0 + u * gsz;
      if (it < 16 * 256 * 128) {
        const int kc = it & 127, gn = it >> 7, n = gn & 255, g = gn >> 8;
        const int d = n >> 7, pp = n & 63, k0 = kc * 8, s = k0 >> 4, jb = k0 & 15;
        a2[u] = pw[(((size_t)d * 16 + g) * 65 + (d ? s : 63 - s)) * 64 + pp];
        const float4* q_ = (const float4*)(bbv + (((size_t)d * 16 + g) * 64 + pp) * 16 + jb);
        b4[u][0] = q_[0]; b4[u][1] = q_[1]; b4[u][2] = q_[2]; b4[u][3] = q_[3];
      }
    }
#pragma unroll
    for (int u = 0; u < 2; ++u) {
      const int it = it0 + u * gsz;
      if (it < 16 * 256 * 128) {
        const int kc = it & 127, gn = it >> 7, n = gn & 255, ri = (n >> 6) & 1, k0 = kc * 8;
        const float2 a = a2[u];
        const float bx[8] = {b4[u][0].x, b4[u][0].z, b4[u][1].x, b4[u][1].z, b4[u][2].x, b4[u][2].z, b4[u][3].x, b4[u][3].z};
        const float by[8] = {b4[u][0].y, b4[u][0].w, b4[u][1].y, b4[u][1].w, b4[u][2].y, b4[u][2].w, b4[u][3].y, b4[u][3].w};
        float v[8];
#pragma unroll
        for (int e = 0; e < 8; ++e) v[e] = ri == 0 ? (a.x * bx[e] - a.y * by[e]) : (a.x * by[e] + a.y * bx[e]);
        u32x4 o; o[0] = pack2(v[0], v[1]); o[1] = pack2(v[2], v[3]); o[2] = pack2(v[4], v[5]); o[3] = pack2(v[6], v[7]);
        *(u32x4*)(b1 + ((size_t)gn * 1024 + k0)) = o;
      }
    }
  }
}

DI void phase_rows(const Params& p, int l, float rscale = 1.f) {
  GPTR wsg_ = (GPTR)p.ws; asm volatile("" : "+s"(wsg_)); char* ws = (char*)wsg_;
  const int tid_ = otid(), lane = tid_ & 63, gw = blockIdx.x * 8 + (tid_ >> 6), nw = gridDim.x * 8;
  bf16_t* X = (bf16_t*)(ws + O_X);
  bf16_t* H1 = (bf16_t*)(ws + O_H1);
  const unsigned char* Y = (const unsigned char*)(ws + O_R);
  const int* slot = (const int*)(ws + O_SLOT);
  const float* gwt = (const float*)(ws + O_GW);
  const int* cnt = (const int*)(ws + O_CNT);
  const float* ada = (const float*)(ws + O_ADA);
  int poff64 = 0;
  if (l > 0) { for (int e = 0; e < 64; ++e) poff64 += (cnt[e] + 255) & ~255; }
  for (int row = gw; row < NTOK; row += nw) {
    int b, isctx, t; tokinfo(row, b, isctx, t);
    const int cv = isctx ? 2 : b;
    float xv[16];
    if (l == 0) {
      const float* src = isctx ? p.ctx + (size_t)(b * 256 + t) * 1024 : p.x + (size_t)row * 1024;
#pragma unroll
      for (int i = 0; i < 4; ++i) { const float4 v = *(const float4*)(src + i * 256 + lane * 4); xv[i * 4] = v.x; xv[i * 4 + 1] = v.y; xv[i * 4 + 2] = v.z; xv[i * 4 + 3] = v.w; }
    } else {
      const bf16_t* src = X + (size_t)row * 1024;
#pragma unroll
      for (int i = 0; i < 4; ++i) { const u32x2 v = *(const u32x2*)(src + i * 256 + lane * 4);
        xv[i * 4] = __uint_as_float(v[0] << 16); xv[i * 4 + 1] = __uint_as_float(v[0] & 0xffff0000u); xv[i * 4 + 2] = __uint_as_float(v[1] << 16); xv[i * 4 + 3] = __uint_as_float(v[1] & 0xffff0000u); }
      float f[16];
      typedef float fl2v __attribute__((ext_vector_type(2)));
      {
        const bf16_t* ys = (const bf16_t*)(ws + O_R + (size_t)YROWS * 1024) + (size_t)row * 1024;
#pragma unroll
        for (int i = 0; i < 4; ++i) { const u32x2 v = *(const u32x2*)(ys + i * 256 + lane * 4);
          f[i * 4] = rscale * __uint_as_float(v[0] << 16); f[i * 4 + 1] = rscale * __uint_as_float(v[0] & 0xffff0000u); f[i * 4 + 2] = rscale * __uint_as_float(v[1] << 16); f[i * 4 + 3] = rscale * __uint_as_float(v[1] & 0xffff0000u); }
      }
      int sv = 0; float wv = 0.f;
      if (lane < 6) { sv = slot[row * 6 + lane]; wv = gwt[row * 6 + lane] * rscale * 0.0625f; }
      int yv[6][4];
#pragma unroll
      for (int k = 0; k < 6; ++k) {
        const int s = __builtin_amdgcn_readlane(sv, k);
        const unsigned char* ys = Y + (size_t)s * 1024;
#pragma unroll
        for (int i = 0; i < 4; ++i) yv[k][i] = *(const int*)(ys + i * 256 + lane * 4);
      }
#pragma unroll
      for (int k = 0; k < 6; ++k) {
        const float w = __int_as_float(__builtin_amdgcn_readlane(__float_as_int(wv), k));
#pragma unroll
        for (int i = 0; i < 4; ++i) {
          const fl2v lo = __builtin_amdgcn_cvt_pk_f32_fp8(yv[k][i], false), hi = __builtin_amdgcn_cvt_pk_f32_fp8(yv[k][i], true);
          f[i * 4] += w * lo[0]; f[i * 4 + 1] += w * lo[1]; f[i * 4 + 2] += w * hi[0]; f[i * 4 + 3] += w * hi[1]; }
      }
      const float* gt2 = ada + ((l - 1) * 3 + cv) * 6144 + 5 * 1024;
#pragma unroll
      for (int i = 0; i < 4; ++i) { const float4 g = *(const float4*)(gt2 + i * 256 + lane * 4);
        xv[i * 4] += g.x * f[i * 4]; xv[i * 4 + 1] += g.y * f[i * 4 + 1]; xv[i * 4 + 2] += g.z * f[i * 4 + 2]; xv[i * 4 + 3] += g.w * f[i * 4 + 3]; }
    }
    float ss = 0.f;
#pragma unroll
    for (int i = 0; i < 16; ++i) ss += xv[i] * xv[i];
    ss = wave_sum(ss, lane);
    const float rstd = rsqrtf(ss * (1.f / 1024.f) + EPS);
    if (l < DEPTH) {
      bf16_t* dst = X + (size_t)row * 1024;
#pragma unroll
      for (int i = 0; i < 4; ++i) { u32x2 o2; o2[0] = pack2(xv[i * 4], xv[i * 4 + 1]); o2[1] = pack2(xv[i * 4 + 2], xv[i * 4 + 3]); *(u32x2*)(dst + i * 256 + lane * 4) = o2; }
      const float* gn = p.g_norm1 + l * 1024;
      const float* sh = ada + (l * 3 + cv) * 6144;
      const float* sc = sh + 1024;
      bf16_t* hd = H1 + (size_t)row * 1024;
#pragma unroll
      for (int i = 0; i < 4; ++i) {
        const int o = i * 256 + lane * 4;
        const float4 g = *(const float4*)(gn + o), s1 = *(const float4*)(sh + o), s2 = *(const float4*)(sc + o);
        const float h0 = xv[i * 4] * rstd * g.x * (1.f + s2.x) + s1.x, h1 = xv[i * 4 + 1] * rstd * g.y * (1.f + s2.y) + s1.y;
        const float h2 = xv[i * 4 + 2] * rstd * g.z * (1.f + s2.z) + s1.z, h3 = xv[i * 4 + 3] * rstd * g.w * (1.f + s2.w) + s1.w;
        u32x2 o2; o2[0] = pack2(h0, h1); o2[1] = pack2(h2, h3);
        *(u32x2*)(hd + o) = o2;
      }
    } else if (!isctx) {
      float* dst = p.out + (size_t)row * 1024;
#pragma unroll
      for (int i = 0; i < 4; ++i) {
        const int o = i * 256 + lane * 4;
        const float4 g = *(const float4*)(p.g_final + o);
        *(float4*)(dst + o) = make_float4(xv[i * 4] * rstd * g.x, xv[i * 4 + 1] * rstd * g.y, xv[i * 4 + 2] * rstd * g.z, xv[i * 4 + 3] * rstd * g.w);
      }
    }
  }
}

#define EPI_ROW_BEGIN \
  _Pragma("unroll") for (int m = 0; m < 4; ++m) { \
    int row = m0 + wr * 64 + m * 16 + fr; asm volatile("" : "+v"(row)); \
    int b, isctx, t; tokinfo(row, b, isctx, t); const int kidx = isctx ? SEQ + t : t; (void)kidx;
#define EPI_ROW_END }
DI f32x4 rope4(const f32x4& v, int c4, int half, int t, const float2* roper, const float2* ropec) {
  f32x4 r;
#pragma unroll
  for (int j = 0; j < 4; ++j) { const float partner = xhalf_get(v[j], c4 >> 3); r[j] = rope_apply(v[j], partner, c4 + j, half, t, roper, ropec); }
  return r;
}
DI void phase_proj(const Params& p, char* lds) {
  GPTR wsg_ = (GPTR)p.ws; asm volatile("" : "+s"(wsg_)); char* ws = (char*)wsg_;
  const float2* roper = (const float2*)(ws + O_ROPER);
  const float2* ropec = (const float2*)(ws + O_ROPEC);
  const UM um(130, 9);
  int mt, ntile;
  for (int k = 0; um.get(k, mt, ntile); ++k) {
    const int m0 = mt * 256, n0 = ntile * 256;
    f32x4 acc[2][2][4][2]; zero_acc8(acc);
    asm volatile("s_waitcnt vmcnt(0)" ::: "memory");
    gemm8<false>(acc, (const bf16_t*)(ws + O_H1), nullptr, m0, (const bf16_t*)(ws + O_WIN) + (size_t)n0 * 1024, (const bf16_t*)(ws + O_WIN) + (size_t)(n0 + 128) * 1024, 1024, lds);
    const int tid = otid(), lane = tid & 63, wid = tid >> 6, wr = wid >> 2, wc = wid & 3, fr = lane & 15, fq = lane >> 4, c4 = fq * 4;
#define EPI8_BEGIN \
    _Pragma("unroll") for (int ai = 0; ai < 2; ++ai) _Pragma("unroll") for (int m = 0; m < 4; ++m) { \
      int row = m0 + ai * 128 + wr * 64 + m * 16 + fr; asm volatile("" : "+v"(row)); \
      int b, isctx, t; tokinfo(row, b, isctx, t); const int kidx = isctx ? SEQ + t : t; (void)kidx; \
      _Pragma("unroll") for (int n = 0; n < 2; ++n) { const int c16 = cb + wc * 32 + n * 16; const f32x4 v = acc[ai][bj][m][n];
#define EPI8_END } }
#pragma unroll
    for (int bj = 0; bj < 2; ++bj) {
      const int cb = n0 + bj * 128, ont = cb >> 7;
      if (ont < 6) {
        const int which = cb >> 8;
        bf16_t* dst = (bf16_t*)(ws + (which == 0 ? O_QN : (which == 1 ? O_KN : O_VN)));
        const float sc = which == 0 ? NA_QS : 1.f;
        EPI8_BEGIN
          const int head = (c16 >> 6) & 3, d = (c16 & 63) + c4;
          bf16_t* hb = dst + (size_t)(b * 4 + head) * KLEN * 64;
          const size_t off = which == 0 ? (size_t)kidx * 64 + d : (which == 1 ? kimg<64>(kidx, d) : vimg(kidx, d));
          *(u32x2*)(hb + off) = pack4(v * sc);
        EPI8_END
      } else if (ont < 10) {
        const int isk = ont >= 8;
        bf16_t *QdL = (bf16_t*)(ws + O_QDL), *QdR = (bf16_t*)(ws + O_QDR), *Kd = (bf16_t*)(ws + O_KD);
        EPI8_BEGIN
          const int cc = c16 - (isk ? 1024 : 768), head8 = cc >> 5, half = (cc >> 4) & 1, d = half * 16 + c4;
          const f32x4 rv = rope4(v, c4, half, t, roper, ropec);
          if (!isk) {
            *(u32x2*)(QdR + ((size_t)(b * 8 + head8) * KLEN + kidx) * 32 + d) = pack4(v * DIFF_QS);
            if (!isctx) *(u32x2*)(QdL + ((size_t)(b * 8 + head8) * SEQ + t) * 32 + d) = pack4(rv * DIFF_QS);
          } else {
            *(u32x2*)(Kd + (size_t)(b * 8 + head8) * KLEN * 32 + kimg<32>(kidx, d)) = pack4(isctx ? v : rv);
          }
        EPI8_END
      } else if (ont < 12) {
        bf16_t* Vd = (bf16_t*)(ws + O_VD);
        EPI8_BEGIN
          const int cc = c16 - 1280, head = cc >> 6, d = (cc & 63) + c4;
          *(u32x2*)(Vd + (size_t)(b * 4 + head) * KLEN * 64 + vimg(kidx, d)) = pack4(v);
        EPI8_END
      } else if (ont < 15) {
        bf16_t* dst = ont < 14 ? (bf16_t*)(ws + O_CQ) : (bf16_t*)(ws + O_CKV);
        const int ldd = ont < 14 ? 256 : 128, base = ont < 14 ? 1536 : 1792;
        EPI8_BEGIN
          *(u32x2*)(dst + (size_t)row * ldd + (c16 - base) + c4) = pack4(v);
        EPI8_END
      } else {
        bf16_t *Km = (bf16_t*)(ws + O_KM), *Uc = (bf16_t*)(ws + O_UCAT);
        EPI8_BEGIN
          if (c16 < 1952) {
            const int half = ((c16 - 1920) >> 4) & 1, d = half * 16 + c4;
            const f32x4 rv = rope4(v, c4, half, t, roper, ropec);
            const u32x2 o = pack4(isctx ? v : rv);
#pragma unroll
            for (int h = 0; h < 4; ++h) *(u32x2*)(Km + (size_t)(b * 4 + h) * KLEN * 96 + kimg<96>(kidx, 64 + d)) = o;
          } else if (c16 < 2208) {
            const int g = (c16 - 1952) >> 4;
            const int sp = isctx ? t : 256 + t;
            *(u32x2*)(Uc + ((size_t)(g * 520 + b * NCHUNK + (sp >> 6)) * 1280) + (sp & 63) * 16 + c4) = pack4(v);
          }
        EPI8_END
      }
    }
#undef EPI8_BEGIN
#undef EPI8_END
  }
}

template <int NI>
DI void row_scales(const bf16_t* A, int row0, int kd, float* rs, int lane) {
  const int r_ = lane >> 2, q_ = lane & 3;
  u32x4 v[2][NI];
#pragma unroll
  for (int ps = 0; ps < 2; ++ps)
#pragma unroll
    for (int i = 0; i < NI; ++i) v[ps][i] = *(const u32x4*)(A + (size_t)(row0 + ps * 16 + r_) * kd + (i * 4 + q_) * 8);
#pragma unroll
  for (int ps = 0; ps < 2; ++ps) {
    float s = 0.f;
#pragma unroll
    for (int i = 0; i < NI; ++i)
#pragma unroll
      for (int e = 0; e < 4; ++e) { const float a = __uint_as_float(v[ps][i][e] << 16), b_ = __uint_as_float(v[ps][i][e] & 0xffff0000u); s += a * a; s += b_ * b_; }
    s += bperm(s, lane ^ 1); s += bperm(s, lane ^ 2);
    if (q_ == 0) rs[ps * 16 + r_] = rsqrtf(s / (float)kd + EPS);
  }
}
DI void phase_up(const Params& p, char* lds) {
  GPTR wsg_ = (GPTR)p.ws; asm volatile("" : "+s"(wsg_)); char* ws = (char*)wsg_;
  const int tid = otid(), lane = tid & 63, wid = tid >> 6, wr = wid >> 1, wc = wid & 1, fr = lane & 15, fq = lane >> 4, c4 = fq * 4;
  const float2* roper = (const float2*)(ws + O_ROPER);
  const float2* ropec = (const float2*)(ws + O_ROPEC);
  const bf16_t *CQ = (const bf16_t*)(ws + O_CQ), *CKV = (const bf16_t*)(ws + O_CKV);
  bf16_t *QmL = (bf16_t*)(ws + O_QML), *QmR = (bf16_t*)(ws + O_QMR), *Km = (bf16_t*)(ws + O_KM), *Vm = (bf16_t*)(ws + O_VM);
  float* rs = (float*)(lds + GEMM_LDS);
  auto job = [&](int u) {
    if (u < 390) return gj_make(CQ, nullptr, 256, (u / 3) * 256, (const bf16_t*)(ws + O_WUQ), 256, (u % 3) * 128, 256);
    if (u < 910) { const int uu = u - 390; return gj_make(CKV, nullptr, 128, (uu / 4) * 256, (const bf16_t*)(ws + O_WUKV), 128, (uu % 4) * 128, 128); }
    if (u < 1006) { const int uu = u - 910, g = uu / 6; return gj_make((const bf16_t*)(ws + O_UCAT) + (size_t)g * 520 * 1280, nullptr, 1280, ((uu % 6) >> 1) * 256, (const bf16_t*)(ws + O_S5B1) + (size_t)g * 256 * 1024, 1024, (uu & 1) * 128, 1024); }
    return gj_none();
  };
  GStream<GNST> gs; gs.start(job(blockIdx.x), lds, tid);
  for (int u = blockIdx.x; u < 1006; u += gridDim.x) {
    f32x4 acc[4][4]; zero_acc(acc);
    if (u < 910) {
      const bool isq = u < 390;
      const int uu = isq ? u : u - 390;
      const int mt = isq ? uu / 3 : uu / 4, ntile = isq ? uu % 3 : uu % 4, m0 = mt * 256, n0 = ntile * 128;
      const int kd = isq ? 256 : 128;
      const bf16_t* A = isq ? CQ : CKV;
      if (isq) row_scales<8>(A, m0 + wid * 32, 256, rs + wid * 32, lane); else row_scales<4>(A, m0 + wid * 32, 128, rs + wid * 32, lane);
      gs.run2(acc, job(u + gridDim.x));
#pragma unroll
      for (int m = 0; m < 4; ++m) {
        int lr = wr * 64 + m * 16 + fr;
        asm volatile("" : "+v"(lr));
        const int row = m0 + lr;
        int b, isctx, t; tokinfo(row, b, isctx, t);
        const int kidx = isctx ? SEQ + t : t;
        const float rsc = rs[lr];
#pragma unroll
        for (int n = 0; n < 4; ++n) {
          const int c16 = n0 + wc * 64 + n * 16;
          if (isq) {
            const int head = c16 / 96, dd = c16 % 96, d = dd + c4;
            const f32x4 v = acc[m][n] * (rsc * MLA_QS);
            bf16_t* qr_ = QmR + ((size_t)(b * 4 + head) * KLEN + kidx) * 96 + d;
            bf16_t* ql_ = QmL + ((size_t)(b * 4 + head) * SEQ + t) * 96 + d;
            if (dd < 64) {
              const u32x2 o = pack4(v);
              *(u32x2*)qr_ = o;
              if (!isctx) *(u32x2*)ql_ = o;
            } else {
              const f32x4 rv = rope4(v, c4, (dd >> 4) & 1, t, roper, ropec);
              *(u32x2*)qr_ = pack4(v);
              if (!isctx) *(u32x2*)ql_ = pack4(rv);
            }
          } else {
            const int head = c16 >> 7, dd = c16 & 127, d = dd + c4;
            const f32x4 v = acc[m][n] * rsc;
            if (dd < 64) *(u32x2*)(Km + (size_t)(b * 4 + head) * KLEN * 96 + kimg<96>(kidx, d)) = pack4(v);
            else *(u32x2*)(Vm + (size_t)(b * 4 + head) * KLEN * 64 + vimg(kidx, d - 64)) = pack4(v);
          }
        }
      }
      asm volatile("s_waitcnt lgkmcnt(0)" ::: "memory"); __builtin_amdgcn_s_barrier();
    } else {
      const int uu = u - 910, g = uu / 6, mt = (uu % 6) >> 1, ntile = uu & 1, m0 = mt * 256, n0 = ntile * 128;
      gs.run2(acc, job(u + gridDim.x));
      float* sloc = (float*)(ws + O_SLOC) + (size_t)g * 520 * 256;
#pragma unroll
      for (int m = 0; m < 4; ++m) {
        const int row = m0 + wr * 64 + m * 16 + fr;
        if (row < 520) {
#pragma unroll
          for (int n = 0; n < 4; ++n) *(f32x4*)(sloc + (size_t)row * 256 + n0 + wc * 64 + n * 16 + c4) = acc[m][n];
        }
      }
    }
  }
}

constexpr int ATT_NST = 4, ATT_STG = 20480, ATT_RPB = ATT_NST * ATT_STG, ATT_LDS = ATT_RPB + 2048;
template <int DK, int NMAP, int MODE, bool FAST>
DI void attn_unit(const bf16_t* const (&Qlat)[NMAP], const bf16_t* const (&Qraw)[NMAP], const bf16_t* const (&Kp)[NMAP], const bf16_t* Vp,
                  int qb, char* lds, float (&lout)[NMAP], f32x16 (&o)[NMAP][2], const float* rpbL) {
  constexpr int KS = DK / 16, KMAP = DK * 128, KBYTES = NMAP * KMAP;
  constexpr int NPOS = KBYTES / 16, KR = (NPOS + NTHR - 1) / NTHR, LPS = KR + 1;
  const int tid = otid(), lane = tid & 63, wid = tid >> 6, r32 = lane & 31, hi = lane >> 5;
  const int qrow = (MODE == 2 ? SEQ : qb * 256) + wid * 32 + r32;
  bf16x8 qf[NMAP][KS];
#pragma unroll
  for (int m = 0; m < NMAP; ++m)
#pragma unroll
    for (int s = 0; s < KS; ++s) qf[m][s] = *(const bf16x8*)((MODE == 0 ? Qlat[m] : Qraw[m]) + (size_t)qrow * DK + s * 16 + hi * 8);
  float mrun[NMAP], lrun[NMAP];
#pragma unroll
  for (int m = 0; m < NMAP; ++m) { mrun[m] = -1e30f; lrun[m] = 0.f; o[m][0] = f32x16{}; o[m][1] = f32x16{}; }
  int kt_lo = 0, kt_hi = 260;
  const int rq = qb * 4 + (wid >> 1), cq = (wid & 1) * 32 + r32;
  if (MODE == 1) { int lo = qb * 4 - 4; lo = lo < 0 ? 0 : (lo > 248 ? 248 : lo); int hi_ = qb * 4 + 3 - 4; hi_ = hi_ < 0 ? 0 : (hi_ > 248 ? 248 : hi_); kt_lo = lo; kt_hi = hi_ + 8; }
  if (MODE == 2) { kt_lo = 256; kt_hi = 260; }
  const int ntile = (MODE == 1) ? (kt_hi - kt_lo + 4) : (kt_hi - kt_lo);
  auto tile_of = [&](int i) { return (MODE == 1 && i >= kt_hi - kt_lo) ? 256 + (i - (kt_hi - kt_lo)) : kt_lo + i; };
  const bf16_t* ksrc[KR];
  int kdst[KR];
#pragma unroll
  for (int i = 0; i < KR; ++i) {
    int q = tid + i * NTHR; if (q >= NPOS) q -= NTHR;
    const int m = q / (KMAP / 16), w = q % (KMAP / 16);
    ksrc[i] = ((NMAP == 2 && m == 1) ? Kp[NMAP - 1] : Kp[0]) + w * 8;
    kdst[i] = q * 16;
  }
  const bf16_t* vsrc = Vp + tid * 8;
  auto issue = [&](int i) {
    const int kt = tile_of(i);
    char* sb = lds + (i % ATT_NST) * ATT_STG;
#pragma unroll
    for (int r = 0; r < KR; ++r) glds16(ksrc[r] + (size_t)kt * 64 * DK, (unsigned)__builtin_amdgcn_readfirstlane((int)(unsigned)(uintptr_t)(sb + kdst[r])));
    glds16(vsrc + (size_t)kt * 4096, (unsigned)__builtin_amdgcn_readfirstlane((int)(unsigned)(uintptr_t)(sb + KBYTES + tid * 16)));
  };
  const int voff = KBYTES + ((lane >> 4) & 1) * 32 + (lane & 3) * 8 + (4 * hi + ((lane & 15) >> 2)) * 64;
#pragma unroll
  for (int m = 0; m < NMAP; ++m)
#pragma unroll
    for (int s = 0; s < KS; ++s) asm volatile("" :: "v"(qf[m][s]));
  asm volatile("s_waitcnt vmcnt(0)" ::: "memory");
#pragma unroll
  for (int i = 0; i < ATT_NST - 1; ++i) if (i < ntile) issue(i);
  auto step = [&](int it) {
    const int kt = tile_of(it);
    {
      const int infl = (ntile - 1 - it) < (ATT_NST - 2) ? (ntile - 1 - it) : (ATT_NST - 2);
      if (infl >= 2) { if (LPS == 2) asm volatile("s_waitcnt vmcnt(4)" ::: "memory"); else asm volatile("s_waitcnt vmcnt(6)" ::: "memory"); }
      else if (infl == 1) { if (LPS == 2) asm volatile("s_waitcnt vmcnt(2)" ::: "memory"); else asm volatile("s_waitcnt vmcnt(3)" ::: "memory"); }
      else asm volatile("s_waitcnt vmcnt(0)" ::: "memory");
    }
    __builtin_amdgcn_s_barrier();
    char* buf = lds + (it % ATT_NST) * ATT_STG;
    bool active = true;
    int dr = 0;
    if (MODE == 1 && kt < 256) { int rs_ = rq - 4; rs_ = rs_ < 0 ? 0 : (rs_ > 248 ? 248 : rs_); active = (kt >= rs_) && (kt < rs_ + 8); dr = kt - rq + 7; }
    if (!active) { if (it + ATT_NST - 1 < ntile) issue(it + ATT_NST - 1); }
    if (active) {
      const char* vp0 = buf + voff;
      bf16x8 pf[NMAP][4];
#pragma unroll
      for (int m = 0; m < NMAP; ++m) {
        f32x16 s0 = f32x16{}, s1 = f32x16{};
        const char* kb = buf + m * KMAP + hi * 1024 + r32 * 16;
#pragma unroll
        for (int s = 0; s < KS; ++s) {
          const bf16x8 k0 = *(const bf16x8*)(kb + s * 2048);
          const bf16x8 k1 = *(const bf16x8*)(kb + s * 2048 + 512);
          s0 = MFMA32(k0, qf[m][s], s0);
          s1 = MFMA32(k1, qf[m][s], s1);
        }
        if (MODE == 1 && kt < 256) {
          int cs = cq - 8; cs = cs < 0 ? 0 : (cs > 48 ? 48 : cs);
#pragma unroll
          for (int r = 0; r < 16; ++r) {
            const int ck0 = crow(r, hi), ck1 = 32 + ck0;
            s0[r] = (ck0 >= cs && ck0 < cs + 16) ? s0[r] + rpbL[dr * 31 + (ck0 - cq + 15)] : -1e30f;
            s1[r] = (ck1 >= cs && ck1 < cs + 16) ? s1[r] + rpbL[dr * 31 + (ck1 - cq + 15)] : -1e30f;
          }
        }
        float ps = 0.f;
        if (FAST) {
#pragma unroll
          for (int r = 0; r < 16; ++r) { s0[r] = __builtin_amdgcn_exp2f(s0[r]); s1[r] = __builtin_amdgcn_exp2f(s1[r]); ps += s0[r] + s1[r]; }
          lrun[m] += ps;
        } else {
          float mx = fmaxf(s0[0], s1[0]);
#pragma unroll
          for (int r = 1; r < 16; ++r) mx = fmaxf(mx, fmaxf(s0[r], s1[r]));
          mx = xhalf_max(mx);
          const float mnew = fmaxf(mrun[m], mx);
          const float alpha = __builtin_amdgcn_exp2f(mrun[m] - mnew);
          mrun[m] = mnew;
#pragma unroll
          for (int r = 0; r < 16; ++r) { s0[r] = __builtin_amdgcn_exp2f(s0[r] - mnew); s1[r] = __builtin_amdgcn_exp2f(s1[r] - mnew); ps += s0[r] + s1[r]; }
          lrun[m] = lrun[m] * alpha + ps;
#pragma unroll
          for (int r = 0; r < 16; ++r) { o[m][0][r] *= alpha; o[m][1][r] *= alpha; }
        }
#pragma unroll
        for (int ks = 0; ks < 4; ++ks) {
          u32x4 pk;
#pragma unroll
          for (int e = 0; e < 4; ++e) {
            const int r = (ks & 1) * 8 + e * 2;
            pk[e] = (ks < 2) ? pack2(s0[r], s0[r + 1]) : pack2(s1[r], s1[r + 1]);
          }
          pf[m][ks] = __builtin_bit_cast(bf16x8, pk);
        }
      }
      if (it + ATT_NST - 1 < ntile) issue(it + ATT_NST - 1);
#pragma unroll
      for (int d0 = 0; d0 < 2; ++d0) {
        bf16x8 vf[4];
#pragma unroll
        for (int ks = 0; ks < 4; ++ks) {
          const s16x4 lo = __builtin_bit_cast(s16x4, __builtin_amdgcn_ds_read_tr16_b64_v4i16((__attribute__((address_space(3))) v4i16_t*)(vp0 + d0 * 4096 + ks * 1024)));
          const s16x4 hh = __builtin_bit_cast(s16x4, __builtin_amdgcn_ds_read_tr16_b64_v4i16((__attribute__((address_space(3))) v4i16_t*)(vp0 + d0 * 4096 + ks * 1024 + 512)));
          vf[ks] = bf16x8{lo[0], lo[1], lo[2], lo[3], hh[0], hh[1], hh[2], hh[3]};
        }
#pragma unroll
        for (int m = 0; m < NMAP; ++m)
#pragma unroll
          for (int ks = 0; ks < 4; ++ks) o[m][d0] = MFMA32(vf[ks], pf[m][ks], o[m][d0]);
      }
    }
  };
  const int n1 = MODE == 0 ? 256 : ntile;
#pragma unroll 1
  for (int it = 0; it < n1; ++it) step(it);
  if (MODE == 0) {
#pragma unroll
    for (int m = 0; m < NMAP; ++m)
#pragma unroll
      for (int s = 0; s < KS; ++s) qf[m][s] = *(const bf16x8*)(Qraw[m] + (size_t)qrow * DK + s * 16 + hi * 8);
#pragma unroll
    for (int m = 0; m < NMAP; ++m)
#pragma unroll
      for (int s = 0; s < KS; ++s) asm volatile("" :: "v"(qf[m][s]));
#pragma unroll 1
    for (int it = 256; it < ntile; ++it) step(it);
  }
#pragma unroll
  for (int m = 0; m < NMAP; ++m) lout[m] = xhalf(lrun[m]);
  __syncthreads();
}
DI bool lsum_bad(float l) { return !(l > 1e-18f && l < 1e18f); }
DI bool block_any(bool v, char* lds) {
  volatile LAS int* flg = (volatile LAS int*)(lds + ATT_RPB + 2032);
  if (otid() == 0) *flg = 0;
  __syncthreads();
  if (v) *flg = 1;
  __syncthreads();
  const int r = *flg;
  __syncthreads();
  return r != 0;
}

DI void attn_store(const float (&val)[2][16], bf16_t* ycat, int token, int colbase, int hi) {
#pragma unroll
  for (int d0 = 0; d0 < 2; ++d0)
#pragma unroll
    for (int g = 0; g < 4; ++g) {
      u32x2 v; v[0] = pack2(val[d0][4 * g], val[d0][4 * g + 1]); v[1] = pack2(val[d0][4 * g + 2], val[d0][4 * g + 3]);
      *(u32x2*)(ycat + (size_t)token * 1024 + colbase + d0 * 32 + 8 * g + 4 * hi) = v;
    }
}

template <int MODE>
DI void attn_diff(const Params& p, int l, int b, int h, int qb, char* lds) {
  GPTR wsg_ = (GPTR)p.ws; asm volatile("" : "+s"(wsg_)); char* ws = (char*)wsg_;
  const bf16_t* const ql[2] = {(const bf16_t*)(ws + O_QDL) + (size_t)(b * 8 + 2 * h) * SEQ * 32, (const bf16_t*)(ws + O_QDL) + (size_t)(b * 8 + 2 * h + 1) * SEQ * 32};
  const bf16_t* const qr[2] = {(const bf16_t*)(ws + O_QDR) + (size_t)(b * 8 + 2 * h) * KLEN * 32, (const bf16_t*)(ws + O_QDR) + (size_t)(b * 8 + 2 * h + 1) * KLEN * 32};
  const bf16_t* const kp[2] = {(const bf16_t*)(ws + O_KD) + (size_t)(b * 8 + 2 * h) * KLEN * 32, (const bf16_t*)(ws + O_KD) + (size_t)(b * 8 + 2 * h + 1) * KLEN * 32};
  const bf16_t* vp = (const bf16_t*)(ws + O_VD) + (size_t)(b * 4 + h) * KLEN * 64;
  float lo[2]; f32x16 o[2][2];
  attn_unit<32, 2, MODE, true>(ql, qr, kp, vp, qb, lds, lo, o, nullptr);
  if (block_any(lsum_bad(lo[0]) || lsum_bad(lo[1]), lds)) attn_unit<32, 2, MODE, false>(ql, qr, kp, vp, qb, lds, lo, o, nullptr);
  const int tid_ = otid(), lane = tid_ & 63, wid = tid_ >> 6, r32 = lane & 31, hi = lane >> 5;
  int lq = l; asm volatile("" : "+s"(lq));
  const float lam = ((const float*)(ws + O_LAMF))[lq];
  const float lam_init = 0.8f - 0.6f * expf(-0.3f * (float)lq);
  const float i0 = 1.f / lo[0], i1 = lam / lo[1];
  float d[2][16]; float ss = 0.f;
#pragma unroll
  for (int d0 = 0; d0 < 2; ++d0)
#pragma unroll
    for (int r = 0; r < 16; ++r) { d[d0][r] = o[0][d0][r] * i0 - o[1][d0][r] * i1; ss += d[d0][r] * d[d0][r]; }
  ss = xhalf(ss);
  const float rstd = rsqrtf(ss * (1.f / 64.f) + EPS) * (1.f - lam_init);
  const float* gs = p.g_diff + lq * 64;
#pragma unroll
  for (int d0 = 0; d0 < 2; ++d0)
#pragma unroll
    for (int r = 0; r < 16; ++r) d[d0][r] *= rstd * gs[d0 * 32 + crow(r, hi)];
  const int token = MODE == 2 ? NL + b * 256 + wid * 32 + r32 : b * SEQ + qb * 256 + wid * 32 + r32;
  attn_store(d, (bf16_t*)(ws + O_YCAT), token, 256 + h * 64, hi);
}
template <int MODE>
DI void attn_mla(const Params& p, int b, int h, int qb, char* lds) {
  GPTR wsg_ = (GPTR)p.ws; asm volatile("" : "+s"(wsg_)); char* ws = (char*)wsg_;
  const bf16_t* const ql[1] = {(const bf16_t*)(ws + O_QML) + (size_t)(b * 4 + h) * SEQ * 96};
  const bf16_t* const qr[1] = {(const bf16_t*)(ws + O_QMR) + (size_t)(b * 4 + h) * KLEN * 96};
  const bf16_t* const kp[1] = {(const bf16_t*)(ws + O_KM) + (size_t)(b * 4 + h) * KLEN * 96};
  const bf16_t* vp = (const bf16_t*)(ws + O_VM) + (size_t)(b * 4 + h) * KLEN * 64;
  float lo[1]; f32x16 o[1][2];
  attn_unit<96, 1, MODE, true>(ql, qr, kp, vp, qb, lds, lo, o, nullptr);
  if (block_any(lsum_bad(lo[0]), lds)) attn_unit<96, 1, MODE, false>(ql, qr, kp, vp, qb, lds, lo, o, nullptr);
  const int tid_ = otid(), lane = tid_ & 63, wid = tid_ >> 6, r32 = lane & 31, hi = lane >> 5;
  const float inv = 1.f / lo[0];
  float d[2][16];
#pragma unroll
  for (int d0 = 0; d0 < 2; ++d0)
#pragma unroll
    for (int r = 0; r < 16; ++r) d[d0][r] = o[0][d0][r] * inv;
  const int token = MODE == 2 ? NL + b * 256 + wid * 32 + r32 : b * SEQ + qb * 256 + wid * 32 + r32;
  attn_store(d, (bf16_t*)(ws + O_YCAT), token, 512 + h * 64, hi);
}
template <int MODE>
DI void attn_na(const Params& p, int l, int b, int h, int qb, char* lds) {
  GPTR wsg_ = (GPTR)p.ws; asm volatile("" : "+s"(wsg_)); char* ws = (char*)wsg_;
  float* rpbL = (float*)(lds + ATT_RPB);
  if (MODE == 1) {
    __syncthreads();
    for (int i = otid(); i < 465; i += NTHR) rpbL[i] = p.na_rpb[(size_t)(l * 4 + h) * 465 + i] * LOG2E;
    __syncthreads();
  }
  const bf16_t* const qr[1] = {(const bf16_t*)(ws + O_QN) + (size_t)(b * 4 + h) * KLEN * 64};
  const bf16_t* const kp[1] = {(const bf16_t*)(ws + O_KN) + (size_t)(b * 4 + h) * KLEN * 64};
  const bf16_t* vp = (const bf16_t*)(ws + O_VN) + (size_t)(b * 4 + h) * KLEN * 64;
  float lo[1]; f32x16 o[1][2];
  attn_unit<64, 1, MODE, true>(qr, qr, kp, vp, qb, lds, lo, o, rpbL);
  if (block_any(lsum_bad(lo[0]), lds)) attn_unit<64, 1, MODE, false>(qr, qr, kp, vp, qb, lds, lo, o, rpbL);
  const int tid_ = otid(), lane = tid_ & 63, wid = tid_ >> 6, r32 = lane & 31, hi = lane >> 5;
  const float inv = 1.f / lo[0];
  float d[2][16];
#pragma unroll
  for (int d0 = 0; d0 < 2; ++d0)
#pragma unroll
    for (int r = 0; r < 16; ++r) d[d0][r] = o[0][d0][r] * inv;
  const int token = MODE == 2 ? NL + b * 256 + wid * 32 + r32 : b * SEQ + qb * 256 + wid * 32 + r32;
  attn_store(d, (bf16_t*)(ws + O_YCAT), token, h * 64, hi);
}

DI void phase_attn(const Params& p, int l, char* lds) {
  GPTR wsg_ = (GPTR)p.ws; asm volatile("" : "+s"(wsg_)); char* ws = (char*)wsg_;
  if (blockIdx.x < 8) {
    const int id = blockIdx.x * NTHR + otid();
    const int pp = id & 63, d = (id >> 6) & 1, g = (id >> 7) & 15, b = id >> 11;
    const float2 a64 = ((const float2*)(ws + O_S5PW))[((((size_t)l * 2 + d) * 16 + g) * 65 + 64) * 64 + pp];
    const float* sloc = (const float*)(ws + O_SLOC) + ((size_t)g * 520 + b * NCHUNK) * 256 + d * 128 + pp;
    bf16_t* uc = (bf16_t*)(ws + O_UCAT) + ((size_t)g * 520 + b * NCHUNK) * 1280 + 1024 + d * 128 + pp;
    float hr = 0.f, hi_ = 0.f;
#pragma unroll 1
    for (int s0 = 0; s0 < NCHUNK; s0 += 26) {
      float sr[26], si[26];
#pragma unroll
      for (int j = 0; j < 26; ++j) { const int s = s0 + j, c = d == 0 ? s : (s < 4 ? 3 - s : 263 - s); sr[j] = sloc[(size_t)c * 256]; si[j] = sloc[(size_t)c * 256 + 64]; }
#pragma unroll
      for (int j = 0; j < 26; ++j) {
        const int s = s0 + j, c = d == 0 ? s : (s < 4 ? 3 - s : 263 - s);
        uc[(size_t)c * 1280] = f2bf(hr); uc[(size_t)c * 1280 + 64] = f2bf(hi_);
        const float nr = a64.x * hr - a64.y * hi_ + sr[j], ni = a64.x * hi_ + a64.y * hr + si[j];
        hr = nr; hi_ = ni;
      }
    }
  }
  int x = blockIdx.x & 7; asm volatile("" : "+s"(x));
  const int b = x >> 2, h = x & 3;
  int* qctr = (int*)(ws + O_QCTR) + x * 64;
  volatile LAS int* qw = (volatile LAS int*)(lds + ATT_RPB + 2040);
#pragma unroll 1
  for (;;) {
    if (otid() == 0) *qw = atomicAdd(qctr, 1);
    __syncthreads();
    const int item = *qw;
    __syncthreads();
    if (item >= 195) break;
    if (item < 64) attn_diff<0>(p, l, b, h, item, lds);
    else if (item < 128) attn_mla<0>(p, b, h, item - 64, lds);
    else if (item < 192) attn_na<1>(p, l, b, h, item - 128, lds);
    else if (item == 192) attn_diff<2>(p, l, b, h, 0, lds);
    else if (item == 193) attn_mla<2>(p, b, h, 0, lds);
    else attn_na<2>(p, l, b, h, 0, lds);
  }
}

DI void phase_s5out(const Params& p, char* lds) {
  GPTR wsg_ = (GPTR)p.ws; asm volatile("" : "+s"(wsg_)); char* ws = (char*)wsg_;
  bf16_t* G5 = (bf16_t*)(ws + O_G5);
  const UM um(48, 4);
  int gm, ntile;
  for (int k = 0; um.get(k, gm, ntile); ++k) {
    const int g = gm / 3, m0 = (gm % 3) * 256, n0 = ntile * 256;
    f32x4 acc[2][2][4][2]; zero_acc8(acc);
    asm volatile("s_waitcnt vmcnt(0)" ::: "memory");
    const bf16_t* bw = (const bf16_t*)(ws + O_S5B2) + ((size_t)g * 1024 + n0) * 1280;
    gemm8<false>(acc, (const bf16_t*)(ws + O_UCAT) + (size_t)g * 520 * 1280, nullptr, m0, bw, bw + (size_t)128 * 1280, 1280, lds);
    const int tid = otid(), lane = tid & 63, wid = tid >> 6, wr = wid >> 2, wc = wid & 3, fr = lane & 15, fq = lane >> 4, c4 = fq * 4;
#pragma unroll
    for (int ai = 0; ai < 2; ++ai)
#pragma unroll
      for (int m = 0; m < 4; ++m) {
        int row = m0 + ai * 128 + wr * 64 + m * 16 + fr; asm volatile("" : "+v"(row));
        if (row < 520) {
          const int b = row >= NCHUNK ? 1 : 0, chunk = row - b * NCHUNK;
#pragma unroll
          for (int bj = 0; bj < 2; ++bj)
#pragma unroll
            for (int n = 0; n < 2; ++n) {
              const int sp = chunk * 64 + ((n0 + bj * 128 + wc * 32) >> 4) + n;
              const int token = sp < 256 ? NL + b * 256 + sp : b * SEQ + sp - 256;
              f32x4 v = acc[ai][bj][m][n];
#pragma unroll
              for (int j = 0; j < 4; ++j) v[j] = gelu_tanh(v[j]);
              *(u32x2*)(G5 + (size_t)token * 256 + g * 16 + c4) = pack4(v);
            }
        }
      }
  }
}
DI void phase_glu(const Params& p, int l, char* lds) {
  GPTR wsg_ = (GPTR)p.ws; asm volatile("" : "+s"(wsg_)); char* ws = (char*)wsg_;
  const int tid = otid(), lane = tid & 63, wid = tid >> 6, wr = wid >> 1, wc = wid & 1, fr = lane & 15, fq = lane >> 4, c4 = fq * 4;
  const bf16_t* G5 = (const bf16_t*)(ws + O_G5);
  bf16_t* Yc = (bf16_t*)(ws + O_YCAT);
  const UM um(128, 2);
  auto job = [&](int k) { int mt, nt; return um.get(k, mt, nt) ? gj_make(G5, nullptr, 256, mt * 256, (const bf16_t*)(ws + O_WGLU), 256, nt * 128, 256) : gj_none(); };
  GStream<GNST> gs; gs.start(job(0), lds, tid);
  int mt, ntile;
  for (int k = 0; um.get(k, mt, ntile); ++k) {
    const int m0 = mt * 256, n0 = ntile * 128;
    f32x4 acc[4][4]; zero_acc(acc);
    gs.run2(acc, job(k + 1));
    u32x2 gqa[4][4];
#pragma unroll
    for (int m = 0; m < 4; ++m)
#pragma unroll
      for (int n = 0; n < 4; ++n) gqa[m][n] = *(const u32x2*)(G5 + (size_t)(m0 + wr * 64 + m * 16 + fr) * 256 + n0 + wc * 64 + n * 16 + c4);
#pragma unroll
    for (int m = 0; m < 4; ++m) {
      const int row = m0 + wr * 64 + m * 16 + fr;
#pragma unroll
      for (int n = 0; n < 4; ++n) {
        const int col = n0 + wc * 64 + n * 16 + c4;
        const u32x2 gq = gqa[m][n];
        const float4 bb = *(const float4*)(p.b_glu + l * 256 + col);
        f32x4 o;
        o[0] = __uint_as_float(gq[0] << 16) * sigm(acc[m][n][0] + bb.x);
        o[1] = __uint_as_float(gq[0] & 0xffff0000u) * sigm(acc[m][n][1] + bb.y);
        o[2] = __uint_as_float(gq[1] << 16) * sigm(acc[m][n][2] + bb.z);
        o[3] = __uint_as_float(gq[1] & 0xffff0000u) * sigm(acc[m][n][3] + bb.w);
        *(u32x2*)(Yc + (size_t)row * 1024 + 768 + col) = pack4(o);
      }
    }
  }
  {
    const int t2 = otid(), ln = t2 & 63, wv = t2 >> 6;
    for (int w = blockIdx.x * 8 + wv; w < 512; w += gridDim.x * 8) {
      const int row0 = NL + (w >> 4) * 16, col = (w & 15) * 16 + (ln & 15);
      f32x4 a4 = f32x4{0.f, 0.f, 0.f, 0.f};
      mini_gemm16(a4, G5 + (size_t)row0 * 256, 256, (const bf16_t*)(ws + O_WGLU) + (size_t)(w & 15) * 16 * 256, 256, 256, ln);
      const float bb = p.b_glu[l * 256 + col];
#pragma unroll
      for (int j = 0; j < 4; ++j) {
        const int row = row0 + 4 * (ln >> 4) + j;
        Yc[(size_t)row * 1024 + 768 + col] = f2bf(bf2f(G5[(size_t)row * 256 + col]) * sigm(a4[j] + bb));
      }
    }
  }
}
DI void phase_merge(const Params& p, char* lds) {
  GPTR wsg_ = (GPTR)p.ws; asm volatile("" : "+s"(wsg_)); char* ws = (char*)wsg_;
  const int tid = otid(), lane = tid & 63, wid = tid >> 6, wr = wid >> 1, wc = wid & 1, fr = lane & 15, fq = lane >> 4, c4 = fq * 4;
  bf16_t* Mb = (bf16_t*)(ws + O_MBUF);
  const UM um(128, 8);
  auto job = [&](int seq) {
    const int i = (seq >> 1) & 3; int mt_, nt_;
    if (!um.get(seq >> 3, mt_, nt_)) return gj_none();
    const int m0 = mt_ * 256, n0 = nt_ * 128;
    if (seq & 1) return gj_make((const bf16_t*)(ws + O_H1), nullptr, 1024, m0, (const bf16_t*)(ws + O_WG) + (size_t)i * 1024 * 1024, 1024, n0, 1024);
    return gj_make((const bf16_t*)(ws + O_YCAT) + i * 256, nullptr, 1024, m0, (const bf16_t*)(ws + O_WBR) + (size_t)i * 262144, 256, n0, 256);
  };
  GStream<GNST> gs; gs.start(job(0), lds, tid);
  int seq = 0, mt, ntile;
  for (int k = 0; um.get(k, mt, ntile); ++k) {
    const int m0 = mt * 256, n0 = ntile * 128;
    u32x2 mpk[4][4];
    for (int i = 0; i < 4; ++i) {
      u32x2 pk[4][4];
      {
        f32x4 acc[4][4]; zero_acc(acc);
        gs.run<true>(acc, job(seq + 1)); ++seq;
#pragma unroll
        for (int m = 0; m < 4; ++m)
#pragma unroll
          for (int n = 0; n < 4; ++n) pk[m][n] = pack4(acc[m][n]);
      }
      f32x4 acc[4][4]; zero_acc(acc);
      gs.run<true>(acc, job(seq + 1)); ++seq;
#pragma unroll
      for (int m = 0; m < 4; ++m)
#pragma unroll
        for (int n = 0; n < 4; ++n) {
          f32x4 t;
          t[0] = sigm(acc[m][n][0]) * __uint_as_float(pk[m][n][0] << 16);
          t[1] = sigm(acc[m][n][1]) * __uint_as_float(pk[m][n][0] & 0xffff0000u);
          t[2] = sigm(acc[m][n][2]) * __uint_as_float(pk[m][n][1] << 16);
          t[3] = sigm(acc[m][n][3]) * __uint_as_float(pk[m][n][1] & 0xffff0000u);
          if (i > 0) {
            t[0] += __uint_as_float(mpk[m][n][0] << 16); t[1] += __uint_as_float(mpk[m][n][0] & 0xffff0000u);
            t[2] += __uint_as_float(mpk[m][n][1] << 16); t[3] += __uint_as_float(mpk[m][n][1] & 0xffff0000u);
          }
          mpk[m][n] = pack4(t);
        }
    }
#pragma unroll
    for (int m = 0; m < 4; ++m) {
      const int row = m0 + wr * 64 + m * 16 + fr;
#pragma unroll
      for (int n = 0; n < 4; ++n) *(u32x2*)(Mb + (size_t)row * 1024 + n0 + wc * 64 + n * 16 + c4) = mpk[m][n];
    }
  }
  {
    const int t2 = otid(), lane = t2 & 63, wid = t2 >> 6;
    if (wid < 2) {
      for (int q = blockIdx.x * 2 + wid; q < 512; q += gridDim.x * 2) {
        const int row0 = NL + (q >> 5) * 32, col0 = (q & 31) * 32;
        f32x4 macc[2][2];
#pragma unroll
        for (int r = 0; r < 2; ++r)
#pragma unroll
          for (int c = 0; c < 2; ++c) macc[r][c] = f32x4{0.f, 0.f, 0.f, 0.f};
#pragma unroll 1
        for (int i = 0; i < 4; ++i) {
          f32x4 ab[2][2], ag[2][2];
#pragma unroll
          for (int r = 0; r < 2; ++r)
#pragma unroll
            for (int c = 0; c < 2; ++c) { ab[r][c] = f32x4{0.f, 0.f, 0.f, 0.f}; ag[r][c] = f32x4{0.f, 0.f, 0.f, 0.f}; }
          mini_gemm32(ab, (const bf16_t*)(ws + O_YCAT) + (size_t)row0 * 1024 + i * 256, 1024, (const bf16_t*)(ws + O_WBR) + (size_t)i * 262144 + (size_t)col0 * 256, 256, 256, lane);
          mini_gemm32(ag, (const bf16_t*)(ws + O_H1) + (size_t)row0 * 1024, 1024, (const bf16_t*)(ws + O_WG) + ((size_t)i * 1024 + col0) * 1024, 1024, 1024, lane);
#pragma unroll
          for (int r = 0; r < 2; ++r)
#pragma unroll
            for (int c = 0; c < 2; ++c)
#pragma unroll
              for (int j = 0; j < 4; ++j) macc[r][c][j] += sigm(ag[r][c][j]) * ab[r][c][j];
        }
#pragma unroll
        for (int r = 0; r < 2; ++r)
#pragma unroll
          for (int c = 0; c < 2; ++c)
#pragma unroll
            for (int j = 0; j < 4; ++j) Mb[(size_t)(row0 + r * 16 + 4 * (lane >> 4) + j) * 1024 + col0 + c * 16 + (lane & 15)] = f2bf(macc[r][c][j]);
      }
    }
  }
}
DI void phase_outproj(const Params& p, int l, char* lds, float rscale = 1.f) {
  GPTR wsg_ = (GPTR)p.ws; asm volatile("" : "+s"(wsg_)); char* ws = (char*)wsg_;
  bf16_t* X = (bf16_t*)(ws + O_X);
  const float* ada = (const float*)(ws + O_ADA);
  const UM um(128, 4);
  int mt, ntile;
  for (int k = 0; um.get(k, mt, ntile); ++k) {
    const int m0 = mt * 256, n0 = ntile * 256;
    f32x4 acc[2][2][4][2]; zero_acc8(acc);
    asm volatile("s_waitcnt vmcnt(0)" ::: "memory");
    gemm8<false>(acc, (const bf16_t*)(ws + O_MBUF), nullptr, m0, (const bf16_t*)(ws + O_WOUT) + (size_t)n0 * 1024, (const bf16_t*)(ws + O_WOUT) + (size_t)(n0 + 128) * 1024, 1024, lds);
    const int tid = otid(), lane = tid & 63, wid = tid >> 6, wr = wid >> 2, wc = wid & 3, fr = lane & 15, fq = lane >> 4;
    const int cv = m0 < NL ? (m0 >> 14) : 2;
    const float* gt = ada + (l * 3 + cv) * 6144 + 2 * 1024 + n0 + wc * 32 + fq * 4;
    float4 g[2][2];
#pragma unroll
    for (int bj = 0; bj < 2; ++bj)
#pragma unroll
      for (int n = 0; n < 2; ++n) g[bj][n] = *(const float4*)(gt + bj * 128 + n * 16);
#pragma unroll
    for (int ai = 0; ai < 2; ++ai) {
      u32x2 xo[4][2][2];
#pragma unroll
      for (int m = 0; m < 4; ++m)
#pragma unroll
        for (int bj = 0; bj < 2; ++bj)
#pragma unroll
          for (int n = 0; n < 2; ++n)
            xo[m][bj][n] = *(const u32x2*)(X + (size_t)(m0 + ai * 128 + wr * 64 + m * 16 + fr) * 1024 + n0 + bj * 128 + wc * 32 + n * 16 + fq * 4);
#pragma unroll
      for (int m = 0; m < 4; ++m)
#pragma unroll
        for (int bj = 0; bj < 2; ++bj)
#pragma unroll
          for (int n = 0; n < 2; ++n) {
            const u32x2 xv = xo[m][bj][n]; const f32x4 av = acc[ai][bj][m][n]; const float4 gg = g[bj][n];
            u32x2 xn;
            xn[0] = pack2(__uint_as_float(xv[0] << 16) + rscale * gg.x * av[0], __uint_as_float(xv[0] & 0xffff0000u) + rscale * gg.y * av[1]);
            xn[1] = pack2(__uint_as_float(xv[1] << 16) + rscale * gg.z * av[2], __uint_as_float(xv[1] & 0xffff0000u) + rscale * gg.w * av[3]);
            *(u32x2*)(X + (size_t)(m0 + ai * 128 + wr * 64 + m * 16 + fr) * 1024 + n0 + bj * 128 + wc * 32 + n * 16 + fq * 4) = xn;
          }
    }
  }
  const int tid = otid(), lane = tid & 63, wid = tid >> 6;
  (void)lane; (void)wid;
  {
    const int t2 = otid(), lane = t2 & 63, wid = t2 >> 6;
    if (wid < 2) {
      for (int q = blockIdx.x * 2 + wid; q < 512; q += gridDim.x * 2) {
        const int row0 = NL + (q >> 5) * 32, col0 = (q & 31) * 32;
        f32x4 acc[2][2];
#pragma unroll
        for (int r = 0; r < 2; ++r)
#pragma unroll
          for (int c = 0; c < 2; ++c) acc[r][c] = f32x4{0.f, 0.f, 0.f, 0.f};
        mini_gemm32(acc, (const bf16_t*)(ws + O_MBUF) + (size_t)row0 * 1024, 1024, (const bf16_t*)(ws + O_WOUT) + (size_t)col0 * 1024, 1024, 1024, lane);
        bf16_t xold[2][2][4];
#pragma unroll
        for (int r = 0; r < 2; ++r)
#pragma unroll
          for (int c = 0; c < 2; ++c)
#pragma unroll
            for (int j = 0; j < 4; ++j) xold[r][c][j] = X[(size_t)(row0 + r * 16 + 4 * (lane >> 4) + j) * 1024 + col0 + c * 16 + (lane & 15)];
#pragma unroll
        for (int c = 0; c < 2; ++c) {
          const float g = ada[(l * 3 + 2) * 6144 + 2 * 1024 + col0 + c * 16 + (lane & 15)];
#pragma unroll
          for (int r = 0; r < 2; ++r)
#pragma unroll
            for (int j = 0; j < 4; ++j) X[(size_t)(row0 + r * 16 + 4 * (lane >> 4) + j) * 1024 + col0 + c * 16 + (lane & 15)] = f2bf(bf2f(xold[r][c][j]) + rscale * g * acc[r][c][j]);
        }
      }
    }
  }
}
DI void phase_norm2(const Params& p, int l, char* lds) {
  GPTR wsg_ = (GPTR)p.ws; asm volatile("" : "+s"(wsg_)); char* ws = (char*)wsg_;
  const int tid = otid(), lane = tid & 63, w = tid >> 6, fr = lane & 15, fq = lane >> 4;
  const bf16_t* X = (const bf16_t*)(ws + O_X);
  bf16_t* H2 = (bf16_t*)(ws + O_H2);
  float* LG = (float*)(ws + O_LOGIT);
  const float* ada = (const float*)(ws + O_ADA);
  float* ssq = (float*)lds;
  float* red = (float*)(lds + 1024);
  float* tabG = (float*)(lds + 40960);
  float* tabS = tabG + 3072;
  for (int i = tid; i < 3072; i += NTHR) {
    const int cv_ = i >> 10, k_ = i & 1023;
    const float* a_ = ada + (l * 3 + cv_) * 6144 + 3 * 1024 + k_;
    tabG[i] = p.g_norm2[l * 1024 + k_] * (1.f + a_[1024]); tabS[i] = a_[0];
  }
  __syncthreads();
  const int kb = w * 128 + fq * 8;
  bf16x8 bh[4][4], bl[4][4];
#pragma unroll
  for (int e = 0; e < 4; ++e)
#pragma unroll
    for (int s_ = 0; s_ < 4; ++s_) {
      const size_t off = (size_t)(e * 16 + fr) * 1024 + kb + s_ * 32;
      bh[e][s_] = *(const bf16x8*)((const bf16_t*)(ws + O_WRHI) + off);
      bl[e][s_] = *(const bf16x8*)((const bf16_t*)(ws + O_WRLO) + off);
    }
  const int ng = NTOK / 16;
  u32x4 xn[4];
  if ((int)blockIdx.x < ng) {
#pragma unroll
    for (int s_ = 0; s_ < 4; ++s_) xn[s_] = *(const u32x4*)(X + (size_t)(blockIdx.x * 16 + fr) * 1024 + kb + s_ * 32);
  }
#pragma unroll 1
  for (int gi = blockIdx.x; gi < ng; gi += gridDim.x) {
    const int row0 = gi * 16, row = row0 + fr, cv = row0 < NL ? (row0 >> 14) : 2;
    u32x4 xr[4];
#pragma unroll
    for (int s_ = 0; s_ < 4; ++s_) xr[s_] = xn[s_];
    if (gi + (int)gridDim.x < ng) {
#pragma unroll
      for (int s_ = 0; s_ < 4; ++s_) xn[s_] = *(const u32x4*)(X + (size_t)((gi + gridDim.x) * 16 + fr) * 1024 + kb + s_ * 32);
    }
    float ss = 0.f;
#pragma unroll
    for (int s_ = 0; s_ < 4; ++s_)
#pragma unroll
      for (int j = 0; j < 4; ++j) { const float a0 = __uint_as_float(xr[s_][j] << 16), a1 = __uint_as_float(xr[s_][j] & 0xffff0000u); ss += a0 * a0; ss += a1 * a1; }
    ss = xhalf(ss); ss += bperm(ss, lane ^ 16);
    if (fq == 0) ssq[w * 16 + fr] = ss;
    __syncthreads();
    float tot = 0.f;
#pragma unroll
    for (int w2 = 0; w2 < 8; ++w2) tot += ssq[w2 * 16 + fr];
    const float rstd = rsqrtf(tot * (1.f / 1024.f) + EPS);
    const float* gn = tabG + cv * 1024 + kb;
    const float* sh = tabS + cv * 1024 + kb;
    f32x4 acc[4];
#pragma unroll
    for (int e = 0; e < 4; ++e) acc[e] = f32x4{0.f, 0.f, 0.f, 0.f};
#pragma unroll
    for (int s_ = 0; s_ < 4; ++s_) {
      u32x4 ahi, alo;
#pragma unroll
      for (int q = 0; q < 2; ++q) {
        const float4 g = *(const float4*)(gn + s_ * 32 + q * 4), s1 = *(const float4*)(sh + s_ * 32 + q * 4);
        const unsigned u0 = xr[s_][q * 2], u1 = xr[s_][q * 2 + 1];
        const float h0 = __uint_as_float(u0 << 16) * rstd * g.x + s1.x, h1 = __uint_as_float(u0 & 0xffff0000u) * rstd * g.y + s1.y;
        const float h2 = __uint_as_float(u1 << 16) * rstd * g.z + s1.z, h3 = __uint_as_float(u1 & 0xffff0000u) * rstd * g.w + s1.w;
        const unsigned p0 = pack2(h0, h1), p1 = pack2(h2, h3);
        ahi[q * 2] = p0; ahi[q * 2 + 1] = p1;
        alo[q * 2] = pack2(h0 - __uint_as_float(p0 << 16), h1 - __uint_as_float(p0 & 0xffff0000u));
        alo[q * 2 + 1] = pack2(h2 - __uint_as_float(p1 << 16), h3 - __uint_as_float(p1 & 0xffff0000u));
      }
      *(u32x4*)(H2 + (size_t)row * 1024 + kb + s_ * 32) = ahi;
      const bf16x8 fh = __builtin_bit_cast(bf16x8, ahi), fl = __builtin_bit_cast(bf16x8, alo);
#pragma unroll
      for (int e = 0; e < 4; ++e) { acc[e] = MFMA16(fh, bh[e][s_], acc[e]); acc[e] = MFMA16(fl, bh[e][s_], acc[e]); acc[e] = MFMA16(fh, bl[e][s_], acc[e]); }
    }
#pragma unroll
    for (int e = 0; e < 4; ++e) *(f32x4*)(red + ((w * 4 + e) * 64 + lane) * 4) = acc[e];
    __syncthreads();
    if (tid < 256) {
      const int e = tid >> 6, ln = tid & 63;
      f32x4 sum = *(const f32x4*)(red + (e * 64 + ln) * 4);
#pragma unroll
      for (int w2 = 1; w2 < 8; ++w2) sum += *(const f32x4*)(red + ((w2 * 4 + e) * 64 + ln) * 4);
#pragma unroll
      for (int j = 0; j < 4; ++j) LG[(size_t)(row0 + (ln >> 4) * 4 + j) * 64 + e * 16 + (ln & 15)] = sum[j];
    }
  }
}
DI void phase_topk(const Params& p, int l, char* lds) {
  GPTR wsg_ = (GPTR)p.ws; asm volatile("" : "+s"(wsg_)); char* ws = (char*)wsg_;
  const int tid = otid(), lane = tid & 63, wid = tid >> 6;
  int* lcnt = (int*)lds;
  int* lbase = lcnt + 64;
  const float* LG = (const float*)(ws + O_LOGIT);
  int* IDX = (int*)(ws + O_IDX); float* GW = (float*)(ws + O_GW); int* RANK = (int*)(ws + O_SLOT);
  if (tid < 64) lcnt[tid] = 0;
  __syncthreads();
  const int rows_per = (NTOK + gridDim.x - 1) / gridDim.x;
  const int r0 = blockIdx.x * rows_per, r1 = min(NTOK, r0 + rows_per);
  const float eb = p.e_bias[l * 64 + lane];
  float lgv[17];
#pragma unroll
  for (int i = 0; i < 17; ++i) { const int row = r0 + wid + i * 8; lgv[i] = row < r1 ? LG[(size_t)row * 64 + lane] : 0.f; }
#pragma unroll
  for (int i = 0; i < 17; ++i) {
    const int row = r0 + wid + i * 8;
    if (row >= r1) break;
    const float score = sigm(lgv[i]);
    float sel = score + eb;
    float gsum = 0.f; int myk = -1;
    for (int k = 0; k < 6; ++k) {
      const float mx = wave_max(sel, lane);
      const unsigned long long bal = __ballot(sel == mx);
      const int win = __ffsll((long long)bal) - 1;
      const float sc_w = bperm(score, win);
      gsum += sc_w;
      if (lane == win) { sel = -1e30f; myk = k; }
    }
    if (myk >= 0) {
      const int lr = atomicAdd(&lcnt[lane], 1);
      IDX[row * 6 + myk] = lane; GW[row * 6 + myk] = score / gsum; RANK[row * 6 + myk] = lr;
    }
  }
  __syncthreads();
  if (tid < 64) lbase[tid] = atomicAdd((int*)(ws + O_CNT) + tid, lcnt[tid]);
  __syncthreads();
  for (int i = r0 * 6 + tid; i < r1 * 6; i += NTHR) RANK[i] += lbase[IDX[i]];
}

DI void phase_lists(const Params& p, char* lds) {
  GPTR wsg_ = (GPTR)p.ws; asm volatile("" : "+s"(wsg_)); char* ws = (char*)wsg_;
  const int tid = otid();
  int* poff = (int*)lds;
  const int* cnt = (const int*)(ws + O_CNT);
  if (tid == 0) { int a = 0; for (int e = 0; e < 64; ++e) { poff[e] = a; a += (cnt[e] + 255) & ~255; } poff[64] = a; }
  __syncthreads();
  int* SLOT = (int*)(ws + O_SLOT); const int* IDX = (const int*)(ws + O_IDX); int* ROWIDX = (int*)(ws + O_ROWIDX);
  for (int i = blockIdx.x * NTHR + tid; i < NTOK * 6; i += gridDim.x * NTHR) {
    const int s = poff[IDX[i]] + SLOT[i];
    SLOT[i] = s; ROWIDX[s] = i / 6;
  }
  for (int e = blockIdx.x; e < 64; e += gridDim.x) {
    const int c = cnt[e], pc = (c + 255) & ~255;
    for (int s = c + tid; s < pc; s += NTHR) ROWIDX[poff[e] + s] = 0;
  }
  for (int t = blockIdx.x * NTHR + tid; t < NTOK; t += gridDim.x * NTHR) ROWIDX[poff[64] + t] = t;
}
DI int find_expert(const int* poff, int slot0) { int e = 0; for (int i = 1; i < 64; ++i) e = (poff[i] <= slot0) ? i : e; return e; }

DI void phase_moe1(const Params& p, char* lds) {
  GPTR wsg_ = (GPTR)p.ws; asm volatile("" : "+s"(wsg_)); char* ws = (char*)wsg_;
  int* poff = (int*)(lds + LDS_POFF);
  {
    const int tid = otid();
    const int* cnt = (const int*)(ws + O_CNT);
    if (tid == 0) { int a = 0; for (int e = 0; e < 64; ++e) { poff[e] = a; a += (cnt[e] + 255) & ~255; } poff[64] = a; }
    __syncthreads();
  }
  const int TR = poff[64] >> 8;
  bf16_t* ACT = (bf16_t*)(ws + O_ACT);
  const bf16_t* H2 = (const bf16_t*)(ws + O_H2);
  const UM um(TR + 130, 2);
  int ti, ntile;
  for (int k = 0; um.get(k, ti, ntile); ++k) {
    const int f0 = ntile * 128, slot0 = ti * 256;
    const int e = ti < TR ? find_expert(poff, slot0) : 64;
    f32x4 acc[2][2][4][2]; zero_acc8(acc);
    asm volatile("s_waitcnt vmcnt(0)" ::: "memory");
    gemm8<true>(acc, H2, (const int*)(ws + O_ROWIDX), slot0, (const bf16_t*)(ws + O_WE1) + (size_t)e * 262144 + (size_t)f0 * 1024, (const bf16_t*)(ws + O_WE3) + (size_t)e * 262144 + (size_t)f0 * 1024, 1024, lds);
    const int tid = otid(), lane = tid & 63, wid = tid >> 6, wr = wid >> 2, wc = wid & 3, fr = lane & 15, fq = lane >> 4;
#pragma unroll
    for (int ai = 0; ai < 2; ++ai)
#pragma unroll
      for (int m = 0; m < 4; ++m) {
        const int row = slot0 + ai * 128 + wr * 64 + m * 16 + fr;
#pragma unroll
        for (int n = 0; n < 2; ++n) {
          const f32x4 g = acc[ai][0][m][n], u = acc[ai][1][m][n];
          f32x4 o;
#pragma unroll
          for (int j = 0; j < 4; ++j) o[j] = g[j] * sigm(g[j]) * u[j];
          *(u32x2*)(ACT + (size_t)row * 256 + f0 + wc * 32 + n * 16 + fq * 4) = pack4(o);
        }
      }
  }
}
DI void phase_moe2(const Params& p, char* lds) {
  GPTR wsg_ = (GPTR)p.ws; asm volatile("" : "+s"(wsg_)); char* ws = (char*)wsg_;
  const int tid = otid(), lane = tid & 63, wid = tid >> 6, wr = wid >> 1, wc = wid & 1, fr = lane & 15, fq = lane >> 4;
  int* poff = (int*)(lds + LDS_POFF);
  const int* cnt = (const int*)(ws + O_CNT);
  if (tid == 0) { int a = 0; for (int e = 0; e < 64; ++e) { poff[e] = a; a += (cnt[e] + 255) & ~255; } poff[64] = a; }
  __syncthreads();
  const int TR = poff[64] >> 8;
  const bf16_t* ACT = (const bf16_t*)(ws + O_ACT);
  unsigned char* Y = (unsigned char*)(ws + O_R);
  const UM um(TR + 130, 4);
  auto job = [&](int k) {
    int ti, nt_;
    if (!um.get(k, ti, nt_)) return gj_none();
    const int slot0 = ti * 256, e = ti < TR ? find_expert(poff, slot0) : 64;
    return gj_make(ACT, nullptr, 256, slot0, (const bf16_t*)(ws + O_WE2) + (size_t)e * 262144, 256, nt_ * 256, 256);
  };
  GStreamW gs; gs.start(job(0), lds, tid);
  int ti, ntile;
  for (int k = 0; um.get(k, ti, ntile); ++k) {
    const int n0 = ntile * 256, slot0 = ti * 256;
    f32x4 acc[4][8]; zero_accw(acc);
    gs.run(acc, job(k + 1));
    if (ti >= TR) {
      bf16_t* Ysh = (bf16_t*)(ws + O_R + (size_t)YROWS * 1024);
#pragma unroll
      for (int m = 0; m < 4; ++m) {
        const int row = (ti - TR) * 256 + wr * 64 + m * 16 + fr;
#pragma unroll
        for (int n = 0; n < 8; ++n) *(u32x2*)(Ysh + (size_t)row * 1024 + n0 + wc * 128 + n * 16 + fq * 4) = pack4(acc[m][n]);
      }
    } else
#pragma unroll
    for (int m = 0; m < 4; ++m) {
      const int row = slot0 + wr * 64 + m * 16 + fr;
#pragma unroll
      for (int hf = 0; hf < 2; ++hf) {
        unsigned a[4];
#pragma unroll
        for (int n = 0; n < 4; ++n) {
          const f32x4 v = acc[m][hf * 4 + n];
          const float q0 = __builtin_amdgcn_fmed3f(v[0] * 16.f, -448.f, 448.f), q1 = __builtin_amdgcn_fmed3f(v[1] * 16.f, -448.f, 448.f);
          const float q2 = __builtin_amdgcn_fmed3f(v[2] * 16.f, -448.f, 448.f), q3 = __builtin_amdgcn_fmed3f(v[3] * 16.f, -448.f, 448.f);
          int w = __builtin_amdgcn_cvt_pk_fp8_f32(q0, q1, 0, false);
          w = __builtin_amdgcn_cvt_pk_fp8_f32(q2, q3, w, true);
          a[n] = (unsigned)w;
        }
        const auto r01 = __builtin_amdgcn_permlane16_swap(a[0], a[1], false, false);
        const auto r23 = __builtin_amdgcn_permlane16_swap(a[2], a[3], false, false);
        const auto s02 = __builtin_amdgcn_permlane32_swap(r01[0], r23[0], false, false);
        const auto s13 = __builtin_amdgcn_permlane32_swap(r01[1], r23[1], false, false);
        *(u32x4*)(Y + (size_t)row * 1024 + n0 + wc * 128 + hf * 64 + fq * 16) = u32x4{s02[0], s13[0], s02[1], s13[1]};
      }
    }
  }
}

#define XB_TMO      128
#define XB_XCNT(j)  (256  + 64 * (j))
#define XB_XSUB(j)  (1280 + 64 * (j))
#define XB_XGEN(j)  (2304 + 64 * (j))
#define XB_TOP      3328
#define XB_TOPGEN   3392
#define XCD_BAR_WORDS 3456
#define XB_SPIN_CAP (1u << 21)
__device__ __forceinline__ unsigned xb_ld(unsigned* p)              { return __hip_atomic_load(p, __ATOMIC_RELAXED, __HIP_MEMORY_SCOPE_AGENT); }
__device__ __forceinline__ unsigned xb_add(unsigned* p, unsigned v) { return __hip_atomic_fetch_add(p, v, __ATOMIC_RELAXED, __HIP_MEMORY_SCOPE_AGENT); }
__device__ __forceinline__ unsigned xb_xcc_id() { return (unsigned)__builtin_amdgcn_s_getreg((3 << 11) | 20) & 0xFu; }
#define XB_SPIN(cond, bar) do { unsigned _sp = 0; while (cond) { __builtin_amdgcn_s_sleep(1); \
    if ((++_sp & 255u) == 0u) { if (xb_ld(&(bar)[XB_TMO])) break; if (_sp > XB_SPIN_CAP) { atomicAdd(&(bar)[XB_TMO], 1u); break; } } } } while (0)
struct XcdBarrier { unsigned* bar; unsigned x; volatile LAS unsigned* st; };
__device__ __forceinline__ XcdBarrier xcd_barrier_post(unsigned* bar, volatile LAS unsigned* st) {
    XcdBarrier b; b.bar = bar; b.x = xb_xcc_id(); b.st = st;
    if (threadIdx.x == 0) (void)xb_add(&bar[XB_XCNT(b.x)], 1u);
    return b;
}
__device__ __forceinline__ void xcd_barrier_complete(unsigned* bar, unsigned x, unsigned& nloc, unsigned& nx) {
    const unsigned G = gridDim.x * gridDim.y * gridDim.z;
    unsigned sum, cnt, mine, sp = 0u;
    for (;;) {
        sum = 0u; cnt = 0u; mine = 0u;
#pragma unroll
        for (unsigned j = 0; j < 16; ++j) { const unsigned c = xb_ld(&bar[XB_XCNT(j)]); sum += c; cnt += (c > 0u) ? 1u : 0u; mine = (j == x) ? c : mine; }
        if (sum == G) break;
        __builtin_amdgcn_s_sleep(1);
        if ((++sp & 255u) == 0u) { if (xb_ld(&bar[XB_TMO])) break; if (sp > XB_SPIN_CAP) { atomicAdd(&bar[XB_TMO], 1u); break; } }
    }
    nloc = mine > 0u ? mine : 1u; nx = cnt > 0u ? cnt : 1u;
}
__device__ __forceinline__ void xcd_barrier(const XcdBarrier& b) {
    asm volatile("s_waitcnt vmcnt(0)" ::: "memory");
    __syncthreads();
    if (threadIdx.x == 0) {
        unsigned* bar = b.bar;
        __builtin_amdgcn_s_waitcnt(0);
        unsigned nloc = b.st[0], nx = b.st[1];
        if (nloc == 0u) { xcd_barrier_complete(bar, b.x, nloc, nx); b.st[0] = nloc; b.st[1] = nx; }
        const unsigned old = xb_add(&bar[XB_XSUB(b.x)], 1u);
        const unsigned gen = old / nloc;
        if (old + 1u == (gen + 1u) * nloc) {
            __builtin_amdgcn_fence(__ATOMIC_RELEASE, "agent");
            asm volatile("s_waitcnt vmcnt(0)" ::: "memory");
            const unsigned og = xb_add(&bar[XB_TOP], 1u);
            const unsigned tg = og / nx;
            if (og + 1u == (tg + 1u) * nx) xb_add(&bar[XB_TOPGEN], 1u);
            else XB_SPIN(xb_ld(&bar[XB_TOPGEN]) == tg, bar);
            __builtin_amdgcn_fence(__ATOMIC_ACQUIRE, "agent");
            xb_add(&bar[XB_XGEN(b.x)], 1u);
            asm volatile("s_waitcnt vmcnt(0)" ::: "memory");
        } else {
            XB_SPIN(xb_ld(&bar[XB_XGEN(b.x)]) == gen, bar);
            __builtin_amdgcn_fence(__ATOMIC_ACQUIRE, "agent");
            asm volatile("s_waitcnt vmcnt(0)" ::: "memory");
        }
    }
    __syncthreads();
}

__global__ void __launch_bounds__(NTHR, 2) k_mega(Params_ p_unused) {
#define p (*kargs())
  extern __shared__ __attribute__((aligned(16))) char lds[];
  uint4* xbw = (uint4*)(lds + LDS_BYTES);
  if (threadIdx.x == 0) *xbw = make_uint4(0u, 0u, 0u, 0u);
  __syncthreads();
  (void)xcd_barrier_post((unsigned*)(p.ws + O_BAR), (volatile LAS unsigned*)xbw);
#define GRID_BAR() do { XcdBarrier b_; unsigned long long bp_ = (unsigned long long)(p.ws + O_BAR); asm volatile("" : "+s"(bp_)); b_.bar = (unsigned*)bp_; b_.x = xb_xcc_id(); b_.st = (volatile LAS unsigned*)(lds + LDS_BYTES); xcd_barrier(b_); } while (0)
#if PROBE_GROUP
#define REPS(g) int reps_ = 1 + ((g) == PROBE_GROUP ? 1 : 0); asm volatile("" : "+s"(reps_)); _Pragma("unroll 1") for (int r_ = 0; r_ < reps_; ++r_)
#define RSC (r_ == 0 ? 1.f : 0.f)
#else
#define REPS(g)
#define RSC 1.f
#endif
  { REPS(11) { phase_p0(p, lds); GRID_BAR(); phase_p1(p); GRID_BAR(); } }
  for (int l = 0; l < DEPTH; ++l) {
    { REPS(1) { phase_rows(p, l, RSC); } }
    { REPS(10) { phase_prep(p, l, lds); GRID_BAR(); } }
    if (blockIdx.x == 0) { const int t_ = otid(); if (t_ < 64) ((int*)(p.ws + O_CNT))[t_] = 0; if (t_ < 8) ((int*)(p.ws + O_QCTR))[t_ * 64] = 0; }
    phase_proj(p, lds); GRID_BAR(); phase_up(p, lds); GRID_BAR();
    phase_attn(p, l, lds); GRID_BAR();
    { REPS(4) { phase_s5out(p, lds); GRID_BAR(); phase_glu(p, l, lds); GRID_BAR(); } }
    { REPS(5) { phase_merge(p, lds); GRID_BAR(); } }
    { REPS(6) { phase_outproj(p, l, lds, RSC); GRID_BAR(); } }
    { REPS(7) { phase_norm2(p, l, lds); GRID_BAR(); } }
    { REPS(12) {
#if PROBE_GROUP == 12
      if (r_ > 0) { if (blockIdx.x == 0) { const int t_ = otid(); if (t_ < 64) ((int*)(p.ws + O_CNT))[t_] = 0; } GRID_BAR(); }
#endif
      phase_topk(p, l, lds); GRID_BAR();
      phase_lists(p, lds); GRID_BAR(); } }
    { REPS(8) { phase_moe1(p, lds); GRID_BAR(); } }
    { REPS(9) { phase_moe2(p, lds); GRID_BAR(); } }
  }
  phase_rows(p, DEPTH);
#undef p
}

extern "C" void kernel_launch(void* const* d_in, const int* in_sizes, int n_in, void* d_out, int out_size, void* d_ws, size_t ws_size, hipStream_t stream) {
  if (ws_size < WS_NEED) { fprintf(stderr, "workspace too small: %zu < %zu\n", ws_size, (size_t)WS_NEED); return; }
  Params_ p{};
  const float** pp = (const float**)&p;
  for (int i = 0; i < 37; ++i) pp[i] = (const float*)d_in[i];
  p.out = (float*)d_out; p.ws = (char*)d_ws;
  constexpr int kDynLds = LDS_TOTAL;
  static int grid = 0;
  if (!grid) {
    int dev = 0, cus = 0, per_cu = 0;
    hipGetDevice(&dev);
    hipDeviceGetAttribute(&cus, hipDeviceAttributeMultiprocessorCount, dev);
    hipFuncSetAttribute((const void*)k_mega, hipFuncAttributeMaxDynamicSharedMemorySize, kDynLds);
    hipOccupancyMaxActiveBlocksPerMultiprocessor(&per_cu, (const void*)k_mega, NTHR, kDynLds);
    grid = cus * (per_cu < 1 ? per_cu : 1);
    if (grid > 256) grid = 256;
  }
  if (grid <= 0) { fprintf(stderr, "k_mega does not fit\n"); return; }
  hipMemsetAsync((char*)d_ws + O_BAR, 0, 16384, stream);
  hipLaunchKernelGGL(k_mega, dim3(grid), dim3(NTHR), kDynLds, stream, p);
}
```

```cpp
#include <hip/hip_runtime.h>
#include <stdint.h>
#include <stdio.h>
typedef __attribute__((address_space(1))) char* GPTR;
#ifndef PROBE_GROUP
#define PROBE_GROUP 0
#endif

#define DI __device__ __forceinline__
#define LAS __attribute__((address_space(3)))
typedef unsigned short bf16_t;
using bf16x8 = __attribute__((ext_vector_type(8))) short;
using s16x4 = __attribute__((ext_vector_type(4))) short;
using f32x4 = __attribute__((ext_vector_type(4))) float;
using f32x16 = __attribute__((ext_vector_type(16))) float;
using u32x4 = __attribute__((ext_vector_type(4))) unsigned;
using u32x2 = __attribute__((ext_vector_type(2))) unsigned;
typedef __bf16 bf2_t __attribute__((ext_vector_type(2)));
typedef float fl2_t __attribute__((ext_vector_type(2)));
typedef short v4i16_t __attribute__((ext_vector_type(4)));

constexpr int NL = 32768, NC = 512, NTOK = 33280, DM = 1024, SEQ = 16384, CTXL = 256, KLEN = 16640, DEPTH = 4;
constexpr int INW = 6304, NTHR = 512;
constexpr int NCHUNK = 260;
constexpr int YROWS = 216064 + 33280;
constexpr float LOG2E = 1.4426950408889634f;
constexpr float NA_QS = 0.125f * LOG2E;
constexpr float DIFF_QS = 0.17677669529663687f * LOG2E;
constexpr float MLA_QS = 0.10206207261596577f * LOG2E;
constexpr float EPS = 1e-6f;

constexpr size_t O_BAR = 0;
constexpr size_t O_TP = O_BAR + 14336;
constexpr size_t O_CNT = O_BAR + 16384;
constexpr size_t O_QCTR = O_CNT + 1024;
constexpr size_t O_LAMF = O_QCTR + 2048;
constexpr size_t O_ADA = O_LAMF + 256;
constexpr size_t O_ROPER = O_ADA + 294912;
constexpr size_t O_ROPEC = O_ROPER + 16384;
constexpr size_t O_S5PW = O_ROPEC + 4096;
constexpr size_t O_S5BB = O_S5PW + 4259840;
constexpr size_t O_S5K = O_S5BB + 1048576;
constexpr size_t O_X = O_S5K + 8388608;
constexpr size_t O_H1 = O_X + 136314880;
constexpr size_t O_R = O_H1 + 68157440;
constexpr size_t O_H2 = O_R;
constexpr size_t O_YCAT = O_H2 + 68157440;
constexpr size_t O_MBUF = O_YCAT + 68157440;
constexpr size_t O_QN = O_MBUF + 68157440;
constexpr size_t O_KN = O_QN + 17039360;
constexpr size_t O_VN = O_KN + 17039360;
constexpr size_t O_QDL = O_VN + 17039360;
constexpr size_t O_QDR = O_QDL + 16777216;
constexpr size_t O_KD = O_QDR + 17039360;
constexpr size_t O_VD = O_KD + 17039360;
constexpr size_t O_QML = O_VD + 17039360;
constexpr size_t O_QMR = O_QML + 25165824;
constexpr size_t O_KM = O_QMR + 25559040;
constexpr size_t O_VM = O_KM + 25559040;
constexpr size_t O_CQ = O_VM + 17039360;
constexpr size_t O_CKV = O_CQ + 17039360;
constexpr size_t O_UCAT = O_CKV + 8519680;
constexpr size_t O_SLOC = O_UCAT + 21954560;
constexpr size_t O_G5 = O_SLOC + 8519680;
constexpr size_t R_END1 = O_G5 + 17039360;
constexpr size_t R_END2 = O_R + (size_t)YROWS * 2048;
constexpr size_t O_ACT = R_END1 > R_END2 ? R_END1 : R_END2;
constexpr size_t O_IDX = O_ACT + (size_t)YROWS * 512;
constexpr size_t O_GW = O_IDX + 798720;
constexpr size_t O_SLOT = O_GW + 798720;
constexpr size_t O_ROWIDX = O_SLOT + 798720;
constexpr size_t O_WIN = O_ROWIDX + 997376;
constexpr size_t O_WG = O_WIN + 2304 * 1024 * 2;
constexpr size_t O_WUQ = O_WG + 4096 * 1024 * 2;
constexpr size_t O_WUKV = O_WUQ + 384 * 256 * 2;
constexpr size_t O_WGLU = O_WUKV + 512 * 128 * 2;
constexpr size_t O_WBR = O_WGLU + 256 * 256 * 2;
constexpr size_t O_WOUT = O_WBR + 4 * 1024 * 256 * 2;
constexpr size_t O_WE1 = O_WOUT + 1024 * 1024 * 2;
constexpr size_t O_WE3 = O_WE1 + (size_t)65 * 256 * 1024 * 2;
constexpr size_t O_WE2 = O_WE3 + (size_t)65 * 256 * 1024 * 2;
constexpr size_t O_S5B2 = O_WE2 + (size_t)65 * 1024 * 256 * 2;
constexpr size_t O_S5B1 = O_S5B2 + (size_t)16 * 1024 * 1280 * 2;
constexpr size_t O_WRHI = O_S5B1 + (size_t)16 * 256 * 1024 * 2;
constexpr size_t O_WRLO = O_WRHI + 128 * 1024 * 2;
constexpr size_t WS_NEED = O_WRLO + 128 * 1024 * 2;
constexpr size_t O_H2LO = O_MBUF;
constexpr size_t O_LOGIT = O_YCAT;

struct Params_ {
  const float *x, *c, *ctx, *c_ctx, *w_ada, *b_ada, *g_norm1, *g_norm2, *w_in, *na_rpb, *diff_lambda, *g_diff, *g_mla_q, *g_mla_kv,
      *w_mla_uq, *w_mla_ukv, *s5_lam_re, *s5_lam_im, *s5_log_step, *s5_b_re, *s5_b_im, *s5_c_re, *s5_c_im, *s5_d, *w_glu, *b_glu,
      *w_branch, *w_out, *w_router, *e_bias, *w_e1, *w_e3, *w_e2, *w_s1, *w_s3, *w_s2, *g_final;
  float* out;
  char* ws;
};
typedef const __attribute__((address_space(4))) Params_ Params;
DI Params* kargs() { Params* k = (Params*)__builtin_amdgcn_kernarg_segment_ptr(); asm volatile("" : "+s"(k)); return k; }

DI float bf2f(bf16_t b) { return __uint_as_float((unsigned)b << 16); }
DI bf16_t f2bf(float x) { unsigned u = __float_as_uint(x); u += 0x7fffu + ((u >> 16) & 1u); return (bf16_t)(u >> 16); }
DI unsigned pack2(float a, float b) { fl2_t f = {a, b}; bf2_t r = __builtin_convertvector(f, bf2_t); return __builtin_bit_cast(unsigned, r); }
DI float sigm(float x) { return __builtin_amdgcn_rcpf(1.f + __builtin_amdgcn_exp2f(-LOG2E * x)); }
DI float gelu_tanh(float x) { float u = 0.7978845608028654f * (x + 0.044715f * x * x * x); return x * (1.f - __builtin_amdgcn_rcpf(__builtin_amdgcn_exp2f((2.f * LOG2E) * u) + 1.f)); }
DI float bperm(float v, int srclane) { return __int_as_float(__builtin_amdgcn_ds_bpermute(srclane << 2, __float_as_int(v))); }
DI float xhalf(float v) { auto rr = __builtin_amdgcn_permlane32_swap(__float_as_uint(v), __float_as_uint(v), false, false); return __uint_as_float(rr[0]) + __uint_as_float(rr[1]); }
DI float xhalf_max(float v) { auto rr = __builtin_amdgcn_permlane32_swap(__float_as_uint(v), __float_as_uint(v), false, false); return fmaxf(__uint_as_float(rr[0]), __uint_as_float(rr[1])); }
DI float xhalf_get(float v, int hi) { auto rr = __builtin_amdgcn_permlane32_swap(__float_as_uint(v), __float_as_uint(v), false, false); return __uint_as_float(hi ? rr[0] : rr[1]); }
DI float wave_sum(float v, int lane) {
#pragma unroll
  for (int o = 16; o > 0; o >>= 1) v += bperm(v, lane ^ o);
  return xhalf(v);
}
DI float wave_max(float v, int lane) {
#pragma unroll
  for (int o = 16; o > 0; o >>= 1) v = fmaxf(v, bperm(v, lane ^ o));
  return xhalf_max(v);
}
DI void tokinfo(int row, int& b, int& isctx, int& t) {
  if (row < NL) { b = row >> 14; t = row & 16383; isctx = 0; }
  else { int r = row - NL; b = r >> 8; t = r & 255; isctx = 1; }
}
#define MFMA16(a, b, c) __builtin_amdgcn_mfma_f32_16x16x32_bf16((a), (b), (c), 0, 0, 0)
#define MFMA32(a, b, c) __builtin_amdgcn_mfma_f32_32x32x16_bf16((a), (b), (c), 0, 0, 0)
DI int otid() { int t = threadIdx.x; asm volatile("" : "+v"(t)); return t; }
template <int DK> DI size_t kimg(int kidx, int d) { return ((size_t)((kidx >> 6) * (DK / 8) + (d >> 3)) * 64 + (kidx & 63)) * 8 + (d & 7); }
DI size_t vimg(int kidx, int d) { return (size_t)(kidx >> 6) * 4096 + (d >> 5) * 2048 + (kidx & 63) * 32 + (d & 31); }
DI void glds16(const void* g, unsigned lds_base) {
  unsigned sv;
  asm volatile("s_mov_b32 %0, m0\n\ts_mov_b32 m0, %2\n\ts_nop 0\n\tglobal_load_lds_dwordx4 %1, off\n\ts_mov_b32 m0, %0" : "=&s"(sv) : "v"(g), "s"(lds_base) : "memory");
}
DI int crow(int r, int hi) { return (r & 3) + 8 * (r >> 2) + 4 * hi; }

constexpr int GSTAGE = 49152;
constexpr int GNST = 3;
constexpr int GEMM_LDS = GNST * GSTAGE;
constexpr int LDS_BYTES = GEMM_LDS + 2048;
constexpr int LDS_XBW = LDS_BYTES, LDS_POFF = LDS_BYTES + 16, LDS_TOTAL = LDS_BYTES + 16 + 512;
struct GJ { const bf16_t* A; const int* ridx; const bf16_t* Bt; int lda, m0, ldb, n0, nt; bool valid; };
DI GJ gj_none() { GJ j; j.A = nullptr; j.ridx = nullptr; j.Bt = nullptr; j.lda = 0; j.m0 = 0; j.ldb = 0; j.n0 = 0; j.nt = 0; j.valid = false; return j; }
DI GJ gj_make(const bf16_t* A, const int* ridx, int lda, int m0, const bf16_t* Bt, int ldb, int n0, int K) {
  GJ j; j.A = A; j.ridx = ridx; j.Bt = Bt; j.lda = lda; j.m0 = m0; j.ldb = ldb; j.n0 = n0; j.nt = K >> 6; j.valid = true; return j; }
struct GP { const bf16_t* p[6]; };
DI GP g_setup(const GJ& j, int tid) {
  const int r = tid >> 3, c = (((tid & 7) ^ ((r >> 1) & 7))) * 8;
  GP g;
#pragma unroll
  for (int i = 0; i < 4; ++i) { int rr = j.m0 + r + 64 * i; if (j.ridx) rr = j.ridx[rr]; g.p[i] = j.A + (size_t)rr * j.lda + c; }
#pragma unroll
  for (int i = 0; i < 2; ++i) g.p[4 + i] = j.Bt + (size_t)(j.n0 + r + 64 * i) * j.ldb + c;
  return g;
}
DI void g_issue1(const GP& g, int kt, char* base, int tid, int i) {
  __builtin_amdgcn_global_load_lds((const unsigned*)(g.p[i] + kt * 64), (unsigned*)(base + i * 8192 + tid * 16), 16, 0, 0);
}
DI const bf16_t* g_ptr1(const GJ& j, int tid, int i) {
  const int r = tid >> 3, c = (((tid & 7) ^ ((r >> 1) & 7))) * 8;
  if (i < 4) { int rr = j.m0 + r + 64 * i; if (j.ridx) rr = j.ridx[rr]; return j.A + (size_t)rr * j.lda + c; }
  return j.Bt + (size_t)(j.n0 + r + 64 * (i - 4)) * j.ldb + c;
}
DI void g_issue(const GP& g, int kt, char* base, int tid) {
#pragma unroll
  for (int i = 0; i < 6; ++i) g_issue1(g, kt, base, tid, i);
}
template <int NST>
struct GStream {
  GP cur; int cur_nt, ring, tid; char* lds;
  DI void start(const GJ& j, char* lds_, int tid_) {
    lds = lds_; tid = tid_; ring = 0; cur_nt = j.nt;
    if (j.valid) { cur = g_setup(j, tid);
#pragma unroll
      for (int i = 0; i < NST - 1; ++i) g_issue(cur, i, lds + i * GSTAGE, tid); }
  }
  template <bool LAZY = false, bool PF2 = true>
  DI void run(f32x4 (&acc)[4][4], const GJ& next) {
    const int lane = tid & 63, wid = tid >> 6, wr = wid >> 1, wc = wid & 1, fr = lane & 15, fq = lane >> 4;
    const int sw = (fr >> 1) & 7;
    const int aoff = (wr * 64 + fr) * 128, boff = 32768 + (wc * 64 + fr) * 128;
    const int c0 = ((fq ^ sw) * 16), c1 = (((4 + fq) ^ sw) * 16);
    const bool hn = next.valid;
    GP nxt = cur;
    if (!LAZY && hn) nxt = g_setup(next, tid);
    const int nt = cur_nt;
#pragma unroll 1
    for (int t = 0; t < nt; ++t) {
      int infl = nt - 1 - t + (hn ? NST - 1 : 0); infl = infl > NST - 2 ? NST - 2 : infl;
      if (infl >= 2) asm volatile("s_waitcnt vmcnt(12)" ::: "memory");
      else if (infl == 1) asm volatile("s_waitcnt vmcnt(6)" ::: "memory");
      else asm volatile("s_waitcnt vmcnt(0)" ::: "memory");
      __builtin_amdgcn_s_barrier();
      const int j = t + NST - 1;
      char* ib = lds + ((ring + j) % NST) * GSTAGE;
      const bool own = j < nt, doi = own || hn;
      const int ikt = own ? j : j - nt;
      GP src = cur;
      if (!LAZY && !own && hn) src = nxt;
#define G_ISSUE1(i_) do { if (LAZY && !own) __builtin_amdgcn_global_load_lds((const unsigned*)(g_ptr1(next, tid, (i_)) + ikt * 64), (unsigned*)(ib + (i_) * 8192 + tid * 16), 16, 0, 0); else g_issue1(src, ikt, ib, tid, (i_)); } while (0)
      const char* base = lds + ((ring + t) % NST) * GSTAGE;
      bf16x8 af[4], bfr[4], af1[4], bf1[4];
#pragma unroll
      for (int m = 0; m < 4; ++m) af[m] = *(const bf16x8*)(base + aoff + m * 2048 + c0);
#pragma unroll
      for (int n = 0; n < 4; ++n) bfr[n] = *(const bf16x8*)(base + boff + n * 2048 + c0);
      __builtin_amdgcn_sched_barrier(0);
#pragma unroll
      for (int m = 0; m < 4; ++m) {
#pragma unroll
        for (int n = 0; n < 4; ++n) acc[m][n] = MFMA16(bfr[n], af[m], acc[m][n]);
        if (doi) G_ISSUE1(m);
        if (!LAZY && PF2) {
          if (m == 0) {
#pragma unroll
            for (int n = 0; n < 4; ++n) bf1[n] = *(const bf16x8*)(base + boff + n * 2048 + c1);
          }
          if (m == 1) {
#pragma unroll
            for (int q = 0; q < 4; ++q) af1[q] = *(const bf16x8*)(base + aoff + q * 2048 + c1);
          }
        }
        __builtin_amdgcn_sched_barrier(0);
      }
      if (LAZY || !PF2) {
#pragma unroll
        for (int m = 0; m < 4; ++m) af1[m] = *(const bf16x8*)(base + aoff + m * 2048 + c1);
#pragma unroll
        for (int n = 0; n < 4; ++n) bf1[n] = *(const bf16x8*)(base + boff + n * 2048 + c1);
        __builtin_amdgcn_sched_barrier(0);
      }
#pragma unroll
      for (int m = 0; m < 4; ++m) {
#pragma unroll
        for (int n = 0; n < 4; ++n) acc[m][n] = MFMA16(bf1[n], af1[m], acc[m][n]);
        if (m < 2 && doi) G_ISSUE1(4 + m);
        __builtin_amdgcn_sched_barrier(0);
      }
    }
#undef G_ISSUE1
    ring = (ring + nt) % NST;
    if (LAZY) { if (hn) cur = g_setup(next, tid); } else cur = nxt;
    cur_nt = next.nt;
  }
  DI void run2(f32x4 (&acc)[4][4], const GJ& next) { run(acc, next); }
};
DI void mini_gemm16(f32x4& acc, const bf16_t* __restrict__ A, int lda, const bf16_t* __restrict__ Bt, int ldb, int K, int lane) {
  const bf16_t* ap = A + (size_t)(lane & 15) * lda + 8 * (lane >> 4);
  const bf16_t* bp = Bt + (size_t)(lane & 15) * ldb + 8 * (lane >> 4);
  int k0 = 0;
#pragma unroll 1
  for (; k0 + 512 <= K; k0 += 512) {
    bf16x8 a[16], b[16];
#pragma unroll
    for (int i = 0; i < 16; ++i) { a[i] = *(const bf16x8*)(ap + k0 + i * 32); b[i] = *(const bf16x8*)(bp + k0 + i * 32); }
#pragma unroll
    for (int i = 0; i < 16; ++i) acc = MFMA16(a[i], b[i], acc);
  }
#pragma unroll 1
  for (; k0 < K; k0 += 256) {
    bf16x8 a[8], b[8];
#pragma unroll
    for (int i = 0; i < 8; ++i) { a[i] = *(const bf16x8*)(ap + k0 + i * 32); b[i] = *(const bf16x8*)(bp + k0 + i * 32); }
#pragma unroll
    for (int i = 0; i < 8; ++i) acc = MFMA16(a[i], b[i], acc);
  }
}
DI void mini_gemm32(f32x4 (&acc)[2][2], const bf16_t* __restrict__ A, int lda, const bf16_t* __restrict__ Bt, int ldb, int K, int lane) {
  const bf16_t* ap = A + (size_t)(lane & 15) * lda + 8 * (lane >> 4);
  const bf16_t* bp = Bt + (size_t)(lane & 15) * ldb + 8 * (lane >> 4);
#pragma unroll 1
  for (int k0 = 0; k0 < K; k0 += 256) {
    bf16x8 a0[8], a1[8], b0[8], b1[8];
#pragma unroll
    for (int i = 0; i < 8; ++i) {
      a0[i] = *(const bf16x8*)(ap + k0 + i * 32); a1[i] = *(const bf16x8*)(ap + (size_t)16 * lda + k0 + i * 32);
      b0[i] = *(const bf16x8*)(bp + k0 + i * 32); b1[i] = *(const bf16x8*)(bp + (size_t)16 * ldb + k0 + i * 32);
    }
#pragma unroll
    for (int i = 0; i < 8; ++i) {
      acc[0][0] = MFMA16(a0[i], b0[i], acc[0][0]); acc[0][1] = MFMA16(a0[i], b1[i], acc[0][1]);
      acc[1][0] = MFMA16(a1[i], b0[i], acc[1][0]); acc[1][1] = MFMA16(a1[i], b1[i], acc[1][1]);
    }
  }
}
constexpr int WSTAGE = 32768, WNST = 4;
struct GPW { const bf16_t* p[4]; };
DI GPW gw_setup(const GJ& j, int tid) {
  const int r = tid >> 2, c = (((tid & 3) ^ ((0 - (r >> 2)) & 3))) * 8;
  GPW g;
#pragma unroll
  for (int i = 0; i < 2; ++i) { int rr = j.m0 + r + 128 * i; if (j.ridx) rr = j.ridx[rr]; g.p[i] = j.A + (size_t)rr * j.lda + c; }
#pragma unroll
  for (int i = 0; i < 2; ++i) g.p[2 + i] = j.Bt + (size_t)(j.n0 + r + 128 * i) * j.ldb + c;
  return g;
}
DI void gw_issue1(const GPW& g, int kt, char* base, int tid, int i) {
  __builtin_amdgcn_global_load_lds((const unsigned*)(g.p[i] + kt * 32), (unsigned*)(base + i * 8192 + tid * 16), 16, 0, 0);
}
struct GStreamW {
  GPW cur; int cur_nt, ring, tid; char* lds;
  DI void start(const GJ& j, char* lds_, int tid_) {
    lds = lds_; tid = tid_; ring = 0; cur_nt = j.nt * 2;
    if (j.valid) { cur = gw_setup(j, tid);
#pragma unroll
      for (int s = 0; s < WNST - 1; ++s)
#pragma unroll
        for (int i = 0; i < 4; ++i) gw_issue1(cur, s, lds + s * WSTAGE, tid, i); }
  }
  DI void run(f32x4 (&acc)[4][8], const GJ& next) {
    const int lane = tid & 63, wid = tid >> 6, wr = wid >> 1, wc = wid & 1, fr = lane & 15, fq = lane >> 4;
    const int fo = ((fq ^ ((0 - (fr >> 2)) & 3)) * 16);
    const int aoff = (wr * 64 + fr) * 64 + fo, boff = 16384 + (wc * 128 + fr) * 64 + fo;
    const bool hn = next.valid;
    GPW nxt = cur;
    if (hn) nxt = gw_setup(next, tid);
    const int nt = cur_nt;
#pragma unroll 1
    for (int t = 0; t < nt; ++t) {
      int infl = nt - 1 - t + (hn ? WNST - 1 : 0); infl = infl > WNST - 2 ? WNST - 2 : infl;
      if (infl >= 2) asm volatile("s_waitcnt vmcnt(8)" ::: "memory");
      else if (infl == 1) asm volatile("s_waitcnt vmcnt(4)" ::: "memory");
      else asm volatile("s_waitcnt vmcnt(0)" ::: "memory");
      __builtin_amdgcn_s_barrier();
      const int j = t + WNST - 1;
      char* ib = lds + ((ring + j) % WNST) * WSTAGE;
      const bool own = j < nt, doi = own || hn;
      const int ikt = own ? j : j - nt;
      GPW src = cur;
      if (!own && hn) src = nxt;
      const char* base = lds + ((ring + t) % WNST) * WSTAGE;
      bf16x8 af[4], bfr[8];
#pragma unroll
      for (int m = 0; m < 4; ++m) af[m] = *(const bf16x8*)(base + aoff + m * 1024);
#pragma unroll
      for (int n = 0; n < 8; ++n) bfr[n] = *(const bf16x8*)(base + boff + n * 1024);
      __builtin_amdgcn_sched_barrier(0);
#pragma unroll
      for (int m = 0; m < 4; ++m) {
#pragma unroll
        for (int n = 0; n < 8; ++n) acc[m][n] = MFMA16(bfr[n], af[m], acc[m][n]);
        if (doi) gw_issue1(src, ikt, ib, tid, m);
        __builtin_amdgcn_sched_barrier(0);
      }
    }
    ring = (ring + nt) % WNST;
    cur = nxt; cur_nt = next.nt * 2;
  }
};
DI void zero_accw(f32x4 (&acc)[4][8]) {
#pragma unroll
  for (int m = 0; m < 4; ++m)
#pragma unroll
    for (int n = 0; n < 8; ++n) acc[m][n] = f32x4{0.f, 0.f, 0.f, 0.f};
}
constexpr int G8_HT = 128 * 64;
DI int g8_lds_byte(int r, int c) { const int st = (r >> 4) * 2 + (c >> 5), rr = r & 15, cc = c & 31, ob = rr * 64 + cc * 2; return st * 1024 + (ob ^ (((ob >> 9) & 1) << 5)); }
DI void g8_stage_rc(int b, int& R, int& C) { const int st = b / 1024, sb = b % 1024, swz = sb ^ (((sb >> 9) & 1) << 5); R = (st >> 1) * 16 + swz / 64; C = (st & 1) * 32 + (swz % 64) / 2; }
template <bool GATHER>
DI void gemm8(f32x4 (&acc)[2][2][4][2], const bf16_t* __restrict__ A, const int* __restrict__ ridx, int brow, const bf16_t* __restrict__ B0, const bf16_t* __restrict__ B1, int K, char* shmc) {
  bf16_t* shm = (bf16_t*)shmc;
#define G8_SA(b, h) (shm + ((b) * 2 + (h)) * G8_HT)
#define G8_SB(b, h) (shm + (4 + (b) * 2 + (h)) * G8_HT)
  int tz = otid();
  int wid = tz >> 6, lane = tz & 63, wr = wid >> 2, wc = wid & 3, fr = lane & 15, fq = lane >> 4;
  int ar[2][2];
  if (GATHER) {
#pragma unroll
    for (int h = 0; h < 2; ++h)
#pragma unroll
      for (int i = 0; i < 2; ++i) { int r_, c_; g8_stage_rc(tz * 16 + i * 8192, r_, c_); ar[h][i] = ridx[brow + h * 128 + r_]; }
  }
#define G8_STAGE_A(P, h, kt) do { _Pragma("unroll") for (int i_ = 0; i_ < 2; ++i_) { const int b_ = tz * 16 + i_ * 8192; int r_, c_; g8_stage_rc(b_, r_, c_); \
      const long row_ = GATHER ? (long)ar[h][i_] : (long)(brow + (h) * 128 + r_); \
      __builtin_amdgcn_global_load_lds((const unsigned*)(A + row_ * K + (long)(kt) * 64 + c_), (unsigned*)((char*)(P) + b_), 16, 0, 0); } } while (0)
#define G8_STAGE_B(P, h, kt) do { const bf16_t* bb_ = (h) ? B1 : B0; _Pragma("unroll") for (int i_ = 0; i_ < 2; ++i_) { const int b_ = tz * 16 + i_ * 8192; int r_, c_; g8_stage_rc(b_, r_, c_); \
      __builtin_amdgcn_global_load_lds((const unsigned*)(bb_ + (long)r_ * K + (long)(kt) * 64 + c_), (unsigned*)((char*)(P) + b_), 16, 0, 0); } } while (0)
#define G8_LDA(dst, b, h) _Pragma("unroll") for (int m = 0; m < 4; ++m) _Pragma("unroll") for (int k = 0; k < 2; ++k) \
    dst[m][k] = *reinterpret_cast<const bf16x8*>((char*)G8_SA(b, h) + g8_lds_byte(wr * 64 + m * 16 + fr, k * 32 + fq * 8))
#define G8_LDB(dst, b, h) _Pragma("unroll") for (int n = 0; n < 2; ++n) _Pragma("unroll") for (int k = 0; k < 2; ++k) \
    dst[n][k] = *reinterpret_cast<const bf16x8*>((char*)G8_SB(b, h) + g8_lds_byte(wc * 32 + n * 16 + fr, k * 32 + fq * 8))
#define G8_MMA(ai, bj, At_, Bt_) do { __builtin_amdgcn_s_setprio(1); \
    _Pragma("unroll") for (int m = 0; m < 4; ++m) _Pragma("unroll") for (int n = 0; n < 2; ++n) _Pragma("unroll") for (int k = 0; k < 2; ++k) \
      acc[ai][bj][m][n] = MFMA16(Bt_[n][k], At_[m][k], acc[ai][bj][m][n]); \
    __builtin_amdgcn_s_setprio(0); } while (0)
#define G8_WAIT_V(n) asm volatile("s_waitcnt vmcnt(" #n ")" ::: "memory")
#define G8_WAIT_L(n) asm volatile("s_waitcnt lgkmcnt(" #n ")" ::: "memory")
#define G8_BAR __builtin_amdgcn_s_barrier()
#define G8_SCHED __builtin_amdgcn_sched_barrier(0)
  bf16x8 At[4][2], Bq0[2][2], Bq1[2][2];
  const int nt = K / 64;
  G8_STAGE_B(G8_SB(0, 0), 0, 0); G8_STAGE_A(G8_SA(0, 0), 0, 0);
  G8_STAGE_B(G8_SB(0, 1), 1, 0); G8_STAGE_A(G8_SA(0, 1), 1, 0);
  if (wr == 1) G8_BAR;
  G8_WAIT_V(4); G8_BAR;
  G8_STAGE_B(G8_SB(1, 0), 0, 1); G8_STAGE_A(G8_SA(1, 0), 0, 1); G8_STAGE_B(G8_SB(1, 1), 1, 1);
  G8_WAIT_V(6); G8_BAR;
#pragma unroll 1
  for (int t = 0; t < nt - 2; t += 2) {
    G8_LDB(Bq0, 0, 0); G8_SCHED; G8_LDA(At, 0, 0); G8_STAGE_A(G8_SA(1, 1), 1, t + 1);
    G8_WAIT_L(8); G8_BAR; G8_WAIT_L(0); G8_MMA(0, 0, At, Bq0); G8_BAR; G8_SCHED;
    G8_LDB(Bq1, 0, 1); G8_STAGE_B(G8_SB(0, 0), 0, t + 2);
    G8_BAR; G8_WAIT_L(0); G8_MMA(0, 1, At, Bq1); G8_BAR;
    G8_LDA(At, 0, 1); G8_STAGE_A(G8_SA(0, 0), 0, t + 2);
    G8_BAR; G8_WAIT_L(0); G8_MMA(1, 0, At, Bq0); G8_BAR; G8_SCHED;
    G8_STAGE_B(G8_SB(0, 1), 1, t + 2);
    G8_WAIT_V(6); G8_BAR; G8_MMA(1, 1, At, Bq1); G8_BAR;
    G8_LDB(Bq0, 1, 0); G8_SCHED; G8_LDA(At, 1, 0); G8_STAGE_A(G8_SA(0, 1), 1, t + 2);
    G8_WAIT_L(8); G8_BAR; G8_WAIT_L(0); G8_MMA(0, 0, At, Bq0); G8_BAR; G8_SCHED;
    G8_LDB(Bq1, 1, 1); G8_STAGE_B(G8_SB(1, 0), 0, t + 3);
    G8_BAR; G8_WAIT_L(0); G8_MMA(0, 1, At, Bq1); G8_BAR;
    G8_LDA(At, 1, 1); G8_STAGE_A(G8_SA(1, 0), 0, t + 3);
    G8_BAR; G8_WAIT_L(0); G8_MMA(1, 0, At, Bq0); G8_BAR; G8_SCHED;
    G8_STAGE_B(G8_SB(1, 1), 1, t + 3);
    G8_WAIT_V(6); G8_BAR; G8_MMA(1, 1, At, Bq1); G8_BAR;
  }
  { int t2 = tz; asm volatile("" : "+v"(t2)); tz = t2; wid = tz >> 6; lane = tz & 63; wr = wid >> 2; wc = wid & 3; fr = lane & 15; fq = lane >> 4; }
  { G8_LDB(Bq0, 0, 0); G8_WAIT_V(0); G8_LDA(At, 0, 0); G8_STAGE_A(G8_SA(1, 1), 1, nt - 1);
    G8_BAR; G8_WAIT_L(0); G8_MMA(0, 0, At, Bq0); G8_BAR;
    G8_LDB(Bq1, 0, 1); G8_BAR; G8_WAIT_L(0); G8_MMA(0, 1, At, Bq1); G8_BAR;
    G8_LDA(At, 0, 1); G8_WAIT_V(4); G8_BAR; G8_WAIT_L(0); G8_MMA(1, 0, At, Bq0); G8_MMA(1, 1, At, Bq1); G8_BAR; }
  { G8_LDB(Bq0, 1, 0); G8_LDA(At, 1, 0); G8_WAIT_V(2); G8_BAR; G8_WAIT_L(0); G8_MMA(0, 0, At, Bq0); G8_BAR;
    G8_LDB(Bq1, 1, 1); G8_WAIT_V(0); G8_BAR; G8_WAIT_L(0); G8_MMA(0, 1, At, Bq1); G8_BAR;
    G8_LDA(At, 1, 1); G8_BAR; G8_WAIT_L(0); G8_MMA(1, 0, At, Bq0); G8_MMA(1, 1, At, Bq1); G8_BAR; }
  if (wr == 0) G8_BAR;
#undef G8_SA
#undef G8_SB
#undef G8_STAGE_A
#undef G8_STAGE_B
#undef G8_LDA
#undef G8_LDB
#undef G8_MMA
#undef G8_WAIT_V
#undef G8_WAIT_L
#undef G8_BAR
#undef G8_SCHED
}
DI void zero_acc8(f32x4 (&acc)[2][2][4][2]) {
#pragma unroll
  for (int a = 0; a < 2; ++a)
#pragma unroll
    for (int b = 0; b < 2; ++b)
#pragma unroll
      for (int m = 0; m < 4; ++m)
#pragma unroll
        for (int n = 0; n < 2; ++n) acc[a][b][m][n] = f32x4{0.f, 0.f, 0.f, 0.f};
}
struct UM {
  int x, r, R, NT, nloc;
  DI UM(int NM, int NT_) { x = blockIdx.x & 7; r = blockIdx.x >> 3; R = gridDim.x >> 3; NT = NT_; nloc = ((NM - x + 7) >> 3) * NT_; if (NM <= x) nloc = 0; }
  DI bool get(int k, int& mt, int& nt) const { const int v = r + k * R; if (k < 0 || v >= nloc) return false; mt = x + 8 * (v / NT); nt = v % NT; return true; }
};
DI u32x2 pack4(const f32x4& v) { u32x2 r; r[0] = pack2(v[0], v[1]); r[1] = pack2(v[2], v[3]); return r; }
DI void zero_acc(f32x4 (&acc)[4][4]) {
#pragma unroll
  for (int m = 0; m < 4; ++m)
#pragma unroll
    for (int n = 0; n < 4; ++n) acc[m][n] = f32x4{0.f, 0.f, 0.f, 0.f};
}

DI float rope_apply(float v, float partner, int fr, int half, int t, const float2* roper, const float2* ropec) {
  const int i = fr & 7;
  const float2 cs = half ? ropec[(t & 63) * 8 + i] : roper[(t >> 6) * 8 + i];
  return (fr & 8) ? (partner * cs.y + v * cs.x) : (v * cs.x - partner * cs.y);
}

DI void phase_p0(const Params& p, char* lds) {
  const int tid = otid(), gtid = blockIdx.x * NTHR + tid, gsz = gridDim.x * NTHR;
  float* sl = (float*)lds;
  for (int i = tid; i < 3072; i += NTHR) { float v = i < 2048 ? p.c[i] : p.c_ctx[i - 2048]; sl[i] = v / (1.f + __expf(-v)); }
  __syncthreads();
  float* adap = (float*)(p.ws + O_ACT);
  for (int w = gtid; w < DEPTH * 6144 * 4; w += gsz) {
    const int kp = w / (DEPTH * 6144), o = w % (DEPTH * 6144);
    const int l = o / 6144, col = o % 6144;
    const float* wp = p.w_ada + ((size_t)l * 1024 + kp * 256) * 6144 + col;
    const float* s0 = sl + kp * 256;
    float a0 = 0.f, a1 = 0.f, a2 = 0.f;
#pragma unroll 16
    for (int k = 0; k < 256; ++k) { const float wv = wp[(size_t)k * 6144]; a0 += s0[k] * wv; a1 += s0[1024 + k] * wv; a2 += s0[2048 + k] * wv; }
    float* dst = adap + (size_t)kp * (DEPTH * 3 * 6144);
    dst[(l * 3 + 0) * 6144 + col] = a0; dst[(l * 3 + 1) * 6144 + col] = a1; dst[(l * 3 + 2) * 6144 + col] = a2;
  }
  float2* rr = (float2*)(p.ws + O_ROPER);
  float2* rc = (float2*)(p.ws + O_ROPEC);
  for (int i = gtid; i < 2048 + 512; i += gsz) {
    const int j = i < 2048 ? i : i - 2048;
    const int pos = j >> 3, f = j & 7;
    double freq = 1.0;
    switch (f) { case 1: freq = 0.31622776601683794; break; case 2: freq = 0.1; break; case 3: freq = 0.031622776601683794; break; case 4: freq = 0.01; break;
      case 5: freq = 0.0031622776601683794; break; case 6: freq = 0.001; break; case 7: freq = 0.00031622776601683794; break; default: break; }
    double rev = (double)pos * freq * 0.15915494309189535; rev -= floor(rev);
    const float rf = (float)rev;
    const float2 cs = make_float2(__builtin_amdgcn_cosf(rf), __builtin_amdgcn_sinf(rf));
    if (i < 2048) rr[j] = cs; else rc[j] = cs;
  }
  float2* pw = (float2*)(p.ws + O_S5PW);
  float2* bb = (float2*)(p.ws + O_S5BB);
  for (int i = gtid; i < DEPTH * 2 * 16 * 64; i += gsz) {
    const int ldg = i >> 6, pp = i & 63;
    const float lr = p.s5_lam_re[i], li = p.s5_lam_im[i];
    const float step = expf(p.s5_log_step[ldg]);
    float ar = 1.f, ai = 0.f;
    for (int tau = 0; tau <= 64; ++tau) {
      double rev = (double)li * (double)step * (double)tau * 0.15915494309189535; rev -= floor(rev);
      const float rf = (float)rev;
      const float mag = expf(lr * step * (float)tau);
      const float2 v = make_float2(mag * __builtin_amdgcn_cosf(rf), mag * __builtin_amdgcn_sinf(rf));
      pw[((size_t)ldg * 65 + tau) * 64 + pp] = v;
      if (tau == 1) { ar = v.x; ai = v.y; }
    }
    const float den = lr * lr + li * li;
    const float fr_ = ((ar - 1.f) * lr + ai * li) / den, fi_ = (ai * lr - (ar - 1.f) * li) / den;
    for (int j = 0; j < 16; ++j) {
      const float br = p.s5_b_re[(size_t)i * 16 + j], bi = p.s5_b_im[(size_t)i * 16 + j];
      bb[(size_t)i * 16 + j] = make_float2(fr_ * br - fi_ * bi, fr_ * bi + fi_ * br);
    }
  }
  if (gtid < DEPTH) {
    const float* lf = p.diff_lambda + gtid * 128;
    float s1 = 0.f, s2 = 0.f;
    for (int k = 0; k < 32; ++k) { s1 += lf[k] * lf[32 + k]; s2 += lf[64 + k] * lf[96 + k]; }
    const float lam_init = 0.8f - 0.6f * expf(-0.3f * (float)gtid);
    ((float*)(p.ws + O_LAMF))[gtid] = expf(s1) - expf(s2) + lam_init;
  }
  if (gtid < 64) ((int*)(p.ws + O_CNT))[gtid] = 0;
}

DI void phase_p1(const Params& p) {
  const int gtid = blockIdx.x * NTHR + otid(), gsz = gridDim.x * NTHR;
  {
    const float* adap = (const float*)(p.ws + O_ACT);
    float* ada = (float*)(p.ws + O_ADA);
    for (int i = gtid; i < DEPTH * 3 * 6144; i += gsz) {
      const int l = i / (3 * 6144), col = i % 6144;
      ada[i] = ((adap[i] + adap[i + DEPTH * 3 * 6144]) + (adap[i + 2 * DEPTH * 3 * 6144] + adap[i + 3 * DEPTH * 3 * 6144])) + p.b_ada[l * 6144 + col];
    }
  }
  const float2* pw = (const float2*)(p.ws + O_S5PW);
  const float2* bb = (const float2*)(p.ws + O_S5BB);
  float* km = (float*)(p.ws + O_S5K);
  for (int o = gtid; o < DEPTH * 2 * 16 * 64 * 256; o += gsz) {
    const int j2 = o & 15, j = (o >> 4) & 15, tau = (o >> 8) & 63, ldg = o >> 14;
    const float* cr = p.s5_c_re + ((size_t)ldg * 16 + j) * 64;
    const float* ci = p.s5_c_im + ((size_t)ldg * 16 + j) * 64;
    const float2* pwr = pw + ((size_t)ldg * 65 + tau) * 64;
    const float2* bbr = bb + (size_t)ldg * 64 * 16 + j2;
    float s = 0.f;
    for (int pp = 0; pp < 64; ++pp) {
      const float2 a = pwr[pp], b = bbr[pp * 16];
      const float wr_ = cr[pp] * a.x - ci[pp] * a.y, wi_ = cr[pp] * a.y + ci[pp] * a.x;
      s += wr_ * b.x - wi_ * b.y;
    }
    km[o] = s;
  }
}

template <int LOPART = 0>
DI void conv_tile(const float* __restrict__ in, int ld_in, bf16_t* __restrict__ out, int ld_out, const float* __restrict__ rs, int k0, int n0, float* sm) {
  const int tid = otid();
  {
    const int k = tid >> 3, n4 = (tid & 7) * 4;
    float4 v = *(const float4*)(in + (size_t)(k0 + k) * ld_in + n0 + n4);
    if (rs) { const float s = rs[k0 + k]; v.x *= s; v.y *= s; v.z *= s; v.w *= s; }
    sm[(n4 + 0) * 65 + k] = v.x; sm[(n4 + 1) * 65 + k] = v.y; sm[(n4 + 2) * 65 + k] = v.z; sm[(n4 + 3) * 65 + k] = v.w;
  }
  __syncthreads();
  {
    const int n = tid >> 4, k4 = (tid & 15) * 4;
    const float* s = sm + n * 65 + k4;
    float v0 = s[0], v1 = s[1], v2 = s[2], v3 = s[3];
    if (LOPART) { v0 -= bf2f(f2bf(v0)); v1 -= bf2f(f2bf(v1)); v2 -= bf2f(f2bf(v2)); v3 -= bf2f(f2bf(v3)); }
    u32x2 o; o[0] = pack2(v0, v1); o[1] = pack2(v2, v3);
    *(u32x2*)(out + (size_t)(n0 + n) * ld_out + k0 + k4) = o;
  }
  __syncthreads();
}
DI void conv_job(const float* in, int ld_in, size_t in_ms, bf16_t* out, int ld_out, size_t out_ms, const float* rs, int K, int N, int multi, float* sm) {
  const int tk = K >> 6, tn = N >> 5, per = tk * tn, total = per * multi;
  const int tid = otid();
  const int k = tid >> 3, n4 = (tid & 7) * 4, n = tid >> 4, k4 = (tid & 15) * 4;
  for (int t0 = blockIdx.x * 4; t0 < total; t0 += gridDim.x * 4) {
    float4 v[4];
#pragma unroll
    for (int q = 0; q < 4; ++q) {
      const int t = t0 + q;
      if (t < total) {
        const int mi = t / per, tt = t % per, k0 = (tt / tn) * 64, n0 = (tt % tn) * 32;
        v[q] = *(const float4*)(in + (size_t)mi * in_ms + (size_t)(k0 + k) * ld_in + n0 + n4);
        if (rs) { const float sc = rs[k0 + k]; v[q].x *= sc; v[q].y *= sc; v[q].z *= sc; v[q].w *= sc; }
      } else v[q] = make_float4(0.f, 0.f, 0.f, 0.f);
    }
#pragma unroll
    for (int q = 0; q < 4; ++q) { float* s_ = sm + q * 2080; s_[(n4 + 0) * 65 + k] = v[q].x; s_[(n4 + 1) * 65 + k] = v[q].y; s_[(n4 + 2) * 65 + k] = v[q].z; s_[(n4 + 3) * 65 + k] = v[q].w; }
    __syncthreads();
#pragma unroll
    for (int q = 0; q < 4; ++q) {
      const int t = t0 + q;
      if (t < total) {
        const int mi = t / per, tt = t % per, k0 = (tt / tn) * 64, n0 = (tt % tn) * 32;
        const float* s_ = sm + q * 2080 + n * 65 + k4;
        u32x2 o; o[0] = pack2(s_[0], s_[1]); o[1] = pack2(s_[2], s_[3]);
        *(u32x2*)(out + (size_t)mi * out_ms + (size_t)(n0 + n) * ld_out + k0 + k4) = o;
      }
    }
    __syncthreads();
  }
}
DI void phase_prep(const Params& p, int l, char* lds) {
  float* sm = (float*)lds;
  GPTR wsg_ = (GPTR)p.ws; asm volatile("" : "+s"(wsg_)); char* ws = (char*)wsg_;
  const int tid = otid(), gtid = blockIdx.x * NTHR + tid, gsz = gridDim.x * NTHR;
  unsigned z0_ = 0u; asm volatile("" : "+v"(z0_));
  const u32x4 zero4 = u32x4{z0_, z0_, z0_, z0_};
  conv_job(p.w_in + (size_t)l * 1024 * INW, INW, 0, (bf16_t*)(ws + O_WIN), 1024, 0, nullptr, 1024, 2208, 1, sm);
  for (int i = gtid; i < 96 * 1024 / 8; i += gsz) ((u32x4*)(ws + O_WIN + (size_t)2208 * 1024 * 2))[i] = zero4;
  conv_job(p.w_in + (size_t)l * 1024 * INW + 2208, INW, 0, (bf16_t*)(ws + O_WG), 1024, 0, nullptr, 1024, 4096, 1, sm);
  conv_job(p.w_mla_uq + (size_t)l * 256 * 384, 384, 0, (bf16_t*)(ws + O_WUQ), 256, 0, p.g_mla_q + l * 256, 256, 384, 1, sm);
  conv_job(p.w_mla_ukv + (size_t)l * 128 * 512, 512, 0, (bf16_t*)(ws + O_WUKV), 128, 0, p.g_mla_kv + l * 128, 128, 512, 1, sm);
  conv_job(p.w_glu + (size_t)l * 65536, 256, 0, (bf16_t*)(ws + O_WGLU), 256, 0, nullptr, 256, 256, 1, sm);
  conv_job(p.w_branch + (size_t)l * 4 * 262144, 1024, 262144, (bf16_t*)(ws + O_WBR), 256, 262144, nullptr, 256, 1024, 4, sm);
  conv_job(p.w_out + (size_t)l * 1048576, 1024, 0, (bf16_t*)(ws + O_WOUT), 1024, 0, nullptr, 1024, 1024, 1, sm);
  conv_job(p.w_e1 + (size_t)l * 64 * 262144, 256, 262144, (bf16_t*)(ws + O_WE1), 1024, 262144, nullptr, 1024, 256, 64, sm);
  conv_job(p.w_e3 + (size_t)l * 64 * 262144, 256, 262144, (bf16_t*)(ws + O_WE3), 1024, 262144, nullptr, 1024, 256, 64, sm);
  conv_job(p.w_e2 + (size_t)l * 64 * 262144, 1024, 262144, (bf16_t*)(ws + O_WE2), 256, 262144, nullptr, 256, 1024, 64, sm);
  conv_job(p.w_s1 + (size_t)l * 262144, 256, 0, (bf16_t*)(ws + O_WE1) + (size_t)64 * 262144, 1024, 0, nullptr, 1024, 256, 1, sm);
  conv_job(p.w_s3 + (size_t)l * 262144, 256, 0, (bf16_t*)(ws + O_WE3) + (size_t)64 * 262144, 1024, 0, nullptr, 1024, 256, 1, sm);
  conv_job(p.w_s2 + (size_t)l * 262144, 1024, 0, (bf16_t*)(ws + O_WE2) + (size_t)64 * 262144, 256, 0, nullptr, 256, 1024, 1, sm);
  for (int t = blockIdx.x; t < 32; t += gridDim.x) {
    conv_tile<0>(p.w_router + (size_t)l * 65536, 64, (bf16_t*)(ws + O_WRHI), 1024, nullptr, (t >> 1) * 64, (t & 1) * 32, sm);
    conv_tile<1>(p.w_router + (size_t)l * 65536, 64, (bf16_t*)(ws + O_WRLO), 1024, nullptr, (t >> 1) * 64, (t & 1) * 32, sm);
  }
  for (int i = gtid; i < 64 * 1024 / 8; i += gsz) { ((u32x4*)(ws + O_WRHI + 64 * 1024 * 2))[i] = zero4; ((u32x4*)(ws + O_WRLO + 64 * 1024 * 2))[i] = zero4; }
  const float2* pw = (const float2*)(ws + O_S5PW) + (size_t)l * 2 * 16 * 65 * 64;
  const float2* bbv = (const float2*)(ws + O_S5BB) + (size_t)l * 2 * 16 * 64 * 16;
  const float* km = (const float*)(ws + O_S5K) + (size_t)l * 2 * 16 * 64 * 256;
  const float* cre = p.s5_c_re + (size_t)l * 2 * 16 * 16 * 64;
  const float* cim = p.s5_c_im + (size_t)l * 2 * 16 * 16 * 64;
  bf16_t* b2 = (bf16_t*)(ws + O_S5B2);
#pragma unroll 1
  for (int it0 = gtid; it0 < 16 * 1024 * 128; it0 += gsz * 4) {
    float4 fa[4][2], fb[4][2]; float dd[4];
#pragma unroll
    for (int u = 0; u < 4; ++u) {
      const int it = it0 + u * gsz;
      const float4 z4 = make_float4(0.f, 0.f, 0.f, 0.f);
      fa[u][0] = z4; fa[u][1] = z4; fb[u][0] = z4; fb[u][1] = z4; dd[u] = 0.f;
      if (it < 16 * 1024 * 128) {
        const int kc = it & 127, gn = it >> 7, n = gn & 1023, g = gn >> 10, i = n >> 4, j = n & 15, k0 = kc * 8, i2 = k0 >> 4, jb = k0 & 15;
        if (i2 <= i) { const float4* q_ = (const float4*)(km + ((((size_t)0 * 16 + g) * 64 + (i - i2)) * 16 + j) * 16 + jb); fa[u][0] = q_[0]; fa[u][1] = q_[1]; }
        if (i2 >= i) { const float4* q_ = (const float4*)(km + ((((size_t)1 * 16 + g) * 64 + (i2 - i)) * 16 + j) * 16 + jb); fb[u][0] = q_[0]; fb[u][1] = q_[1]; }
        if (i2 == i && (j >> 3) == (jb >> 3)) dd[u] = p.s5_d[(l * 16 + g) * 16 + j];
      }
    }
#pragma unroll
    for (int u = 0; u < 4; ++u) {
      const int it = it0 + u * gsz;
      if (it < 16 * 1024 * 128) {
        const int kc = it & 127, gn = it >> 7, j = gn & 15, k0 = kc * 8;
        float v[8] = {0.f + fa[u][0].x + fb[u][0].x, 0.f + fa[u][0].y + fb[u][0].y, 0.f + fa[u][0].z + fb[u][0].z, 0.f + fa[u][0].w + fb[u][0].w,
                      0.f + fa[u][1].x + fb[u][1].x, 0.f + fa[u][1].y + fb[u][1].y, 0.f + fa[u][1].z + fb[u][1].z, 0.f + fa[u][1].w + fb[u][1].w};
#pragma unroll
        for (int e = 0; e < 8; ++e) if (e == (j & 7)) v[e] += dd[u];
        u32x4 o; o[0] = pack2(v[0], v[1]); o[1] = pack2(v[2], v[3]); o[2] = pack2(v[4], v[5]); o[3] = pack2(v[6], v[7]);
        *(u32x4*)(b2 + ((size_t)gn * 1280 + k0)) = o;
      }
    }
  }
#pragma unroll 1
  for (int it0 = gtid; it0 < 16 * 1024 * 32; it0 += gsz * 2) {
    float4 cr4[2][2], ci4[2][2], pw4[2][4];
#pragma unroll
    for (int u = 0; u < 2; ++u) {
      const int it = it0 + u * gsz;
      if (it < 16 * 1024 * 32) {
        const int kq = it & 31, gn = it >> 5, n = gn & 1023, g = gn >> 10, i = n >> 4, j = n & 15;
        const int d = kq >> 4, kk = (kq & 15) * 8, p0 = kk & 63, tau = d ? 64 - i : i + 1;
        const float4* c1 = (const float4*)(cre + (((size_t)d * 16 + g) * 16 + j) * 64 + p0);
        const float4* c2 = (const float4*)(cim + (((size_t)d * 16 + g) * 16 + j) * 64 + p0);
        const float4* c3 = (const float4*)(pw + (((size_t)d * 16 + g) * 65 + tau) * 64 + p0);
        cr4[u][0] = c1[0]; cr4[u][1] = c1[1]; ci4[u][0] = c2[0]; ci4[u][1] = c2[1];
        pw4[u][0] = c3[0]; pw4[u][1] = c3[1]; pw4[u][2] = c3[2]; pw4[u][3] = c3[3];
      }
    }
#pragma unroll
    for (int u = 0; u < 2; ++u) {
      const int it = it0 + u * gsz;
      if (it < 16 * 1024 * 32) {
        const int kq = it & 31, gn = it >> 5, kk = (kq & 15) * 8, ri = kk >> 6;
        const float cr[8] = {cr4[u][0].x, cr4[u][0].y, cr4[u][0].z, cr4[u][0].w, cr4[u][1].x, cr4[u][1].y, cr4[u][1].z, cr4[u][1].w};
        const float ci[8] = {ci4[u][0].x, ci4[u][0].y, ci4[u][0].z, ci4[u][0].w, ci4[u][1].x, ci4[u][1].y, ci4[u][1].z, ci4[u][1].w};
        const float ax[8] = {pw4[u][0].x, pw4[u][0].z, pw4[u][1].x, pw4[u][1].z, pw4[u][2].x, pw4[u][2].z, pw4[u][3].x, pw4[u][3].z};
        const float ay[8] = {pw4[u][0].y, pw4[u][0].w, pw4[u][1].y, pw4[u][1].w, pw4[u][2].y, pw4[u][2].w, pw4[u][3].y, pw4[u][3].w};
        float v[8];
#pragma unroll
        for (int e = 0; e < 8; ++e) {
          const float wr_ = cr[e] * ax[e] - ci[e] * ay[e], wi_ = cr[e] * ay[e] + ci[e] * ax[e];
          v[e] = ri == 0 ? wr_ : -wi_;
        }
        u32x4 o; o[0] = pack2(v[0], v[1]); o[1] = pack2(v[2], v[3]); o[2] = pack2(v[4], v[5]); o[3] = pack2(v[6], v[7]);
        *(u32x4*)(b2 + ((size_t)gn * 1280 + 1024 + kq * 8)) = o;
      }
    }
  }
  bf16_t* b1 = (bf16_t*)(ws + O_S5B1);
#pragma unroll 1
  for (int it0 = gtid; it0 < 16 * 256 * 128; it0 += gsz * 2) {
    float2 a2[2]; float4 b4[2][4];
#pragma unroll
    for (int u = 0; u < 2; ++u) {
      const int it = it0 + u * gsz;
      if (it < 16 * 256 * 128) {
        const int kc = it & 127, gn = it >> 7, n = gn & 255, g = gn >> 8;
        const int d = n >> 7, pp = n & 63, k0 = kc * 8, s = k0 >> 4, jb = k0 & 15;
        a2[u] = pw[(((size_t)d * 16 + g) * 65 + (d ? s : 63 - s)) * 64 + pp];
        const float4* q_ = (const float4*)(bbv + (((size_t)d * 16 + g) * 64 + pp) * 16 + jb);
        b4[u][0] = q_[0]; b4[u][1] = q_[1]; b4[u][2] = q_[2]; b4[u][3] = q_[3];
      }
    }
#pragma unroll
    for (int u = 0; u < 2; ++u) {
      const int it = it0 + u * gsz;
      if (it < 16 * 256 * 128) {
        const int kc = it & 127, gn = it >> 7, n = gn & 255, ri = (n >> 6) & 1, k0 = kc * 8;
        const float2 a = a2[u];
        const float bx[8] = {b4[u][0].x, b4[u][0].z, b4[u][1].x, b4[u][1].z, b4[u][2].x, b4[u][2].z, b4[u][3].x, b4[u][3].z};
        const float by[8] = {b4[u][0].y, b4[u][0].w, b4[u][1].y, b4[u][1].w, b4[u][2].y, b4[u][2].w, b4[u][3].y, b4[u][3].w};
        float v[8];
#pragma unroll
        for (int e = 0; e < 8; ++e) v[e] = ri == 0 ? (a.x * bx[e] - a.y * by[e]) : (a.x * by[e] + a.y * bx[e]);
        u32x4 o; o[0] = pack2(v[0], v[1]); o[1] = pack2(v[2], v[3]); o[2] = pack2(v[4], v[5]); o[3] = pack2(v[6], v[7]);
        *(u32x4*)(b1 + ((size_t)gn * 1024 + k0)) = o;
      }
    }
  }
}

DI void phase_rows(const Params& p, int l, float rscale = 1.f) {
  GPTR wsg_ = (GPTR)p.ws; asm volatile("" : "+s"(wsg_)); char* ws = (char*)wsg_;
  const int tid_ = otid(), lane = tid_ & 63, gw = blockIdx.x * 8 + (tid_ >> 6), nw = gridDim.x * 8;
  bf16_t* X = (bf16_t*)(ws + O_X);
  bf16_t* H1 = (bf16_t*)(ws + O_H1);
  const unsigned char* Y = (const unsigned char*)(ws + O_R);
  const int* slot = (const int*)(ws + O_SLOT);
  const float* gwt = (const float*)(ws + O_GW);
  const int* cnt = (const int*)(ws + O_CNT);
  const float* ada = (const float*)(ws + O_ADA);
  int poff64 = 0;
  if (l > 0) { for (int e = 0; e < 64; ++e) poff64 += (cnt[e] + 255) & ~255; }
  for (int row = gw; row < NTOK; row += nw) {
    int b, isctx, t; tokinfo(row, b, isctx, t);
    const int cv = isctx ? 2 : b;
    float xv[16];
    if (l == 0) {
      const float* src = isctx ? p.ctx + (size_t)(b * 256 + t) * 1024 : p.x + (size_t)row * 1024;
#pragma unroll
      for (int i = 0; i < 4; ++i) { const float4 v = *(const float4*)(src + i * 256 + lane * 4); xv[i * 4] = v.x; xv[i * 4 + 1] = v.y; xv[i * 4 + 2] = v.z; xv[i * 4 + 3] = v.w; }
    } else {
      const bf16_t* src = X + (size_t)row * 1024;
#pragma unroll
      for (int i = 0; i < 4; ++i) { const u32x2 v = *(const u32x2*)(src + i * 256 + lane * 4);
        xv[i * 4] = __uint_as_float(v[0] << 16); xv[i * 4 + 1] = __uint_as_float(v[0] & 0xffff0000u); xv[i * 4 + 2] = __uint_as_float(v[1] << 16); xv[i * 4 + 3] = __uint_as_float(v[1] & 0xffff0000u); }
      float f[16];
      typedef float fl2v __attribute__((ext_vector_type(2)));
      {
        const bf16_t* ys = (const bf16_t*)(ws + O_R + (size_t)YROWS * 1024) + (size_t)row * 1024;
#pragma unroll
        for (int i = 0; i < 4; ++i) { const u32x2 v = *(const u32x2*)(ys + i * 256 + lane * 4);
          f[i * 4] = rscale * __uint_as_float(v[0] << 16); f[i * 4 + 1] = rscale * __uint_as_float(v[0] & 0xffff0000u); f[i * 4 + 2] = rscale * __uint_as_float(v[1] << 16); f[i * 4 + 3] = rscale * __uint_as_float(v[1] & 0xffff0000u); }
      }
      int sv = 0; float wv = 0.f;
      if (lane < 6) { sv = slot[row * 6 + lane]; wv = gwt[row * 6 + lane] * rscale * 0.0625f; }
      int yv[6][4];
#pragma unroll
      for (int k = 0; k < 6; ++k) {
        const int s = __builtin_amdgcn_readlane(sv, k);
        const unsigned char* ys = Y + (size_t)s * 1024;
#pragma unroll
        for (int i = 0; i < 4; ++i) yv[k][i] = *(const int*)(ys + i * 256 + lane * 4);
      }
#pragma unroll
      for (int k = 0; k < 6; ++k) {
        const float w = __int_as_float(__builtin_amdgcn_readlane(__float_as_int(wv), k));
#pragma unroll
        for (int i = 0; i < 4; ++i) {
          const fl2v lo = __builtin_amdgcn_cvt_pk_f32_fp8(yv[k][i], false), hi = __builtin_amdgcn_cvt_pk_f32_fp8(yv[k][i], true);
          f[i * 4] += w * lo[0]; f[i * 4 + 1] += w * lo[1]; f[i * 4 + 2] += w * hi[0]; f[i * 4 + 3] += w * hi[1]; }
      }
      const float* gt2 = ada + ((l - 1) * 3 + cv) * 6144 + 5 * 1024;
#pragma unroll
      for (int i = 0; i < 4; ++i) { const float4 g = *(const float4*)(gt2 + i * 256 + lane * 4);
        xv[i * 4] += g.x * f[i * 4]; xv[i * 4 + 1] += g.y * f[i * 4 + 1]; xv[i * 4 + 2] += g.z * f[i * 4 + 2]; xv[i * 4 + 3] += g.w * f[i * 4 + 3]; }
    }
    float ss = 0.f;
#pragma unroll
    for (int i = 0; i < 16; ++i) ss += xv[i] * xv[i];
    ss = wave_sum(ss, lane);
    const float rstd = rsqrtf(ss * (1.f / 1024.f) + EPS);
    if (l < DEPTH) {
      bf16_t* dst = X + (size_t)row * 1024;
#pragma unroll
      for (int i = 0; i < 4; ++i) { u32x2 o2; o2[0] = pack2(xv[i * 4], xv[i * 4 + 1]); o2[1] = pack2(xv[i * 4 + 2], xv[i * 4 + 3]); *(u32x2*)(dst + i * 256 + lane * 4) = o2; }
      const float* gn = p.g_norm1 + l * 1024;
      const float* sh = ada + (l * 3 + cv) * 6144;
      const float* sc = sh + 1024;
      bf16_t* hd = H1 + (size_t)row * 1024;
#pragma unroll
      for (int i = 0; i < 4; ++i) {
        const int o = i * 256 + lane * 4;
        const float4 g = *(const float4*)(gn + o), s1 = *(const float4*)(sh + o), s2 = *(const float4*)(sc + o);
        const float h0 = xv[i * 4] * rstd * g.x * (1.f + s2.x) + s1.x, h1 = xv[i * 4 + 1] * rstd * g.y * (1.f + s2.y) + s1.y;
        const float h2 = xv[i * 4 + 2] * rstd * g.z * (1.f + s2.z) + s1.z, h3 = xv[i * 4 + 3] * rstd * g.w * (1.f + s2.w) + s1.w;
        u32x2 o2; o2[0] = pack2(h0, h1); o2[1] = pack2(h2, h3);
        *(u32x2*)(hd + o) = o2;
      }
    } else if (!isctx) {
      float* dst = p.out + (size_t)row * 1024;
#pragma unroll
      for (int i = 0; i < 4; ++i) {
        const int o = i * 256 + lane * 4;
        const float4 g = *(const float4*)(p.g_final + o);
        *(float4*)(dst + o) = make_float4(xv[i * 4] * rstd * g.x, xv[i * 4 + 1] * rstd * g.y, xv[i * 4 + 2] * rstd * g.z, xv[i * 4 + 3] * rstd * g.w);
      }
    }
  }
}

#define EPI_ROW_BEGIN \
  _Pragma("unroll") for (int m = 0; m < 4; ++m) { \
    int row = m0 + wr * 64 + m * 16 + fr; asm volatile("" : "+v"(row)); \
    int b, isctx, t; tokinfo(row, b, isctx, t); const int kidx = isctx ? SEQ + t : t; (void)kidx;
#define EPI_ROW_END }
DI f32x4 rope4(const f32x4& v, int c4, int half, int t, const float2* roper, const float2* ropec) {
  f32x4 r;
#pragma unroll
  for (int j = 0; j < 4; ++j) { const float partner = xhalf_get(v[j], c4 >> 3); r[j] = rope_apply(v[j], partner, c4 + j, half, t, roper, ropec); }
  return r;
}
DI void phase_proj(const Params& p, char* lds) {
  GPTR wsg_ = (GPTR)p.ws; asm volatile("" : "+s"(wsg_)); char* ws = (char*)wsg_;
  const float2* roper = (const float2*)(ws + O_ROPER);
  const float2* ropec = (const float2*)(ws + O_ROPEC);
  const UM um(130, 9);
  int mt, ntile;
  for (int k = 0; um.get(k, mt, ntile); ++k) {
    const int m0 = mt * 256, n0 = ntile * 256;
    f32x4 acc[2][2][4][2]; zero_acc8(acc);
    asm volatile("s_waitcnt vmcnt(0)" ::: "memory");
    gemm8<false>(acc, (const bf16_t*)(ws + O_H1), nullptr, m0, (const bf16_t*)(ws + O_WIN) + (size_t)n0 * 1024, (const bf16_t*)(ws + O_WIN) + (size_t)(n0 + 128) * 1024, 1024, lds);
    const int tid = otid(), lane = tid & 63, wid = tid >> 6, wr = wid >> 2, wc = wid & 3, fr = lane & 15, fq = lane >> 4, c4 = fq * 4;
#define EPI8_BEGIN \
    _Pragma("unroll") for (int ai = 0; ai < 2; ++ai) _Pragma("unroll") for (int m = 0; m < 4; ++m) { \
      int row = m0 + ai * 128 + wr * 64 + m * 16 + fr; asm volatile("" : "+v"(row)); \
      int b, isctx, t; tokinfo(row, b, isctx, t); const int kidx = isctx ? SEQ + t : t; (void)kidx; \
      _Pragma("unroll") for (int n = 0; n < 2; ++n) { const int c16 = cb + wc * 32 + n * 16; const f32x4 v = acc[ai][bj][m][n];
#define EPI8_END } }
#pragma unroll
    for (int bj = 0; bj < 2; ++bj) {
      const int cb = n0 + bj * 128, ont = cb >> 7;
      if (ont < 6) {
        const int which = cb >> 8;
        bf16_t* dst = (bf16_t*)(ws + (which == 0 ? O_QN : (which == 1 ? O_KN : O_VN)));
        const float sc = which == 0 ? NA_QS : 1.f;
        EPI8_BEGIN
          const int head = (c16 >> 6) & 3, d = (c16 & 63) + c4;
          bf16_t* hb = dst + (size_t)(b * 4 + head) * KLEN * 64;
          const size_t off = which == 0 ? (size_t)kidx * 64 + d : (which == 1 ? kimg<64>(kidx, d) : vimg(kidx, d));
          *(u32x2*)(hb + off) = pack4(v * sc);
        EPI8_END
      } else if (ont < 10) {
        const int isk = ont >= 8;
        bf16_t *QdL = (bf16_t*)(ws + O_QDL), *QdR = (bf16_t*)(ws + O_QDR), *Kd = (bf16_t*)(ws + O_KD);
        EPI8_BEGIN
          const int cc = c16 - (isk ? 1024 : 768), head8 = cc >> 5, half = (cc >> 4) & 1, d = half * 16 + c4;
          const f32x4 rv = rope4(v, c4, half, t, roper, ropec);
          if (!isk) {
            *(u32x2*)(QdR + ((size_t)(b * 8 + head8) * KLEN + kidx) * 32 + d) = pack4(v * DIFF_QS);
            if (!isctx) *(u32x2*)(QdL + ((size_t)(b * 8 + head8) * SEQ + t) * 32 + d) = pack4(rv * DIFF_QS);
          } else {
            *(u32x2*)(Kd + (size_t)(b * 8 + head8) * KLEN * 32 + kimg<32>(kidx, d)) = pack4(isctx ? v : rv);
          }
        EPI8_END
      } else if (ont < 12) {
        bf16_t* Vd = (bf16_t*)(ws + O_VD);
        EPI8_BEGIN
          const int cc = c16 - 1280, head = cc >> 6, d = (cc & 63) + c4;
          *(u32x2*)(Vd + (size_t)(b * 4 + head) * KLEN * 64 + vimg(kidx, d)) = pack4(v);
        EPI8_END
      } else if (ont < 15) {
        bf16_t* dst = ont < 14 ? (bf16_t*)(ws + O_CQ) : (bf16_t*)(ws + O_CKV);
        const int ldd = ont < 14 ? 256 : 128, base = ont < 14 ? 1536 : 1792;
        EPI8_BEGIN
          *(u32x2*)(dst + (size_t)row * ldd + (c16 - base) + c4) = pack4(v);
        EPI8_END
      } else {
        bf16_t *Km = (bf16_t*)(ws + O_KM), *Uc = (bf16_t*)(ws + O_UCAT);
        EPI8_BEGIN
          if (c16 < 1952) {
            const int half = ((c16 - 1920) >> 4) & 1, d = half * 16 + c4;
            const f32x4 rv = rope4(v, c4, half, t, roper, ropec);
            const u32x2 o = pack4(isctx ? v : rv);
#pragma unroll
            for (int h = 0; h < 4; ++h) *(u32x2*)(Km + (size_t)(b * 4 + h) * KLEN * 96 + kimg<96>(kidx, 64 + d)) = o;
          } else if (c16 < 2208) {
            const int g = (c16 - 1952) >> 4;
            const int sp = isctx ? t : 256 + t;
            *(u32x2*)(Uc + ((size_t)(g * 520 + b * NCHUNK + (sp >> 6)) * 1280) + (sp & 63) * 16 + c4) = pack4(v);
          }
        EPI8_END
      }
    }
#undef EPI8_BEGIN
#undef EPI8_END
  }
}

template <int NI>
DI void row_scales(const bf16_t* A, int row0, int kd, float* rs, int lane) {
  const int r_ = lane >> 2, q_ = lane & 3;
  u32x4 v[2][NI];
#pragma unroll
  for (int ps = 0; ps < 2; ++ps)
#pragma unroll
    for (int i = 0; i < NI; ++i) v[ps][i] = *(const u32x4*)(A + (size_t)(row0 + ps * 16 + r_) * kd + (i * 4 + q_) * 8);
#pragma unroll
  for (int ps = 0; ps < 2; ++ps) {
    float s = 0.f;
#pragma unroll
    for (int i = 0; i < NI; ++i)
#pragma unroll
      for (int e = 0; e < 4; ++e) { const float a = __uint_as_float(v[ps][i][e] << 16), b_ = __uint_as_float(v[ps][i][e] & 0xffff0000u); s += a * a; s += b_ * b_; }
    s += bperm(s, lane ^ 1); s += bperm(s, lane ^ 2);
    if (q_ == 0) rs[ps * 16 + r_] = rsqrtf(s / (float)kd + EPS);
  }
}
DI void phase_up(const Params& p, char* lds) {
  GPTR wsg_ = (GPTR)p.ws; asm volatile("" : "+s"(wsg_)); char* ws = (char*)wsg_;
  const int tid = otid(), lane = tid & 63, wid = tid >> 6, wr = wid >> 1, wc = wid & 1, fr = lane & 15, fq = lane >> 4, c4 = fq * 4;
  const float2* roper = (const float2*)(ws + O_ROPER);
  const float2* ropec = (const float2*)(ws + O_ROPEC);
  const bf16_t *CQ = (const bf16_t*)(ws + O_CQ), *CKV = (const bf16_t*)(ws + O_CKV);
  bf16_t *QmL = (bf16_t*)(ws + O_QML), *QmR = (bf16_t*)(ws + O_QMR), *Km = (bf16_t*)(ws + O_KM), *Vm = (bf16_t*)(ws + O_VM);
  float* rs = (float*)(lds + GEMM_LDS);
  auto job = [&](int u) {
    if (u < 390) return gj_make(CQ, nullptr, 256, (u / 3) * 256, (const bf16_t*)(ws + O_WUQ), 256, (u % 3) * 128, 256);
    if (u < 910) { const int uu = u - 390; return gj_make(CKV, nullptr, 128, (uu / 4) * 256, (const bf16_t*)(ws + O_WUKV), 128, (uu % 4) * 128, 128); }
    if (u < 1006) { const int uu = u - 910, g = uu / 6; return gj_make((const bf16_t*)(ws + O_UCAT) + (size_t)g * 520 * 1280, nullptr, 1280, ((uu % 6) >> 1) * 256, (const bf16_t*)(ws + O_S5B1) + (size_t)g * 256 * 1024, 1024, (uu & 1) * 128, 1024); }
    return gj_none();
  };
  GStream<GNST> gs; gs.start(job(blockIdx.x), lds, tid);
  for (int u = blockIdx.x; u < 1006; u += gridDim.x) {
    f32x4 acc[4][4]; zero_acc(acc);
    if (u < 910) {
      const bool isq = u < 390;
      const int uu = isq ? u : u - 390;
      const int mt = isq ? uu / 3 : uu / 4, ntile = isq ? uu % 3 : uu % 4, m0 = mt * 256, n0 = ntile * 128;
      const int kd = isq ? 256 : 128;
      const bf16_t* A = isq ? CQ : CKV;
      if (isq) row_scales<8>(A, m0 + wid * 32, 256, rs + wid * 32, lane); else row_scales<4>(A, m0 + wid * 32, 128, rs + wid * 32, lane);
      gs.run2(acc, job(u + gridDim.x));
#pragma unroll
      for (int m = 0; m < 4; ++m) {
        int lr = wr * 64 + m * 16 + fr;
        asm volatile("" : "+v"(lr));
        const int row = m0 + lr;
        int b, isctx, t; tokinfo(row, b, isctx, t);
        const int kidx = isctx ? SEQ + t : t;
        const float rsc = rs[lr];
#pragma unroll
        for (int n = 0; n < 4; ++n) {
          const int c16 = n0 + wc * 64 + n * 16;
          if (isq) {
            const int head = c16 / 96, dd = c16 % 96, d = dd + c4;
            const f32x4 v = acc[m][n] * (rsc * MLA_QS);
            bf16_t* qr_ = QmR + ((size_t)(b * 4 + head) * KLEN + kidx) * 96 + d;
            bf16_t* ql_ = QmL + ((size_t)(b * 4 + head) * SEQ + t) * 96 + d;
            if (dd < 64) {
              const u32x2 o = pack4(v);
              *(u32x2*)qr_ = o;
              if (!isctx) *(u32x2*)ql_ = o;
            } else {
              const f32x4 rv = rope4(v, c4, (dd >> 4) & 1, t, roper, ropec);
              *(u32x2*)qr_ = pack4(v);
              if (!isctx) *(u32x2*)ql_ = pack4(rv);
            }
          } else {
            const int head = c16 >> 7, dd = c16 & 127, d = dd + c4;
            const f32x4 v = acc[m][n] * rsc;
            if (dd < 64) *(u32x2*)(Km + (size_t)(b * 4 + head) * KLEN * 96 + kimg<96>(kidx, d)) = pack4(v);
            else *(u32x2*)(Vm + (size_t)(b * 4 + head) * KLEN * 64 + vimg(kidx, d - 64)) = pack4(v);
          }
        }
      }
      asm volatile("s_waitcnt lgkmcnt(0)" ::: "memory"); __builtin_amdgcn_s_barrier();
    } else {
      const int uu = u - 910, g = uu / 6, mt = (uu % 6) >> 1, ntile = uu & 1, m0 = mt * 256, n0 = ntile * 128;
      gs.run2(acc, job(u + gridDim.x));
      float* sloc = (float*)(ws + O_SLOC) + (size_t)g * 520 * 256;
#pragma unroll
      for (int m = 0; m < 4; ++m) {
        const int row = m0 + wr * 64 + m * 16 + fr;
        if (row < 520) {
#pragma unroll
          for (int n = 0; n < 4; ++n) *(f32x4*)(sloc + (size_t)row * 256 + n0 + wc * 64 + n * 16 + c4) = acc[m][n];
        }
      }
    }
  }
}

constexpr int ATT_NST = 4, ATT_STG = 20480, ATT_RPB = ATT_NST * ATT_STG, ATT_LDS = ATT_RPB + 2048;
template <int DK, int NMAP, int MODE, bool FAST>
DI void attn_unit(const bf16_t* const (&Qlat)[NMAP], const bf16_t* const (&Qraw)[NMAP], const bf16_t* const (&Kp)[NMAP], const bf16_t* Vp,
                  int qb, char* lds, float (&lout)[NMAP], f32x16 (&o)[NMAP][2], const float* rpbL) {
  constexpr int KS = DK / 16, KMAP = DK * 128, KBYTES = NMAP * KMAP;
  constexpr int NPOS = KBYTES / 16, KR = (NPOS + NTHR - 1) / NTHR, LPS = KR + 1;
  const int tid = otid(), lane = tid & 63, wid = tid >> 6, r32 = lane & 31, hi = lane >> 5;
  const int qrow = (MODE == 2 ? SEQ : qb * 256) + wid * 32 + r32;
  bf16x8 qf[NMAP][KS];
#pragma unroll
  for (int m = 0; m < NMAP; ++m)
#pragma unroll
    for (int s = 0; s < KS; ++s) qf[m][s] = *(const bf16x8*)((MODE == 0 ? Qlat[m] : Qraw[m]) + (size_t)qrow * DK + s * 16 + hi * 8);
  float mrun[NMAP], lrun[NMAP];
#pragma unroll
  for (int m = 0; m < NMAP; ++m) { mrun[m] = -1e30f; lrun[m] = 0.f; o[m][0] = f32x16{}; o[m][1] = f32x16{}; }
  int kt_lo = 0, kt_hi = 260;
  const int rq = qb * 4 + (wid >> 1), cq = (wid & 1) * 32 + r32;
  if (MODE == 1) { int lo = qb * 4 - 4; lo = lo < 0 ? 0 : (lo > 248 ? 248 : lo); int hi_ = qb * 4 + 3 - 4; hi_ = hi_ < 0 ? 0 : (hi_ > 248 ? 248 : hi_); kt_lo = lo; kt_hi = hi_ + 8; }
  if (MODE == 2) { kt_lo = 256; kt_hi = 260; }
  const int ntile = (MODE == 1) ? (kt_hi - kt_lo + 4) : (kt_hi - kt_lo);
  auto tile_of = [&](int i) { return (MODE == 1 && i >= kt_hi - kt_lo) ? 256 + (i - (kt_hi - kt_lo)) : kt_lo + i; };
  const bf16_t* ksrc[KR];
  int kdst[KR];
#pragma unroll
  for (int i = 0; i < KR; ++i) {
    int q = tid + i * NTHR; if (q >= NPOS) q -= NTHR;
    const int m = q / (KMAP / 16), w = q % (KMAP / 16);
    ksrc[i] = ((NMAP == 2 && m == 1) ? Kp[NMAP - 1] : Kp[0]) + w * 8;
    kdst[i] = q * 16;
  }
  const bf16_t* vsrc = Vp + tid * 8;
  auto issue = [&](int i) {
    const int kt = tile_of(i);
    char* sb = lds + (i % ATT_NST) * ATT_STG;
#pragma unroll
    for (int r = 0; r < KR; ++r) glds16(ksrc[r] + (size_t)kt * 64 * DK, (unsigned)__builtin_amdgcn_readfirstlane((int)(unsigned)(uintptr_t)(sb + kdst[r])));
    glds16(vsrc + (size_t)kt * 4096, (unsigned)__builtin_amdgcn_readfirstlane((int)(unsigned)(uintptr_t)(sb + KBYTES + tid * 16)));
  };
  const int voff = KBYTES + ((lane >> 4) & 1) * 32 + (lane & 3) * 8 + (4 * hi + ((lane & 15) >> 2)) * 64;
#pragma unroll
  for (int m = 0; m < NMAP; ++m)
#pragma unroll
    for (int s = 0; s < KS; ++s) asm volatile("" :: "v"(qf[m][s]));
  asm volatile("s_waitcnt vmcnt(0)" ::: "memory");
#pragma unroll
  for (int i = 0; i < ATT_NST - 1; ++i) if (i < ntile) issue(i);
  auto step = [&](int it) {
    const int kt = tile_of(it);
    {
      const int infl = (ntile - 1 - it) < (ATT_NST - 2) ? (ntile - 1 - it) : (ATT_NST - 2);
      if (infl >= 2) { if (LPS == 2) asm volatile("s_waitcnt vmcnt(4)" ::: "memory"); else asm volatile("s_waitcnt vmcnt(6)" ::: "memory"); }
      else if (infl == 1) { if (LPS == 2) asm volatile("s_waitcnt vmcnt(2)" ::: "memory"); else asm volatile("s_waitcnt vmcnt(3)" ::: "memory"); }
      else asm volatile("s_waitcnt vmcnt(0)" ::: "memory");
    }
    __builtin_amdgcn_s_barrier();
    char* buf = lds + (it % ATT_NST) * ATT_STG;
    bool active = true;
    int dr = 0;
    if (MODE == 1 && kt < 256) { int rs_ = rq - 4; rs_ = rs_ < 0 ? 0 : (rs_ > 248 ? 248 : rs_); active = (kt >= rs_) && (kt < rs_ + 8); dr = kt - rq + 7; }
    if (!active) { if (it + ATT_NST - 1 < ntile) issue(it + ATT_NST - 1); }
    if (active) {
      const char* vp0 = buf + voff;
      bf16x8 pf[NMAP][4];
#pragma unroll
      for (int m = 0; m < NMAP; ++m) {
        f32x16 s0 = f32x16{}, s1 = f32x16{};
        const char* kb = buf + m * KMAP + hi * 1024 + r32 * 16;
#pragma unroll
        for (int s = 0; s < KS; ++s) {
          const bf16x8 k0 = *(const bf16x8*)(kb + s * 2048);
          const bf16x8 k1 = *(const bf16x8*)(kb + s * 2048 + 512);
          s0 = MFMA32(k0, qf[m][s], s0);
          s1 = MFMA32(k1, qf[m][s], s1);
        }
        if (MODE == 1 && kt < 256) {
          int cs = cq - 8; cs = cs < 0 ? 0 : (cs > 48 ? 48 : cs);
#pragma unroll
          for (int r = 0; r < 16; ++r) {
            const int ck0 = crow(r, hi), ck1 = 32 + ck0;
            s0[r] = (ck0 >= cs && ck0 < cs + 16) ? s0[r] + rpbL[dr * 31 + (ck0 - cq + 15)] : -1e30f;
            s1[r] = (ck1 >= cs && ck1 < cs + 16) ? s1[r] + rpbL[dr * 31 + (ck1 - cq + 15)] : -1e30f;
          }
        }
        float ps = 0.f;
        if (FAST) {
#pragma unroll
          for (int r = 0; r < 16; ++r) { s0[r] = __builtin_amdgcn_exp2f(s0[r]); s1[r] = __builtin_amdgcn_exp2f(s1[r]); ps += s0[r] + s1[r]; }
          lrun[m] += ps;
        } else {
          float mx = fmaxf(s0[0], s1[0]);
#pragma unroll
          for (int r = 1; r < 16; ++r) mx = fmaxf(mx, fmaxf(s0[r], s1[r]));
          mx = xhalf_max(mx);
          const float mnew = fmaxf(mrun[m], mx);
          const float alpha = __builtin_amdgcn_exp2f(mrun[m] - mnew);
          mrun[m] = mnew;
#pragma unroll
          for (int r = 0; r < 16; ++r) { s0[r] = __builtin_amdgcn_exp2f(s0[r] - mnew); s1[r] = __builtin_amdgcn_exp2f(s1[r] - mnew); ps += s0[r] + s1[r]; }
          lrun[m] = lrun[m] * alpha + ps;
#pragma unroll
          for (int r = 0; r < 16; ++r) { o[m][0][r] *= alpha; o[m][1][r] *= alpha; }
        }
#pragma unroll
        for (int ks = 0; ks < 4; ++ks) {
          u32x4 pk;
#pragma unroll
          for (int e = 0; e < 4; ++e) {
            const int r = (ks & 1) * 8 + e * 2;
            pk[e] = (ks < 2) ? pack2(s0[r], s0[r + 1]) : pack2(s1[r], s1[r + 1]);
          }
          pf[m][ks] = __builtin_bit_cast(bf16x8, pk);
        }
      }
      if (it + ATT_NST - 1 < ntile) issue(it + ATT_NST - 1);
#pragma unroll
      for (int d0 = 0; d0 < 2; ++d0) {
        bf16x8 vf[4];
#pragma unroll
        for (int ks = 0; ks < 4; ++ks) {
          const s16x4 lo = __builtin_bit_cast(s16x4, __builtin_amdgcn_ds_read_tr16_b64_v4i16((__attribute__((address_space(3))) v4i16_t*)(vp0 + d0 * 4096 + ks * 1024)));
          const s16x4 hh = __builtin_bit_cast(s16x4, __builtin_amdgcn_ds_read_tr16_b64_v4i16((__attribute__((address_space(3))) v4i16_t*)(vp0 + d0 * 4096 + ks * 1024 + 512)));
          vf[ks] = bf16x8{lo[0], lo[1], lo[2], lo[3], hh[0], hh[1], hh[2], hh[3]};
        }
#pragma unroll
        for (int m = 0; m < NMAP; ++m)
#pragma unroll
          for (int ks = 0; ks < 4; ++ks) o[m][d0] = MFMA32(vf[ks], pf[m][ks], o[m][d0]);
      }
    }
  };
  const int n1 = MODE == 0 ? 256 : ntile;
#pragma unroll 1
  for (int it = 0; it < n1; ++it) step(it);
  if (MODE == 0) {
#pragma unroll
    for (int m = 0; m < NMAP; ++m)
#pragma unroll
      for (int s = 0; s < KS; ++s) qf[m][s] = *(const bf16x8*)(Qraw[m] + (size_t)qrow * DK + s * 16 + hi * 8);
#pragma unroll
    for (int m = 0; m < NMAP; ++m)
#pragma unroll
      for (int s = 0; s < KS; ++s) asm volatile("" :: "v"(qf[m][s]));
#pragma unroll 1
    for (int it = 256; it < ntile; ++it) step(it);
  }
#pragma unroll
  for (int m = 0; m < NMAP; ++m) lout[m] = xhalf(lrun[m]);
  __syncthreads();
}
DI bool lsum_bad(float l) { return !(l > 1e-18f && l < 1e18f); }
DI bool block_any(bool v, char* lds) {
  volatile LAS int* flg = (volatile LAS int*)(lds + ATT_RPB + 2032);
  if (otid() == 0) *flg = 0;
  __syncthreads();
  if (v) *flg = 1;
  __syncthreads();
  const int r = *flg;
  __syncthreads();
  return r != 0;
}

DI void attn_store(const float (&val)[2][16], bf16_t* ycat, int token, int colbase, int hi) {
#pragma unroll
  for (int d0 = 0; d0 < 2; ++d0)
#pragma unroll
    for (int g = 0; g < 4; ++g) {
      u32x2 v; v[0] = pack2(val[d0][4 * g], val[d0][4 * g + 1]); v[1] = pack2(val[d0][4 * g + 2], val[d0][4 * g + 3]);
      *(u32x2*)(ycat + (size_t)token * 1024 + colbase + d0 * 32 + 8 * g + 4 * hi) = v;
    }
}

template <int MODE>
DI void attn_diff(const Params& p, int l, int b, int h, int qb, char* lds) {
  GPTR wsg_ = (GPTR)p.ws; asm volatile("" : "+s"(wsg_)); char* ws = (char*)wsg_;
  const bf16_t* const ql[2] = {(const bf16_t*)(ws + O_QDL) + (size_t)(b * 8 + 2 * h) * SEQ * 32, (const bf16_t*)(ws + O_QDL) + (size_t)(b * 8 + 2 * h + 1) * SEQ * 32};
  const bf16_t* const qr[2] = {(const bf16_t*)(ws + O_QDR) + (size_t)(b * 8 + 2 * h) * KLEN * 32, (const bf16_t*)(ws + O_QDR) + (size_t)(b * 8 + 2 * h + 1) * KLEN * 32};
  const bf16_t* const kp[2] = {(const bf16_t*)(ws + O_KD) + (size_t)(b * 8 + 2 * h) * KLEN * 32, (const bf16_t*)(ws + O_KD) + (size_t)(b * 8 + 2 * h + 1) * KLEN * 32};
  const bf16_t* vp = (const bf16_t*)(ws + O_VD) + (size_t)(b * 4 + h) * KLEN * 64;
  float lo[2]; f32x16 o[2][2];
  attn_unit<32, 2, MODE, true>(ql, qr, kp, vp, qb, lds, lo, o, nullptr);
  if (block_any(lsum_bad(lo[0]) || lsum_bad(lo[1]), lds)) attn_unit<32, 2, MODE, false>(ql, qr, kp, vp, qb, lds, lo, o, nullptr);
  const int tid_ = otid(), lane = tid_ & 63, wid = tid_ >> 6, r32 = lane & 31, hi = lane >> 5;
  int lq = l; asm volatile("" : "+s"(lq));
  const float lam = ((const float*)(ws + O_LAMF))[lq];
  const float lam_init = 0.8f - 0.6f * expf(-0.3f * (float)lq);
  const float i0 = 1.f / lo[0], i1 = lam / lo[1];
  float d[2][16]; float ss = 0.f;
#pragma unroll
  for (int d0 = 0; d0 < 2; ++d0)
#pragma unroll
    for (int r = 0; r < 16; ++r) { d[d0][r] = o[0][d0][r] * i0 - o[1][d0][r] * i1; ss += d[d0][r] * d[d0][r]; }
  ss = xhalf(ss);
  const float rstd = rsqrtf(ss * (1.f / 64.f) + EPS) * (1.f - lam_init);
  const float* gs = p.g_diff + lq * 64;
#pragma unroll
  for (int d0 = 0; d0 < 2; ++d0)
#pragma unroll
    for (int r = 0; r < 16; ++r) d[d0][r] *= rstd * gs[d0 * 32 + crow(r, hi)];
  const int token = MODE == 2 ? NL + b * 256 + wid * 32 + r32 : b * SEQ + qb * 256 + wid * 32 + r32;
  attn_store(d, (bf16_t*)(ws + O_YCAT), token, 256 + h * 64, hi);
}
template <int MODE>
DI void attn_mla(const Params& p, int b, int h, int qb, char* lds) {
  GPTR wsg_ = (GPTR)p.ws; asm volatile("" : "+s"(wsg_)); char* ws = (char*)wsg_;
  const bf16_t* const ql[1] = {(const bf16_t*)(ws + O_QML) + (size_t)(b * 4 + h) * SEQ * 96};
  const bf16_t* const qr[1] = {(const bf16_t*)(ws + O_QMR) + (size_t)(b * 4 + h) * KLEN * 96};
  const bf16_t* const kp[1] = {(const bf16_t*)(ws + O_KM) + (size_t)(b * 4 + h) * KLEN * 96};
  const bf16_t* vp = (const bf16_t*)(ws + O_VM) + (size_t)(b * 4 + h) * KLEN * 64;
  float lo[1]; f32x16 o[1][2];
  attn_unit<96, 1, MODE, true>(ql, qr, kp, vp, qb, lds, lo, o, nullptr);
  if (block_any(lsum_bad(lo[0]), lds)) attn_unit<96, 1, MODE, false>(ql, qr, kp, vp, qb, lds, lo, o, nullptr);
  const int tid_ = otid(), lane = tid_ & 63, wid = tid_ >> 6, r32 = lane & 31, hi = lane >> 5;
  const float inv = 1.f / lo[0];
  float d[2][16];
#pragma unroll
  for (int d0 = 0; d0 < 2; ++d0)
#pragma unroll
    for (int r = 0; r < 16; ++r) d[d0][r] = o[0][d0][r] * inv;
  const int token = MODE == 2 ? NL + b * 256 + wid * 32 + r32 : b * SEQ + qb * 256 + wid * 32 + r32;
  attn_store(d, (bf16_t*)(ws + O_YCAT), token, 512 + h * 64, hi);
}
template <int MODE>
DI void attn_na(const Params& p, int l, int b, int h, int qb, char* lds) {
  GPTR wsg_ = (GPTR)p.ws; asm volatile("" : "+s"(wsg_)); char* ws = (char*)wsg_;
  float* rpbL = (float*)(lds + ATT_RPB);
  if (MODE == 1) {
    __syncthreads();
    for (int i = otid(); i < 465; i += NTHR) rpbL[i] = p.na_rpb[(size_t)(l * 4 + h) * 465 + i] * LOG2E;
    __syncthreads();
  }
  const bf16_t* const qr[1] = {(const bf16_t*)(ws + O_QN) + (size_t)(b * 4 + h) * KLEN * 64};
  const bf16_t* const kp[1] = {(const bf16_t*)(ws + O_KN) + (size_t)(b * 4 + h) * KLEN * 64};
  const bf16_t* vp = (const bf16_t*)(ws + O_VN) + (size_t)(b * 4 + h) * KLEN * 64;
  float lo[1]; f32x16 o[1][2];
  attn_unit<64, 1, MODE, true>(qr, qr, kp, vp, qb, lds, lo, o, rpbL);
  if (block_any(lsum_bad(lo[0]), lds)) attn_unit<64, 1, MODE, false>(qr, qr, kp, vp, qb, lds, lo, o, rpbL);
  const int tid_ = otid(), lane = tid_ & 63, wid = tid_ >> 6, r32 = lane & 31, hi = lane >> 5;
  const float inv = 1.f / lo[0];
  float d[2][16];
#pragma unroll
  for (int d0 = 0; d0 < 2; ++d0)
#pragma unroll
    for (int r = 0; r < 16; ++r) d[d0][r] = o[0][d0][r] * inv;
  const int token = MODE == 2 ? NL + b * 256 + wid * 32 + r32 : b * SEQ + qb * 256 + wid * 32 + r32;
  attn_store(d, (bf16_t*)(ws + O_YCAT), token, h * 64, hi);
}

DI void phase_attn(const Params& p, int l, char* lds) {
  GPTR wsg_ = (GPTR)p.ws; asm volatile("" : "+s"(wsg_)); char* ws = (char*)wsg_;
  if (blockIdx.x < 8) {
    const int id = blockIdx.x * NTHR + otid();
    const int pp = id & 63, d = (id >> 6) & 1, g = (id >> 7) & 15, b = id >> 11;
    const float2 a64 = ((const float2*)(ws + O_S5PW))[((((size_t)l * 2 + d) * 16 + g) * 65 + 64) * 64 + pp];
    const float* sloc = (const float*)(ws + O_SLOC) + ((size_t)g * 520 + b * NCHUNK) * 256 + d * 128 + pp;
    bf16_t* uc = (bf16_t*)(ws + O_UCAT) + ((size_t)g * 520 + b * NCHUNK) * 1280 + 1024 + d * 128 + pp;
    float hr = 0.f, hi_ = 0.f;
#pragma unroll 1
    for (int s0 = 0; s0 < NCHUNK; s0 += 26) {
      float sr[26], si[26];
#pragma unroll
      for (int j = 0; j < 26; ++j) { const int s = s0 + j, c = d == 0 ? s : (s < 4 ? 3 - s : 263 - s); sr[j] = sloc[(size_t)c * 256]; si[j] = sloc[(size_t)c * 256 + 64]; }
#pragma unroll
      for (int j = 0; j < 26; ++j) {
        const int s = s0 + j, c = d == 0 ? s : (s < 4 ? 3 - s : 263 - s);
        uc[(size_t)c * 1280] = f2bf(hr); uc[(size_t)c * 1280 + 64] = f2bf(hi_);
        const float nr = a64.x * hr - a64.y * hi_ + sr[j], ni = a64.x * hi_ + a64.y * hr + si[j];
        hr = nr; hi_ = ni;
      }
    }
  }
  int x = blockIdx.x & 7; asm volatile("" : "+s"(x));
  const int b = x >> 2, h = x & 3;
  int* qctr = (int*)(ws + O_QCTR) + x * 64;
  volatile LAS int* qw = (volatile LAS int*)(lds + ATT_RPB + 2040);
#pragma unroll 1
  for (;;) {
    if (otid() == 0) *qw = atomicAdd(qctr, 1);
    __syncthreads();
    const int item = *qw;
    __syncthreads();
    if (item >= 195) break;
    if (item < 64) attn_diff<0>(p, l, b, h, item, lds);
    else if (item < 128) attn_mla<0>(p, b, h, item - 64, lds);
    else if (item < 192) attn_na<1>(p, l, b, h, item - 128, lds);
    else if (item == 192) attn_diff<2>(p, l, b, h, 0, lds);
    else if (item == 193) attn_mla<2>(p, b, h, 0, lds);
    else attn_na<2>(p, l, b, h, 0, lds);
  }
}

DI void phase_s5out(const Params& p, char* lds) {
  GPTR wsg_ = (GPTR)p.ws; asm volatile("" : "+s"(wsg_)); char* ws = (char*)wsg_;
  bf16_t* G5 = (bf16_t*)(ws + O_G5);
  const UM um(48, 4);
  int gm, ntile;
  for (int k = 0; um.get(k, gm, ntile); ++k) {
    const int g = gm / 3, m0 = (gm % 3) * 256, n0 = ntile * 256;
    f32x4 acc[2][2][4][2]; zero_acc8(acc);
    asm volatile("s_waitcnt vmcnt(0)" ::: "memory");
    const bf16_t* bw = (const bf16_t*)(ws + O_S5B2) + ((size_t)g * 1024 + n0) * 1280;
    gemm8<false>(acc, (const bf16_t*)(ws + O_UCAT) + (size_t)g * 520 * 1280, nullptr, m0, bw, bw + (size_t)128 * 1280, 1280, lds);
    const int tid = otid(), lane = tid & 63, wid = tid >> 6, wr = wid >> 2, wc = wid & 3, fr = lane & 15, fq = lane >> 4, c4 = fq * 4;
#pragma unroll
    for (int ai = 0; ai < 2; ++ai)
#pragma unroll
      for (int m = 0; m < 4; ++m) {
        int row = m0 + ai * 128 + wr * 64 + m * 16 + fr; asm volatile("" : "+v"(row));
        if (row < 520) {
          const int b = row >= NCHUNK ? 1 : 0, chunk = row - b * NCHUNK;
#pragma unroll
          for (int bj = 0; bj < 2; ++bj)
#pragma unroll
            for (int n = 0; n < 2; ++n) {
              const int sp = chunk * 64 + ((n0 + bj * 128 + wc * 32) >> 4) + n;
              const int token = sp < 256 ? NL + b * 256 + sp : b * SEQ + sp - 256;
              f32x4 v = acc[ai][bj][m][n];
#pragma unroll
              for (int j = 0; j < 4; ++j) v[j] = gelu_tanh(v[j]);
              *(u32x2*)(G5 + (size_t)token * 256 + g * 16 + c4) = pack4(v);
            }
        }
      }
  }
}
DI void phase_glu(const Params& p, int l, char* lds) {
  GPTR wsg_ = (GPTR)p.ws; asm volatile("" : "+s"(wsg_)); char* ws = (char*)wsg_;
  const int tid = otid(), lane = tid & 63, wid = tid >> 6, wr = wid >> 1, wc = wid & 1, fr = lane & 15, fq = lane >> 4, c4 = fq * 4;
  const bf16_t* G5 = (const bf16_t*)(ws + O_G5);
  bf16_t* Yc = (bf16_t*)(ws + O_YCAT);
  const UM um(128, 2);
  auto job = [&](int k) { int mt, nt; return um.get(k, mt, nt) ? gj_make(G5, nullptr, 256, mt * 256, (const bf16_t*)(ws + O_WGLU), 256, nt * 128, 256) : gj_none(); };
  GStream<GNST> gs; gs.start(job(0), lds, tid);
  int mt, ntile;
  for (int k = 0; um.get(k, mt, ntile); ++k) {
    const int m0 = mt * 256, n0 = ntile * 128;
    f32x4 acc[4][4]; zero_acc(acc);
    gs.run2(acc, job(k + 1));
    u32x2 gqa[4][4];
#pragma unroll
    for (int m = 0; m < 4; ++m)
#pragma unroll
      for (int n = 0; n < 4; ++n) gqa[m][n] = *(const u32x2*)(G5 + (size_t)(m0 + wr * 64 + m * 16 + fr) * 256 + n0 + wc * 64 + n * 16 + c4);
#pragma unroll
    for (int m = 0; m < 4; ++m) {
      const int row = m0 + wr * 64 + m * 16 + fr;
#pragma unroll
      for (int n = 0; n < 4; ++n) {
        const int col = n0 + wc * 64 + n * 16 + c4;
        const u32x2 gq = gqa[m][n];
        const float4 bb = *(const float4*)(p.b_glu + l * 256 + col);
        f32x4 o;
        o[0] = __uint_as_float(gq[0] << 16) * sigm(acc[m][n][0] + bb.x);
        o[1] = __uint_as_float(gq[0] & 0xffff0000u) * sigm(acc[m][n][1] + bb.y);
        o[2] = __uint_as_float(gq[1] << 16) * sigm(acc[m][n][2] + bb.z);
        o[3] = __uint_as_float(gq[1] & 0xffff0000u) * sigm(acc[m][n][3] + bb.w);
        *(u32x2*)(Yc + (size_t)row * 1024 + 768 + col) = pack4(o);
      }
    }
  }
  {
    const int t2 = otid(), ln = t2 & 63, wv = t2 >> 6;
    for (int w = blockIdx.x * 8 + wv; w < 512; w += gridDim.x * 8) {
      const int row0 = NL + (w >> 4) * 16, col = (w & 15) * 16 + (ln & 15);
      f32x4 a4 = f32x4{0.f, 0.f, 0.f, 0.f};
      mini_gemm16(a4, G5 + (size_t)row0 * 256, 256, (const bf16_t*)(ws + O_WGLU) + (size_t)(w & 15) * 16 * 256, 256, 256, ln);
      const float bb = p.b_glu[l * 256 + col];
#pragma unroll
      for (int j = 0; j < 4; ++j) {
        const int row = row0 + 4 * (ln >> 4) + j;
        Yc[(size_t)row * 1024 + 768 + col] = f2bf(bf2f(G5[(size_t)row * 256 + col]) * sigm(a4[j] + bb));
      }
    }
  }
}
DI void phase_merge(const Params& p, char* lds) {
  GPTR wsg_ = (GPTR)p.ws; asm volatile("" : "+s"(wsg_)); char* ws = (char*)wsg_;
  const int tid = otid(), lane = tid & 63, wid = tid >> 6, wr = wid >> 1, wc = wid & 1, fr = lane & 15, fq = lane >> 4, c4 = fq * 4;
  bf16_t* Mb = (bf16_t*)(ws + O_MBUF);
  const UM um(128, 8);
  auto job = [&](int seq) {
    const int i = (seq >> 1) & 3; int mt_, nt_;
    if (!um.get(seq >> 3, mt_, nt_)) return gj_none();
    const int m0 = mt_ * 256, n0 = nt_ * 128;
    if (seq & 1) return gj_make((const bf16_t*)(ws + O_H1), nullptr, 1024, m0, (const bf16_t*)(ws + O_WG) + (size_t)i * 1024 * 1024, 1024, n0, 1024);
    return gj_make((const bf16_t*)(ws + O_YCAT) + i * 256, nullptr, 1024, m0, (const bf16_t*)(ws + O_WBR) + (size_t)i * 262144, 256, n0, 256);
  };
  GStream<GNST> gs; gs.start(job(0), lds, tid);
  int seq = 0, mt, ntile;
  for (int k = 0; um.get(k, mt, ntile); ++k) {
    const int m0 = mt * 256, n0 = ntile * 128;
    u32x2 mpk[4][4];
    for (int i = 0; i < 4; ++i) {
      u32x2 pk[4][4];
      {
        f32x4 acc[4][4]; zero_acc(acc);
        gs.run<true>(acc, job(seq + 1)); ++seq;
#pragma unroll
        for (int m = 0; m < 4; ++m)
#pragma unroll
          for (int n = 0; n < 4; ++n) pk[m][n] = pack4(acc[m][n]);
      }
      f32x4 acc[4][4]; zero_acc(acc);
      gs.run<true>(acc, job(seq + 1)); ++seq;
#pragma unroll
      for (int m = 0; m < 4; ++m)
#pragma unroll
        for (int n = 0; n < 4; ++n) {
          f32x4 t;
          t[0] = sigm(acc[m][n][0]) * __uint_as_float(pk[m][n][0] << 16);
          t[1] = sigm(acc[m][n][1]) * __uint_as_float(pk[m][n][0] & 0xffff0000u);
          t[2] = sigm(acc[m][n][2]) * __uint_as_float(pk[m][n][1] << 16);
          t[3] = sigm(acc[m][n][3]) * __uint_as_float(pk[m][n][1] & 0xffff0000u);
          if (i > 0) {
            t[0] += __uint_as_float(mpk[m][n][0] << 16); t[1] += __uint_as_float(mpk[m][n][0] & 0xffff0000u);
            t[2] += __uint_as_float(mpk[m][n][1] << 16); t[3] += __uint_as_float(mpk[m][n][1] & 0xffff0000u);
          }
          mpk[m][n] = pack4(t);
        }
    }
#pragma unroll
    for (int m = 0; m < 4; ++m) {
      const int row = m0 + wr * 64 + m * 16 + fr;
#pragma unroll
      for (int n = 0; n < 4; ++n) *(u32x2*)(Mb + (size_t)row * 1024 + n0 + wc * 64 + n * 16 + c4) = mpk[m][n];
    }
  }
  {
    const int t2 = otid(), lane = t2 & 63, wid = t2 >> 6;
    const int pr_ = wid >> 1, hf = wid & 1;
    f32x4* part = (f32x4*)lds;
    __syncthreads();
    for (int q0 = blockIdx.x * 2; q0 < 512; q0 += gridDim.x * 2) {
      const int q = q0 + pr_;
      const int row0 = NL + (q >> 5) * 32, col0 = (q & 31) * 32;
      f32x4 macc[2][2];
#pragma unroll
      for (int r = 0; r < 2; ++r)
#pragma unroll
        for (int c = 0; c < 2; ++c) macc[r][c] = f32x4{0.f, 0.f, 0.f, 0.f};
      if (wid < 4) {
#pragma unroll 1
        for (int ii = 0; ii < 2; ++ii) {
          const int i = hf * 2 + ii;
          f32x4 ab[2][2], ag[2][2];
#pragma unroll
          for (int r = 0; r < 2; ++r)
#pragma unroll
            for (int c = 0; c < 2; ++c) { ab[r][c] = f32x4{0.f, 0.f, 0.f, 0.f}; ag[r][c] = f32x4{0.f, 0.f, 0.f, 0.f}; }
          mini_gemm32(ab, (const bf16_t*)(ws + O_YCAT) + (size_t)row0 * 1024 + i * 256, 1024, (const bf16_t*)(ws + O_WBR) + (size_t)i * 262144 + (size_t)col0 * 256, 256, 256, lane);
          mini_gemm32(ag, (const bf16_t*)(ws + O_H1) + (size_t)row0 * 1024, 1024, (const bf16_t*)(ws + O_WG) + ((size_t)i * 1024 + col0) * 1024, 1024, 1024, lane);
#pragma unroll
          for (int r = 0; r < 2; ++r)
#pragma unroll
            for (int c = 0; c < 2; ++c)
#pragma unroll
              for (int j = 0; j < 4; ++j) macc[r][c][j] += sigm(ag[r][c][j]) * ab[r][c][j];
        }
        if (hf == 1) {
#pragma unroll
          for (int r = 0; r < 2; ++r)
#pragma unroll
            for (int c = 0; c < 2; ++c) part[(pr_ * 4 + r * 2 + c) * 64 + lane] = macc[r][c];
        }
      }
      __syncthreads();
      if (wid < 4 && hf == 0) {
#pragma unroll
        for (int r = 0; r < 2; ++r)
#pragma unroll
          for (int c = 0; c < 2; ++c) {
            const f32x4 o = macc[r][c] + part[(pr_ * 4 + r * 2 + c) * 64 + lane];
#pragma unroll
            for (int j = 0; j < 4; ++j) Mb[(size_t)(row0 + r * 16 + 4 * (lane >> 4) + j) * 1024 + col0 + c * 16 + (lane & 15)] = f2bf(o[j]);
          }
      }
      __syncthreads();
    }
  }
}
DI void phase_outproj(const Params& p, int l, char* lds, float rscale = 1.f) {
  GPTR wsg_ = (GPTR)p.ws; asm volatile("" : "+s"(wsg_)); char* ws = (char*)wsg_;
  bf16_t* X = (bf16_t*)(ws + O_X);
  const float* ada = (const float*)(ws + O_ADA);
  const UM um(128, 4);
  int mt, ntile;
  for (int k = 0; um.get(k, mt, ntile); ++k) {
    const int m0 = mt * 256, n0 = ntile * 256;
    f32x4 acc[2][2][4][2]; zero_acc8(acc);
    asm volatile("s_waitcnt vmcnt(0)" ::: "memory");
    gemm8<false>(acc, (const bf16_t*)(ws + O_MBUF), nullptr, m0, (const bf16_t*)(ws + O_WOUT) + (size_t)n0 * 1024, (const bf16_t*)(ws + O_WOUT) + (size_t)(n0 + 128) * 1024, 1024, lds);
    const int tid = otid(), lane = tid & 63, wid = tid >> 6, wr = wid >> 2, wc = wid & 3, fr = lane & 15, fq = lane >> 4;
    const int cv = m0 < NL ? (m0 >> 14) : 2;
    const float* gt = ada + (l * 3 + cv) * 6144 + 2 * 1024 + n0 + wc * 32 + fq * 4;
    float4 g[2][2];
#pragma unroll
    for (int bj = 0; bj < 2; ++bj)
#pragma unroll
      for (int n = 0; n < 2; ++n) g[bj][n] = *(const float4*)(gt + bj * 128 + n * 16);
#pragma unroll
    for (int ai = 0; ai < 2; ++ai) {
      u32x2 xo[4][2][2];
#pragma unroll
      for (int m = 0; m < 4; ++m)
#pragma unroll
        for (int bj = 0; bj < 2; ++bj)
#pragma unroll
          for (int n = 0; n < 2; ++n)
            xo[m][bj][n] = *(const u32x2*)(X + (size_t)(m0 + ai * 128 + wr * 64 + m * 16 + fr) * 1024 + n0 + bj * 128 + wc * 32 + n * 16 + fq * 4);
#pragma unroll
      for (int m = 0; m < 4; ++m)
#pragma unroll
        for (int bj = 0; bj < 2; ++bj)
#pragma unroll
          for (int n = 0; n < 2; ++n) {
            const u32x2 xv = xo[m][bj][n]; const f32x4 av = acc[ai][bj][m][n]; const float4 gg = g[bj][n];
            u32x2 xn;
            xn[0] = pack2(__uint_as_float(xv[0] << 16) + rscale * gg.x * av[0], __uint_as_float(xv[0] & 0xffff0000u) + rscale * gg.y * av[1]);
            xn[1] = pack2(__uint_as_float(xv[1] << 16) + rscale * gg.z * av[2], __uint_as_float(xv[1] & 0xffff0000u) + rscale * gg.w * av[3]);
            *(u32x2*)(X + (size_t)(m0 + ai * 128 + wr * 64 + m * 16 + fr) * 1024 + n0 + bj * 128 + wc * 32 + n * 16 + fq * 4) = xn;
          }
    }
  }
  const int tid = otid(), lane = tid & 63, wid = tid >> 6;
  (void)lane; (void)wid;
  {
    const int t2 = otid(), lane = t2 & 63, wid = t2 >> 6;
    if (wid < 2) {
      for (int q = blockIdx.x * 2 + wid; q < 512; q += gridDim.x * 2) {
        const int row0 = NL + (q >> 5) * 32, col0 = (q & 31) * 32;
        f32x4 acc[2][2];
#pragma unroll
        for (int r = 0; r < 2; ++r)
#pragma unroll
          for (int c = 0; c < 2; ++c) acc[r][c] = f32x4{0.f, 0.f, 0.f, 0.f};
        mini_gemm32(acc, (const bf16_t*)(ws + O_MBUF) + (size_t)row0 * 1024, 1024, (const bf16_t*)(ws + O_WOUT) + (size_t)col0 * 1024, 1024, 1024, lane);
        bf16_t xold[2][2][4];
#pragma unroll
        for (int r = 0; r < 2; ++r)
#pragma unroll
          for (int c = 0; c < 2; ++c)
#pragma unroll
            for (int j = 0; j < 4; ++j) xold[r][c][j] = X[(size_t)(row0 + r * 16 + 4 * (lane >> 4) + j) * 1024 + col0 + c * 16 + (lane & 15)];
#pragma unroll
        for (int c = 0; c < 2; ++c) {
          const float g = ada[(l * 3 + 2) * 6144 + 2 * 1024 + col0 + c * 16 + (lane & 15)];
#pragma unroll
          for (int r = 0; r < 2; ++r)
#pragma unroll
            for (int j = 0; j < 4; ++j) X[(size_t)(row0 + r * 16 + 4 * (lane >> 4) + j) * 1024 + col0 + c * 16 + (lane & 15)] = f2bf(bf2f(xold[r][c][j]) + rscale * g * acc[r][c][j]);
        }
      }
    }
  }
}
DI void phase_norm2(const Params& p, int l, char* lds) {
  GPTR wsg_ = (GPTR)p.ws; asm volatile("" : "+s"(wsg_)); char* ws = (char*)wsg_;
  const int tid = otid(), lane = tid & 63, w = tid >> 6, fr = lane & 15, fq = lane >> 4;
  const bf16_t* X = (const bf16_t*)(ws + O_X);
  bf16_t* H2 = (bf16_t*)(ws + O_H2);
  float* LG = (float*)(ws + O_LOGIT);
  const float* ada = (const float*)(ws + O_ADA);
  float* ssq = (float*)lds;
  float* red = (float*)(lds + 1024);
  float* tabG = (float*)(lds + 40960);
  float* tabS = tabG + 3072;
  for (int i = tid; i < 3072; i += NTHR) {
    const int cv_ = i >> 10, k_ = i & 1023;
    const float* a_ = ada + (l * 3 + cv_) * 6144 + 3 * 1024 + k_;
    tabG[i] = p.g_norm2[l * 1024 + k_] * (1.f + a_[1024]); tabS[i] = a_[0];
  }
  __syncthreads();
  const int kb = w * 128 + fq * 8;
  bf16x8 bh[4][4], bl[4][4];
#pragma unroll
  for (int e = 0; e < 4; ++e)
#pragma unroll
    for (int s_ = 0; s_ < 4; ++s_) {
      const size_t off = (size_t)(e * 16 + fr) * 1024 + kb + s_ * 32;
      bh[e][s_] = *(const bf16x8*)((const bf16_t*)(ws + O_WRHI) + off);
      bl[e][s_] = *(const bf16x8*)((const bf16_t*)(ws + O_WRLO) + off);
    }
  const int ng = NTOK / 16;
  u32x4 xn[4];
  if ((int)blockIdx.x < ng) {
#pragma unroll
    for (int s_ = 0; s_ < 4; ++s_) xn[s_] = *(const u32x4*)(X + (size_t)(blockIdx.x * 16 + fr) * 1024 + kb + s_ * 32);
  }
#pragma unroll 1
  for (int gi = blockIdx.x; gi < ng; gi += gridDim.x) {
    const int row0 = gi * 16, row = row0 + fr, cv = row0 < NL ? (row0 >> 14) : 2;
    u32x4 xr[4];
#pragma unroll
    for (int s_ = 0; s_ < 4; ++s_) xr[s_] = xn[s_];
    if (gi + (int)gridDim.x < ng) {
#pragma unroll
      for (int s_ = 0; s_ < 4; ++s_) xn[s_] = *(const u32x4*)(X + (size_t)((gi + gridDim.x) * 16 + fr) * 1024 + kb + s_ * 32);
    }
    float ss = 0.f;
#pragma unroll
    for (int s_ = 0; s_ < 4; ++s_)
#pragma unroll
      for (int j = 0; j < 4; ++j) { const float a0 = __uint_as_float(xr[s_][j] << 16), a1 = __uint_as_float(xr[s_][j] & 0xffff0000u); ss += a0 * a0; ss += a1 * a1; }
    ss = xhalf(ss); ss += bperm(ss, lane ^ 16);
    if (fq == 0) ssq[w * 16 + fr] = ss;
    __syncthreads();
    float tot = 0.f;
#pragma unroll
    for (int w2 = 0; w2 < 8; ++w2) tot += ssq[w2 * 16 + fr];
    const float rstd = rsqrtf(tot * (1.f / 1024.f) + EPS);
    const float* gn = tabG + cv * 1024 + kb;
    const float* sh = tabS + cv * 1024 + kb;
    f32x4 acc[4];
#pragma unroll
    for (int e = 0; e < 4; ++e) acc[e] = f32x4{0.f, 0.f, 0.f, 0.f};
#pragma unroll
    for (int s_ = 0; s_ < 4; ++s_) {
      u32x4 ahi, alo;
#pragma unroll
      for (int q = 0; q < 2; ++q) {
        const float4 g = *(const float4*)(gn + s_ * 32 + q * 4), s1 = *(const float4*)(sh + s_ * 32 + q * 4);
        const unsigned u0 = xr[s_][q * 2], u1 = xr[s_][q * 2 + 1];
        const float h0 = __uint_as_float(u0 << 16) * rstd * g.x + s1.x, h1 = __uint_as_float(u0 & 0xffff0000u) * rstd * g.y + s1.y;
        const float h2 = __uint_as_float(u1 << 16) * rstd * g.z + s1.z, h3 = __uint_as_float(u1 & 0xffff0000u) * rstd * g.w + s1.w;
        const unsigned p0 = pack2(h0, h1), p1 = pack2(h2, h3);
        ahi[q * 2] = p0; ahi[q * 2 + 1] = p1;
        alo[q * 2] = pack2(h0 - __uint_as_float(p0 << 16), h1 - __uint_as_float(p0 & 0xffff0000u));
        alo[q * 2 + 1] = pack2(h2 - __uint_as_float(p1 << 16), h3 - __uint_as_float(p1 & 0xffff0000u));
      }
      *(u32x4*)(H2 + (size_t)row * 1024 + kb + s_ * 32) = ahi;
      const bf16x8 fh = __builtin_bit_cast(bf16x8, ahi), fl = __builtin_bit_cast(bf16x8, alo);
#pragma unroll
      for (int e = 0; e < 4; ++e) { acc[e] = MFMA16(fh, bh[e][s_], acc[e]); acc[e] = MFMA16(fl, bh[e][s_], acc[e]); acc[e] = MFMA16(fh, bl[e][s_], acc[e]); }
    }
#pragma unroll
    for (int e = 0; e < 4; ++e) *(f32x4*)(red + ((w * 4 + e) * 64 + lane) * 4) = acc[e];
    __syncthreads();
    if (tid < 256) {
      const int e = tid >> 6, ln = tid & 63;
      f32x4 sum = *(const f32x4*)(red + (e * 64 + ln) * 4);
#pragma unroll
      for (int w2 = 1; w2 < 8; ++w2) sum += *(const f32x4*)(red + ((w2 * 4 + e) * 64 + ln) * 4);
#pragma unroll
      for (int j = 0; j < 4; ++j) LG[(size_t)(row0 + (ln >> 4) * 4 + j) * 64 + e * 16 + (ln & 15)] = sum[j];
    }
  }
}
DI void phase_topk(const Params& p, int l, char* lds) {
  GPTR wsg_ = (GPTR)p.ws; asm volatile("" : "+s"(wsg_)); char* ws = (char*)wsg_;
  const int tid = otid(), lane = tid & 63, wid = tid >> 6;
  int* lcnt = (int*)lds;
  int* lbase = lcnt + 64;
  const float* LG = (const float*)(ws + O_LOGIT);
  int* IDX = (int*)(ws + O_IDX); float* GW = (float*)(ws + O_GW); int* RANK = (int*)(ws + O_SLOT);
  if (tid < 64) lcnt[tid] = 0;
  __syncthreads();
  const int rows_per = (NTOK + gridDim.x - 1) / gridDim.x;
  const int r0 = blockIdx.x * rows_per, r1 = min(NTOK, r0 + rows_per);
  const float eb = p.e_bias[l * 64 + lane];
  float lgv[17];
#pragma unroll
  for (int i = 0; i < 17; ++i) { const int row = r0 + wid + i * 8; lgv[i] = row < r1 ? LG[(size_t)row * 64 + lane] : 0.f; }
#pragma unroll
  for (int i = 0; i < 17; ++i) {
    const int row = r0 + wid + i * 8;
    if (row >= r1) break;
    const float score = sigm(lgv[i]);
    float sel = score + eb;
    float gsum = 0.f; int myk = -1;
    for (int k = 0; k < 6; ++k) {
      const float mx = wave_max(sel, lane);
      const unsigned long long bal = __ballot(sel == mx);
      const int win = __ffsll((long long)bal) - 1;
      const float sc_w = bperm(score, win);
      gsum += sc_w;
      if (lane == win) { sel = -1e30f; myk = k; }
    }
    if (myk >= 0) {
      const int lr = atomicAdd(&lcnt[lane], 1);
      IDX[row * 6 + myk] = lane; GW[row * 6 + myk] = score / gsum; RANK[row * 6 + myk] = lr;
    }
  }
  __syncthreads();
  if (tid < 64) lbase[tid] = atomicAdd((int*)(ws + O_CNT) + tid, lcnt[tid]);
  __syncthreads();
  for (int i = r0 * 6 + tid; i < r1 * 6; i += NTHR) RANK[i] += lbase[IDX[i]];
}

DI void phase_lists(const Params& p, char* lds) {
  GPTR wsg_ = (GPTR)p.ws; asm volatile("" : "+s"(wsg_)); char* ws = (char*)wsg_;
  const int tid = otid();
  int* poff = (int*)lds;
  const int* cnt = (const int*)(ws + O_CNT);
  if (tid == 0) { int a = 0; for (int e = 0; e < 64; ++e) { poff[e] = a; a += (cnt[e] + 255) & ~255; } poff[64] = a; }
  __syncthreads();
  int* SLOT = (int*)(ws + O_SLOT); const int* IDX = (const int*)(ws + O_IDX); int* ROWIDX = (int*)(ws + O_ROWIDX);
  for (int i = blockIdx.x * NTHR + tid; i < NTOK * 6; i += gridDim.x * NTHR) {
    const int s = poff[IDX[i]] + SLOT[i];
    SLOT[i] = s; ROWIDX[s] = i / 6;
  }
  for (int e = blockIdx.x; e < 64; e += gridDim.x) {
    const int c = cnt[e], pc = (c + 255) & ~255;
    for (int s = c + tid; s < pc; s += NTHR) ROWIDX[poff[e] + s] = 0;
  }
  for (int t = blockIdx.x * NTHR + tid; t < NTOK; t += gridDim.x * NTHR) ROWIDX[poff[64] + t] = t;
}
DI int find_expert(const int* poff, int slot0) { int e = 0; for (int i = 1; i < 64; ++i) e = (poff[i] <= slot0) ? i : e; return e; }

DI void phase_moe1(const Params& p, char* lds) {
  GPTR wsg_ = (GPTR)p.ws; asm volatile("" : "+s"(wsg_)); char* ws = (char*)wsg_;
  int* poff = (int*)(lds + LDS_POFF);
  {
    const int tid = otid();
    const int* cnt = (const int*)(ws + O_CNT);
    if (tid == 0) { int a = 0; for (int e = 0; e < 64; ++e) { poff[e] = a; a += (cnt[e] + 255) & ~255; } poff[64] = a; }
    __syncthreads();
  }
  const int TR = poff[64] >> 8;
  bf16_t* ACT = (bf16_t*)(ws + O_ACT);
  const bf16_t* H2 = (const bf16_t*)(ws + O_H2);
  const UM um(TR + 130, 2);
  int ti, ntile;
  for (int k = 0; um.get(k, ti, ntile); ++k) {
    const int f0 = ntile * 128, slot0 = ti * 256;
    const int e = ti < TR ? find_expert(poff, slot0) : 64;
    f32x4 acc[2][2][4][2]; zero_acc8(acc);
    asm volatile("s_waitcnt vmcnt(0)" ::: "memory");
    gemm8<true>(acc, H2, (const int*)(ws + O_ROWIDX), slot0, (const bf16_t*)(ws + O_WE1) + (size_t)e * 262144 + (size_t)f0 * 1024, (const bf16_t*)(ws + O_WE3) + (size_t)e * 262144 + (size_t)f0 * 1024, 1024, lds);
    const int tid = otid(), lane = tid & 63, wid = tid >> 6, wr = wid >> 2, wc = wid & 3, fr = lane & 15, fq = lane >> 4;
#pragma unroll
    for (int ai = 0; ai < 2; ++ai)
#pragma unroll
      for (int m = 0; m < 4; ++m) {
        const int row = slot0 + ai * 128 + wr * 64 + m * 16 + fr;
#pragma unroll
        for (int n = 0; n < 2; ++n) {
          const f32x4 g = acc[ai][0][m][n], u = acc[ai][1][m][n];
          f32x4 o;
#pragma unroll
          for (int j = 0; j < 4; ++j) o[j] = g[j] * sigm(g[j]) * u[j];
          *(u32x2*)(ACT + (size_t)row * 256 + f0 + wc * 32 + n * 16 + fq * 4) = pack4(o);
        }
      }
  }
}
DI void phase_moe2(const Params& p, char* lds) {
  GPTR wsg_ = (GPTR)p.ws; asm volatile("" : "+s"(wsg_)); char* ws = (char*)wsg_;
  const int tid = otid(), lane = tid & 63, wid = tid >> 6, wr = wid >> 1, wc = wid & 1, fr = lane & 15, fq = lane >> 4;
  int* poff = (int*)(lds + LDS_POFF);
  const int* cnt = (const int*)(ws + O_CNT);
  if (tid == 0) { int a = 0; for (int e = 0; e < 64; ++e) { poff[e] = a; a += (cnt[e] + 255) & ~255; } poff[64] = a; }
  __syncthreads();
  const int TR = poff[64] >> 8;
  const bf16_t* ACT = (const bf16_t*)(ws + O_ACT);
  unsigned char* Y = (unsigned char*)(ws + O_R);
  const UM um(TR + 130, 4);
  auto job = [&](int k) {
    int ti, nt_;
    if (!um.get(k, ti, nt_)) return gj_none();
    const int slot0 = ti * 256, e = ti < TR ? find_expert(poff, slot0) : 64;
    return gj_make(ACT, nullptr, 256, slot0, (const bf16_t*)(ws + O_WE2) + (size_t)e * 262144, 256, nt_ * 256, 256);
  };
  GStreamW gs; gs.start(job(0), lds, tid);
  int ti, ntile;
  for (int k = 0; um.get(k, ti, ntile); ++k) {
    const int n0 = ntile * 256, slot0 = ti * 256;
    f32x4 acc[4][8]; zero_accw(acc);
    gs.run(acc, job(k + 1));
    if (ti >= TR) {
      bf16_t* Ysh = (bf16_t*)(ws + O_R + (size_t)YROWS * 1024);
#pragma unroll
      for (int m = 0; m < 4; ++m) {
        const int row = (ti - TR) * 256 + wr * 64 + m * 16 + fr;
#pragma unroll
        for (int n = 0; n < 8; ++n) *(u32x2*)(Ysh + (size_t)row * 1024 + n0 + wc * 128 + n * 16 + fq * 4) = pack4(acc[m][n]);
      }
    } else
#pragma unroll
    for (int m = 0; m < 4; ++m) {
      const int row = slot0 + wr * 64 + m * 16 + fr;
#pragma unroll
      for (int hf = 0; hf < 2; ++hf) {
        unsigned a[4];
#pragma unroll
        for (int n = 0; n < 4; ++n) {
          const f32x4 v = acc[m][hf * 4 + n];
          const float q0 = __builtin_amdgcn_fmed3f(v[0] * 16.f, -448.f, 448.f), q1 = __builtin_amdgcn_fmed3f(v[1] * 16.f, -448.f, 448.f);
          const float q2 = __builtin_amdgcn_fmed3f(v[2] * 16.f, -448.f, 448.f), q3 = __builtin_amdgcn_fmed3f(v[3] * 16.f, -448.f, 448.f);
          int w = __builtin_amdgcn_cvt_pk_fp8_f32(q0, q1, 0, false);
          w = __builtin_amdgcn_cvt_pk_fp8_f32(q2, q3, w, true);
          a[n] = (unsigned)w;
        }
        const auto r01 = __builtin_amdgcn_permlane16_swap(a[0], a[1], false, false);
        const auto r23 = __builtin_amdgcn_permlane16_swap(a[2], a[3], false, false);
        const auto s02 = __builtin_amdgcn_permlane32_swap(r01[0], r23[0], false, false);
        const auto s13 = __builtin_amdgcn_permlane32_swap(r01[1], r23[1], false, false);
        *(u32x4*)(Y + (size_t)row * 1024 + n0 + wc * 128 + hf * 64 + fq * 16) = u32x4{s02[0], s13[0], s02[1], s13[1]};
      }
    }
  }
}

#define XB_TMO      128
#define XB_XCNT(j)  (256  + 64 * (j))
#define XB_XSUB(j)  (1280 + 64 * (j))
#define XB_XGEN(j)  (2304 + 64 * (j))
#define XB_TOP      3328
#define XB_TOPGEN   3392
#define XCD_BAR_WORDS 3456
#define XB_SPIN_CAP (1u << 21)
__device__ __forceinline__ unsigned xb_ld(unsigned* p)              { return __hip_atomic_load(p, __ATOMIC_RELAXED, __HIP_MEMORY_SCOPE_AGENT); }
__device__ __forceinline__ unsigned xb_add(unsigned* p, unsigned v) { return __hip_atomic_fetch_add(p, v, __ATOMIC_RELAXED, __HIP_MEMORY_SCOPE_AGENT); }
__device__ __forceinline__ unsigned xb_xcc_id() { return (unsigned)__builtin_amdgcn_s_getreg((3 << 11) | 20) & 0xFu; }
#define XB_SPIN(cond, bar) do { unsigned _sp = 0; while (cond) { __builtin_amdgcn_s_sleep(1); \
    if ((++_sp & 255u) == 0u) { if (xb_ld(&(bar)[XB_TMO])) break; if (_sp > XB_SPIN_CAP) { atomicAdd(&(bar)[XB_TMO], 1u); break; } } } } while (0)
struct XcdBarrier { unsigned* bar; unsigned x; volatile LAS unsigned* st; };
__device__ __forceinline__ XcdBarrier xcd_barrier_post(unsigned* bar, volatile LAS unsigned* st) {
    XcdBarrier b; b.bar = bar; b.x = xb_xcc_id(); b.st = st;
    if (threadIdx.x == 0) (void)xb_add(&bar[XB_XCNT(b.x)], 1u);
    return b;
}
__device__ __forceinline__ void xcd_barrier_complete(unsigned* bar, unsigned x, unsigned& nloc, unsigned& nx) {
    const unsigned G = gridDim.x * gridDim.y * gridDim.z;
    unsigned sum, cnt, mine, sp = 0u;
    for (;;) {
        sum = 0u; cnt = 0u; mine = 0u;
#pragma unroll
        for (unsigned j = 0; j < 16; ++j) { const unsigned c = xb_ld(&bar[XB_XCNT(j)]); sum += c; cnt += (c > 0u) ? 1u : 0u; mine = (j == x) ? c : mine; }
        if (sum == G) break;
        __builtin_amdgcn_s_sleep(1);
        if ((++sp & 255u) == 0u) { if (xb_ld(&bar[XB_TMO])) break; if (sp > XB_SPIN_CAP) { atomicAdd(&bar[XB_TMO], 1u); break; } }
    }
    nloc = mine > 0u ? mine : 1u; nx = cnt > 0u ? cnt : 1u;
}
__device__ __forceinline__ void xcd_barrier(const XcdBarrier& b) {
    asm volatile("s_waitcnt vmcnt(0)" ::: "memory");
    __syncthreads();
    if (threadIdx.x == 0) {
        unsigned* bar = b.bar;
        __builtin_amdgcn_s_waitcnt(0);
        unsigned nloc = b.st[0], nx = b.st[1];
        if (nloc == 0u) { xcd_barrier_complete(bar, b.x, nloc, nx); b.st[0] = nloc; b.st[1] = nx; }
        const unsigned old = xb_add(&bar[XB_XSUB(b.x)], 1u);
        const unsigned gen = old / nloc;
        if (old + 1u == (gen + 1u) * nloc) {
            __builtin_amdgcn_fence(__ATOMIC_RELEASE, "agent");
            asm volatile("s_waitcnt vmcnt(0)" ::: "memory");
            const unsigned og = xb_add(&bar[XB_TOP], 1u);
            const unsigned tg = og / nx;
            if (og + 1u == (tg + 1u) * nx) xb_add(&bar[XB_TOPGEN], 1u);
            else XB_SPIN(xb_ld(&bar[XB_TOPGEN]) == tg, bar);
            __builtin_amdgcn_fence(__ATOMIC_ACQUIRE, "agent");
            xb_add(&bar[XB_XGEN(b.x)], 1u);
            asm volatile("s_waitcnt vmcnt(0)" ::: "memory");
        } else {
            XB_SPIN(xb_ld(&bar[XB_XGEN(b.x)]) == gen, bar);
            __builtin_amdgcn_fence(__ATOMIC_ACQUIRE, "agent");
            asm volatile("s_waitcnt vmcnt(0)" ::: "memory");
        }
    }
    __syncthreads();
}

__global__ void __launch_bounds__(NTHR, 2) k_mega(Params_ p_unused) {
#define p (*kargs())
  extern __shared__ __attribute__((aligned(16))) char lds[];
  uint4* xbw = (uint4*)(lds + LDS_BYTES);
  if (threadIdx.x == 0) *xbw = make_uint4(0u, 0u, 0u, 0u);
  __syncthreads();
  (void)xcd_barrier_post((unsigned*)(p.ws + O_BAR), (volatile LAS unsigned*)xbw);
#define GRID_BAR() do { XcdBarrier b_; unsigned long long bp_ = (unsigned long long)(p.ws + O_BAR); asm volatile("" : "+s"(bp_)); b_.bar = (unsigned*)bp_; b_.x = xb_xcc_id(); b_.st = (volatile LAS unsigned*)(lds + LDS_BYTES); xcd_barrier(b_); } while (0)
#if PROBE_GROUP
#define REPS(g) int reps_ = 1 + ((g) == PROBE_GROUP ? 1 : 0); asm volatile("" : "+s"(reps_)); _Pragma("unroll 1") for (int r_ = 0; r_ < reps_; ++r_)
#define RSC (r_ == 0 ? 1.f : 0.f)
#else
#define REPS(g)
#define RSC 1.f
#endif
  { REPS(11) { phase_p0(p, lds); GRID_BAR(); phase_p1(p); GRID_BAR(); } }
  for (int l = 0; l < DEPTH; ++l) {
    { REPS(1) { phase_rows(p, l, RSC); } }
    { REPS(10) { phase_prep(p, l, lds); GRID_BAR(); } }
    if (blockIdx.x == 0) { const int t_ = otid(); if (t_ < 64) ((int*)(p.ws + O_CNT))[t_] = 0; if (t_ < 8) ((int*)(p.ws + O_QCTR))[t_ * 64] = 0; }
    phase_proj(p, lds); GRID_BAR(); phase_up(p, lds); GRID_BAR();
    phase_attn(p, l, lds); GRID_BAR();
    { REPS(4) { phase_s5out(p, lds); GRID_BAR(); phase_glu(p, l, lds); GRID_BAR(); } }
    { REPS(5) { phase_merge(p, lds); GRID_BAR(); } }
    { REPS(6) { phase_outproj(p, l, lds, RSC); GRID_BAR(); } }
    { REPS(7) { phase_norm2(p, l, lds); GRID_BAR(); } }
    { REPS(12) {
#if PROBE_GROUP == 12
      if (r_ > 0) { if (blockIdx.x == 0) { const int t_ = otid(); if (t_ < 64) ((int*)(p.ws + O_CNT))[t_] = 0; } GRID_BAR(); }
#endif
      phase_topk(p, l, lds); GRID_BAR();
      phase_lists(p, lds); GRID_BAR(); } }
    { REPS(8) { phase_moe1(p, lds); GRID_BAR(); } }
    { REPS(9) { phase_moe2(p, lds); GRID_BAR(); } }
  }
  phase_rows(p, DEPTH);
#undef p
}

extern "C" void kernel_launch(void* const* d_in, const int* in_sizes, int n_in, void* d_out, int out_size, void* d_ws, size_t ws_size, hipStream_t stream) {
  if (ws_size < WS_NEED) { fprintf(stderr, "workspace too small: %zu < %zu\n", ws_size, (size_t)WS_NEED); return; }
  Params_ p{};
  const float** pp = (const float**)&p;
  for (int i = 0; i < 37; ++i) pp[i] = (const float*)d_in[i];
  p.out = (float*)d_out; p.ws = (char*)d_ws;
  constexpr int kDynLds = LDS_TOTAL;
  static int grid = 0;
  if (!grid) {
    int dev = 0, cus = 0, per_cu = 0;
    hipGetDevice(&dev);
    hipDeviceGetAttribute(&cus, hipDeviceAttributeMultiprocessorCount, dev);
    hipFuncSetAttribute((const void*)k_mega, hipFuncAttributeMaxDynamicSharedMemorySize, kDynLds);
    hipOccupancyMaxActiveBlocksPerMultiprocessor(&per_cu, (const void*)k_mega, NTHR, kDynLds);
    grid = cus * (per_cu < 1 ? per_cu : 1);
    if (grid > 256) grid = 256;
  }
  if (grid <= 0) { fprintf(stderr, "k_mega does not fit\n"); return; }
  hipMemsetAsync((char*)d_ws + O_BAR, 0, 16384, stream);
  hipLaunchKernelGGL(k_mega, dim3(grid), dim3(NTHR), kDynLds, stream, p);
}
```
